# Optimizing an MI355X kernel written in HIP

```python
import jax, jax.numpy as jnp
from jax import lax
import numpy as np

D_MODEL = 1024
BATCH = 8
SEQ = 4096
DEPTH = 4

N_META = 16
N_HEADS = 8
N_KV_HEADS = 2
HEAD_DIM = 64
GQA_GROUP = N_HEADS // N_KV_HEADS
ATTN_WIDTH = N_HEADS * HEAD_DIM
KV_WIDTH = N_KV_HEADS * HEAD_DIM
WINDOW = 128
BLOCK = 128
N_FOURIER_GROUPS = 4
FOURIER_GROUP = 128
FOURIER_WIDTH = N_FOURIER_GROUPS * FOURIER_GROUP
N_BRANCHES = 2
IN_WIDTH = ATTN_WIDTH + 2 * KV_WIDTH + FOURIER_WIDTH + N_BRANCHES * D_MODEL
N_EXPERTS = 16
CAPACITY_FACTOR = 2
D_FF_EXPERT = 1536
DEEPNORM_ALPHA = (2 * DEPTH) ** 0.25
DEEPNORM_BETA = (8 * DEPTH) ** -0.25
LN_EPS = 1e-5
NEG_INF = -1e30
Q_END = ATTN_WIDTH
K_END = Q_END + KV_WIDTH
V_END = K_END + KV_WIDTH
F_END = V_END + FOURIER_WIDTH

kernel_name = 'hybrid_swa_fnet_ec_moe_encoder'


def alibi_slopes():
    return np.array([2.0 ** (-8.0 * (h + 1) / N_HEADS) for h in range(N_HEADS)], dtype=np.float32)


def layer_norm(x, g, b):
    xf = x.astype(jnp.float32)
    mu = jnp.mean(xf, axis=-1, keepdims=True)
    var = jnp.mean(jnp.square(xf - mu), axis=-1, keepdims=True)
    y = (xf - mu) * lax.rsqrt(var + LN_EPS)
    return (y * g.astype(jnp.float32) + b.astype(jnp.float32)).astype(x.dtype)


def windowed_gqa_alibi_sink(q, k, v, sink):
    B, L = q.shape[0], q.shape[1]
    nb = -(-L // BLOCK)
    lp = nb * BLOCK
    lead = lp - L
    qb = jnp.pad(q, ((0, 0), (lead, 0), (0, 0), (0, 0))).reshape(B, nb, BLOCK, N_KV_HEADS, GQA_GROUP, HEAD_DIM)
    kp = jnp.pad(k, ((0, 0), (lead + BLOCK, BLOCK), (0, 0), (0, 0))).reshape(B, nb + 2, BLOCK, N_KV_HEADS, HEAD_DIM)
    vp = jnp.pad(v, ((0, 0), (lead + BLOCK, BLOCK), (0, 0), (0, 0))).reshape(B, nb + 2, BLOCK, N_KV_HEADS, HEAD_DIM)
    kwin = jnp.concatenate([kp[:, :-2], kp[:, 1:-1], kp[:, 2:]], axis=2)
    vwin = jnp.concatenate([vp[:, :-2], vp[:, 1:-1], vp[:, 2:]], axis=2)
    scores = jnp.einsum('bnqkgd,bnskd->bnkgqs', qb, kwin).astype(jnp.float32) * (HEAD_DIM ** -0.5)
    s_idx = jnp.arange(3 * BLOCK)
    rel = s_idx[None, :] - BLOCK - jnp.arange(BLOCK)[:, None]
    kpos = (jnp.arange(nb)[:, None] - 1) * BLOCK + s_idx[None, :]
    kvalid = (kpos >= lead) & (kpos < lp)
    mask = (jnp.abs(rel) <= WINDOW)[None, :, :] & kvalid[:, None, :]
    slopes = jnp.asarray(alibi_slopes()).reshape(N_KV_HEADS, GQA_GROUP)
    bias = -slopes[:, :, None, None] * jnp.abs(rel).astype(jnp.float32)
    logits = jnp.where(mask[None, :, None, None], scores + bias, NEG_INF)
    sink_l = sink.astype(jnp.float32).reshape(N_KV_HEADS, GQA_GROUP)[:, :, None]
    m = jnp.maximum(jnp.max(logits, axis=-1), sink_l)
    p = jnp.exp(logits - m[..., None])
    denom = jnp.sum(p, axis=-1) + jnp.exp(sink_l - m)
    o = jnp.einsum('bnkgqs,bnskd->bnqkgd', p, vwin.astype(jnp.float32))
    o = o / jnp.transpose(denom, (0, 1, 4, 2, 3))[..., None]
    return o.reshape(B, lp, ATTN_WIDTH)[:, lead:].astype(q.dtype)


def fourier_mix(u):
    B, L = u.shape[0], u.shape[1]
    uf = u.astype(jnp.float32).reshape(B, L, N_FOURIER_GROUPS, FOURIER_GROUP)
    z = jnp.fft.fft2(uf, axes=(1, 3), norm='ortho').real
    return z.reshape(B, L, FOURIER_WIDTH).astype(u.dtype)


def hybrid_mixer(h, w_in, b_gate, sink, w_attn_o, w_four_o, w_out):
    B, L, _ = h.shape
    u = jnp.einsum('bld,dn->bln', h, w_in)
    q = u[..., :Q_END].reshape(B, L, N_HEADS, HEAD_DIM)
    k = u[..., Q_END:K_END].reshape(B, L, N_KV_HEADS, HEAD_DIM)
    v = u[..., K_END:V_END].reshape(B, L, N_KV_HEADS, HEAD_DIM)
    uf = u[..., V_END:F_END]
    ug = u[..., F_END:].reshape(B, L, N_BRANCHES, D_MODEL)
    attn = windowed_gqa_alibi_sink(q, k, v, sink)
    four = fourier_mix(uf)
    gates = jax.nn.sigmoid(ug + b_gate)
    merged = (gates[:, :, 0] * jnp.einsum('blc,cd->bld', attn, w_attn_o)
              + gates[:, :, 1] * jnp.einsum('blc,cd->bld', four, w_four_o))
    return jnp.einsum('bld,de->ble', merged, w_out)


def expert_choice_moe(h, w_router, w_gate, w_up, w_down):
    B, L, _ = h.shape
    cap = CAPACITY_FACTOR * L // N_EXPERTS
    aff = jax.nn.softmax(jnp.einsum('bld,de->ble', h, w_router).astype(jnp.float32), axis=-1)
    g, idx = lax.top_k(jnp.swapaxes(aff, 1, 2), cap)
    bidx = jnp.arange(B)[:, None, None]
    xg = h[bidx, idx]
    a = jnp.einsum('becd,edf->becf', xg, w_gate)
    b = jnp.einsum('becd,edf->becf', xg, w_up)
    y = jnp.einsum('becf,efd->becd', jax.nn.silu(a) * b, w_down)
    y = y * g[..., None].astype(y.dtype)
    return jnp.zeros_like(h).at[bidx, idx].add(y)


def setup_inputs(seed: int = 0) -> dict:
    key = jax.random.key(seed)
    ks = jax.random.split(key, 24)
    nrm = lambda kk, shape, s: jax.random.normal(kk, shape, jnp.float32) * s
    w_in = nrm(ks[3], (DEPTH, D_MODEL, IN_WIDTH), D_MODEL ** -0.5)
    w_in = w_in.at[:, :, K_END:V_END].multiply(DEEPNORM_BETA)
    return {
        'x': nrm(ks[0], (BATCH, SEQ, D_MODEL), 1.0),
        'meta': nrm(ks[1], (N_META, D_MODEL), 1.0),
        'ln0_g': 1.0 + nrm(ks[2], (D_MODEL,), 0.02),
        'ln0_b': nrm(ks[4], (D_MODEL,), 0.02),
        'w_in': w_in,
        'b_gate': nrm(ks[5], (DEPTH, N_BRANCHES, D_MODEL), 0.1),
        'sink': nrm(ks[6], (DEPTH, N_HEADS), 0.5),
        'w_attn_o': nrm(ks[7], (DEPTH, ATTN_WIDTH, D_MODEL), ATTN_WIDTH ** -0.5 * DEEPNORM_BETA),
        'w_four_o': nrm(ks[8], (DEPTH, FOURIER_WIDTH, D_MODEL), FOURIER_WIDTH ** -0.5 * DEEPNORM_BETA),
        'w_out': nrm(ks[9], (DEPTH, D_MODEL, D_MODEL), D_MODEL ** -0.5 * DEEPNORM_BETA),
        'ln1_g': 1.0 + nrm(ks[10], (DEPTH, D_MODEL), 0.02),
        'ln1_b': nrm(ks[11], (DEPTH, D_MODEL), 0.02),
        'w_router': nrm(ks[12], (DEPTH, D_MODEL, N_EXPERTS), D_MODEL ** -0.5),
        'w_e_gate': nrm(ks[13], (DEPTH, N_EXPERTS, D_MODEL, D_FF_EXPERT), D_MODEL ** -0.5),
        'w_e_up': nrm(ks[14], (DEPTH, N_EXPERTS, D_MODEL, D_FF_EXPERT), D_MODEL ** -0.5),
        'w_e_down': nrm(ks[15], (DEPTH, N_EXPERTS, D_FF_EXPERT, D_MODEL), D_FF_EXPERT ** -0.5 * DEEPNORM_BETA),
        'ln2_g': 1.0 + nrm(ks[16], (DEPTH, D_MODEL), 0.02),
        'ln2_b': nrm(ks[17], (DEPTH, D_MODEL), 0.02),
    }


def reference(x, meta, ln0_g, ln0_b, w_in, b_gate, sink, w_attn_o, w_four_o, w_out,
              ln1_g, ln1_b, w_router, w_e_gate, w_e_up, w_e_down, ln2_g, ln2_b):
    B = x.shape[0]
    m = jnp.broadcast_to(meta[None].astype(x.dtype), (B, N_META, D_MODEL))
    h = layer_norm(jnp.concatenate([m, x], axis=1), ln0_g, ln0_b)
    for l in range(DEPTH):
        mix = hybrid_mixer(h, w_in[l], b_gate[l], sink[l], w_attn_o[l], w_four_o[l], w_out[l])
        h = layer_norm(DEEPNORM_ALPHA * h + mix, ln1_g[l], ln1_b[l])
        ffn = expert_choice_moe(h, w_router[l], w_e_gate[l], w_e_up[l], w_e_down[l])
        h = layer_norm(DEEPNORM_ALPHA * h + ffn, ln2_g[l], ln2_b[l])
    return h[:, N_META:]
```

```cpp
#include <hip/hip_runtime.h>
#include <cstdio>
#include <cstdint>

#ifndef MK_DEBUG
#define MK_DEBUG 0
#endif

#define LAS __attribute__((address_space(3)))
#define GAS __attribute__((address_space(1)))
typedef unsigned short bf16_t;
typedef short bf16x8 __attribute__((ext_vector_type(8)));
typedef short s16x4 __attribute__((ext_vector_type(4)));
typedef float f32x4 __attribute__((ext_vector_type(4)));
typedef float f32x16 __attribute__((ext_vector_type(16)));
typedef unsigned u32x4 __attribute__((ext_vector_type(4)));
typedef unsigned u32x2 __attribute__((ext_vector_type(2)));
typedef float f32x2_t __attribute__((ext_vector_type(2)));
typedef __bf16 bf16x2_t __attribute__((ext_vector_type(2)));

constexpr int D = 1024, BATCH = 8, SEQ = 4096, DEPTH = 4, NMETA = 16;
constexpr int LSEQ = SEQ + NMETA;
constexpr int T = BATCH * LSEQ;
constexpr int TP = 33024;
constexpr int NH = 8, NKV = 2, HD = 64, AW = 512, FW = 512, INW = 3328;
constexpr int NE = 16, CAP = 514, FF = 1536;
constexpr int ESLOTS = 4352;
constexpr int NSLOT = NE * ESLOTS;
constexpr int DK = 4352, QOFF = 2176;
constexpr int HALFL = LSEQ / 2;
constexpr int VT_LD = 4480, VT_OFF = 128;
constexpr int AFF_LD = 4128;
constexpr float LN_EPS = 1e-5f;
constexpr float ALPHA = 1.681792830507429f;
constexpr float LOG2E = 1.4426950408889634f;
constexpr float QSCALE = 0.125f * LOG2E;

constexpr size_t al(size_t x) { return (x + 4095) & ~(size_t)4095; }
constexpr size_t WS_CTL = 0, CTL_BYTES = 1u << 20;
constexpr size_t WS_WIN = WS_CTL + CTL_BYTES;
constexpr size_t WS_WA = WS_WIN + al((size_t)DEPTH * INW * D * 2);
constexpr size_t WS_WF = WS_WA + al((size_t)DEPTH * D * AW * 2);
constexpr size_t WS_WOUT = WS_WF + al((size_t)DEPTH * D * FW * 2);
constexpr size_t WS_WGU = WS_WOUT + al((size_t)DEPTH * D * D * 2);
constexpr size_t WS_WD = WS_WGU + al((size_t)DEPTH * NE * 2 * FF * D * 2);
constexpr size_t WS_DFTM = WS_WD + al((size_t)DEPTH * NE * D * FF * 2);
constexpr size_t WS_CSM = WS_DFTM + al((size_t)DK * DK * 2);
constexpr size_t WS_H = WS_CSM + al(256 * 256 * 2);
constexpr size_t WS_HB = WS_H + al((size_t)TP * D * 4);
constexpr size_t WS_VT = WS_HB + al((size_t)TP * D * 2);
constexpr size_t WS_ROWIDX = WS_VT + al((size_t)BATCH * NKV * HD * VT_LD * 2);
constexpr size_t WS_GATE = WS_ROWIDX + al((size_t)NSLOT * 4);
constexpr size_t WS_TMP = WS_GATE + al((size_t)NSLOT * 4);
constexpr size_t WS_Q = WS_TMP;
constexpr size_t WS_KB = WS_Q + al((size_t)TP * AW * 2);
constexpr size_t WS_UF = WS_KB + al((size_t)TP * 128 * 2);
constexpr size_t WS_G = WS_UF + al((size_t)TP * FW * 2 + 4096);
constexpr size_t WS_ATT = WS_G + al((size_t)TP * 2 * D * 2);
constexpr size_t WS_PQT = WS_ATT + al((size_t)TP * AW * 2);
constexpr size_t WS_FOUR = WS_PQT + al((size_t)4096 * DK * 2);
constexpr size_t WS_P1 = WS_FOUR + al((size_t)TP * FW * 2);
constexpr size_t WS_MG = WS_P1 + al((size_t)TP * D * 2);
constexpr size_t WS_MIX_END = WS_MG + al((size_t)TP * D * 2);
constexpr size_t WS_AFFT = WS_TMP;
constexpr size_t WS_SLOTMAP = WS_AFFT + al((size_t)BATCH * NE * AFF_LD * 4);
constexpr size_t WS_HID = WS_SLOTMAP + al((size_t)T * NE * 4);
constexpr size_t WS_Y = WS_HID + al((size_t)NSLOT * FF * 2);
constexpr size_t WS_MOE_END = WS_Y + al((size_t)NSLOT * D * 2);
constexpr size_t WS_END = (WS_MIX_END > WS_MOE_END ? WS_MIX_END : WS_MOE_END);
static_assert(WS_END <= (size_t)1536 * 1024 * 1024, "d_ws map exceeds the guaranteed workspace");

constexpr int CW_BAR = 4096;
constexpr int CW_ERR = 1024;

constexpr int RING_BYTES = 131072;
constexpr int IDXTAB_OFF = RING_BYTES;
constexpr int IDXTAB_UNITS = 14;
constexpr int MISC_OFF = IDXTAB_OFF + IDXTAB_UNITS * 1024;
constexpr int LDS_BYTES = 147456;
static_assert(MISC_OFF + 256 <= LDS_BYTES, "LDS map");

#define LDS_WAIT() asm volatile("s_waitcnt lgkmcnt(0)" ::: "memory")
#define VM_WAIT() asm volatile("s_waitcnt vmcnt(0)" ::: "memory")
__device__ __forceinline__ unsigned cvtpk(float lo, float hi) { f32x2_t v = {lo, hi}; bf16x2_t b = __builtin_convertvector(v, bf16x2_t); return __builtin_bit_cast(unsigned, b); }
__device__ __forceinline__ bf16_t f2bf(float f) { return (bf16_t)(cvtpk(f, 0.f) & 0xffffu); }
__device__ __forceinline__ float bf2f(unsigned b) { return __uint_as_float(b << 16); }
__device__ __forceinline__ float bflo(unsigned w) { return __uint_as_float(w << 16); }
__device__ __forceinline__ float bfhi(unsigned w) { return __uint_as_float(w & 0xffff0000u); }
__device__ __forceinline__ float fast_sigmoid(float x) { return __builtin_amdgcn_rcpf(1.0f + __builtin_amdgcn_exp2f(-LOG2E * x)); }
__device__ __forceinline__ float wave_sum(float v) {
#pragma unroll
    for (int o = 1; o < 64; o <<= 1) v += __shfl_xor(v, o);
    return v;
}

#define XB_TMO      128
#define XB_XCNT(j)  (256  + 64 * (j))
#define XB_XSUB(j)  (1280 + 64 * (j))
#define XB_XGEN(j)  (2304 + 64 * (j))
#define XB_TOP      3328
#define XB_TOPGEN   3392
#define XCD_BAR_WORDS 3456
#define XB_SPIN_CAP (1u << 18)
__device__ __forceinline__ unsigned xb_ld(unsigned* p)              { return __hip_atomic_load(p, __ATOMIC_RELAXED, __HIP_MEMORY_SCOPE_AGENT); }
__device__ __forceinline__ unsigned xb_add(unsigned* p, unsigned v) { return __hip_atomic_fetch_add(p, v, __ATOMIC_RELAXED, __HIP_MEMORY_SCOPE_AGENT); }
__device__ __forceinline__ unsigned xb_xcc_id() { return (unsigned)__builtin_amdgcn_s_getreg((3 << 11) | 20) & 0xFu; }
#define XB_SPIN(cond, bar) do { unsigned _sp = 0; while (cond) { __builtin_amdgcn_s_sleep(1); \
    if ((++_sp & 255u) == 0u) { if (xb_ld(&(bar)[XB_TMO])) break; if (_sp > XB_SPIN_CAP) { atomicAdd(&(bar)[XB_TMO], 1u); break; } } } } while (0)
struct XcdBarrier { unsigned* bar; unsigned x; volatile LAS unsigned* st; };
__device__ __forceinline__ XcdBarrier xcd_barrier_post(unsigned* bar, volatile LAS unsigned* st) {
    XcdBarrier b; b.bar = bar; b.x = (unsigned)__builtin_amdgcn_readfirstlane((int)xb_xcc_id()); b.st = st;
    if (threadIdx.x == 0) (void)xb_add(&bar[XB_XCNT(b.x)], 1u);
    return b;
}
__device__ __forceinline__ void xcd_barrier_complete(unsigned* bar, unsigned x, unsigned& nloc, unsigned& nx) {
    const unsigned G = gridDim.x * gridDim.y * gridDim.z;
    unsigned sum, cnt, mine, sp = 0u;
    for (;;) {
        sum = 0u; cnt = 0u; mine = 0u;
#pragma unroll
        for (unsigned j = 0; j < 16; ++j) { const unsigned c = xb_ld(&bar[XB_XCNT(j)]); sum += c; cnt += (c > 0u) ? 1u : 0u; mine = (j == x) ? c : mine; }
        if (sum == G) break;
        __builtin_amdgcn_s_sleep(1);
        if ((++sp & 255u) == 0u) { if (xb_ld(&bar[XB_TMO])) break; if (sp > XB_SPIN_CAP) { atomicAdd(&bar[XB_TMO], 1u); break; } }
    }
    nloc = mine > 0u ? mine : 1u; nx = cnt > 0u ? cnt : 1u;
}
__device__ __forceinline__ void xcd_barrier(const XcdBarrier& b) {
    asm volatile("s_waitcnt vmcnt(0)" ::: "memory");
    __syncthreads();
    if (threadIdx.x == 0) {
        unsigned* bar = b.bar; unsigned bx = b.x; asm volatile("" : "+s"(bx));
        __builtin_amdgcn_s_waitcnt(0);
        unsigned nloc = b.st[0], nx = b.st[1];
        if (nloc == 0u) { xcd_barrier_complete(bar, bx, nloc, nx); b.st[0] = nloc; b.st[1] = nx; }
        const unsigned old = xb_add(&bar[XB_XSUB(bx)], 1u);
        const unsigned gen = old / nloc;
        if (old + 1u == (gen + 1u) * nloc) {
            __builtin_amdgcn_fence(__ATOMIC_RELEASE, "agent");
            asm volatile("s_waitcnt vmcnt(0)" ::: "memory");
            const unsigned og = xb_add(&bar[XB_TOP], 1u);
            const unsigned tg = og / nx;
            if (og + 1u == (tg + 1u) * nx) xb_add(&bar[XB_TOPGEN], 1u);
            else XB_SPIN(xb_ld(&bar[XB_TOPGEN]) == tg, bar);
            __builtin_amdgcn_fence(__ATOMIC_ACQUIRE, "agent");
            xb_add(&bar[XB_XGEN(bx)], 1u);
            asm volatile("s_waitcnt vmcnt(0)" ::: "memory");
        } else {
            XB_SPIN(xb_ld(&bar[XB_XGEN(bx)]) == gen, bar);
            __builtin_amdgcn_fence(__ATOMIC_ACQUIRE, "agent");
            asm volatile("s_waitcnt vmcnt(0)" ::: "memory");
        }
    }
    __syncthreads();
}

namespace pg8 {
constexpr int BM = 256, BK = 64, HALF = 128, HTB = HALF * BK * 2, STAGE_BYTES = 8 * HTB, NXCD = 8, WGM = 8;
__host__ __device__ __forceinline__ int lds_byte(int r, int c) { const int st = (r >> 4) * 2 + (c >> 5), rr = r & 15, cc = c & 31, ob = rr * 64 + cc * 2; return st * 1024 + (ob ^ (((ob >> 9) & 1) << 5)); }
__host__ __device__ __forceinline__ void stage_rc(int b, int& R, int& C) { const int st = b / 1024, sb = b % 1024, swz = sb ^ (((sb >> 9) & 1) << 5); R = (st >> 1) * 16 + swz / 64; C = (st & 1) * 32 + (swz % 64) / 2; }
__host__ __device__ __forceinline__ int perm32(int rho) { const int n = rho >> 4, i = rho & 15; return 8 * (i >> 2) + 4 * n + (i & 3); }

struct Unit { int pm, pn; const char* A; const char* B; };

struct TileOrder {
    int nM, nN, nwg, G, c;
    __device__ __forceinline__ void init(int nM_, int nN_, int G_, int c_) { nM = nM_; nN = nN_; nwg = nM * nN; G = G_; c = c_; }
    __device__ __forceinline__ bool tile(int i, int& pm, int& pn) const {
        const long L = (long)i * G + c; if (L >= nwg) return false;
        int wgid = (int)L; { const int q = nwg / NXCD, r = nwg % NXCD, xcd = wgid % NXCD, off = wgid / NXCD; wgid = (xcd < r ? xcd * (q + 1) : r * (q + 1) + (xcd - r) * q) + off; }
        const int nig = WGM * nN, gid = wgid / nig, fm = gid * WGM, gsz = (nM - fm) < WGM ? (nM - fm) : WGM;
        pm = fm + ((wgid % nig) % gsz); pn = (wgid % nig) / gsz; return true;
    }
};

template <class Epi, class Sched, bool ALIGN_EPI>
__device__ __forceinline__ void gemm_phase(LAS unsigned char* lds, const Sched& S, const Epi& E, const int K, const int ldb) {
    int tid_ = threadIdx.x; asm volatile("" : "+v"(tid_));
    const int tid = tid_, wid = __builtin_amdgcn_readfirstlane(tid >> 6), lane = tid & 63, wr = wid >> 2, wc = wid & 3, fr = lane & 15, fq = lane >> 4;
    int nt = K / BK; asm volatile("" : "+s"(nt));
    int sR[2], sC[2]; unsigned voffB[2];
#pragma unroll
    for (int i = 0; i < 2; ++i) { stage_rc(tid * 16 + i * 8192, sR[i], sC[i]); const int Rb = Epi::PERM ? ((sR[i] & ~31) + perm32(sR[i] & 31)) : sR[i];
        voffB[i] = (unsigned)(Rb * ldb + sC[i]) * 2u; }
    const size_t kstep = (size_t)(BK * 2);
    const size_t hstepB = (size_t)HALF * ldb * 2;
    unsigned voffA[2]; size_t hstepA = 0;
    if constexpr (!Sched::GATHER) { hstepA = (size_t)HALF * S.lda * 2;
#pragma unroll
        for (int i = 0; i < 2; ++i) voffA[i] = (unsigned)(sR[i] * S.lda + sC[i]) * 2u; }
    const unsigned ldsw = (unsigned)wid * 1024u;
    const int aoff = lds_byte(wr * 64 + fr, fq * 8), boff = lds_byte(wc * 32 + fr, fq * 8);
#define PG8_SA(b, h) (((b) * 2 + (h)) * HTB)
#define PG8_SB(b, h) ((4 + (b) * 2 + (h)) * HTB)
#define PG8_STAGE(bufoff, gbase, voff) do { _Pragma("unroll") for (int _i = 0; _i < 2; ++_i) \
        __builtin_amdgcn_global_load_lds((const unsigned*)((const char*)(gbase) + (voff)[_i]), (LAS unsigned*)(lds + (bufoff) + ldsw + _i * 8192), 16, 0, 0); } while (0)
#define PG8_STAGE_A(bufoff, gbase, h, OFFS) do { if constexpr (Sched::GATHER) PG8_STAGE(bufoff, gbase, OFFS[h]); else PG8_STAGE(bufoff, (gbase) + (h) * hstepA, voffA); } while (0)
#define PG8_LDA(dst, b, h) do { _Pragma("unroll") for (int m = 0; m < 4; ++m) _Pragma("unroll") for (int k = 0; k < 2; ++k) dst[m][k] = *(const LAS bf16x8*)(lds + PG8_SA(b, h) + aoff + m * 2048 + k * 1024); } while (0)
#define PG8_LDB(dst, b, h) do { _Pragma("unroll") for (int n = 0; n < 2; ++n) _Pragma("unroll") for (int k = 0; k < 2; ++k) dst[n][k] = *(const LAS bf16x8*)(lds + PG8_SB(b, h) + boff + n * 2048 + k * 1024); } while (0)
#define PG8_MMA(ai, bj, At, Bt) do { __builtin_amdgcn_s_setprio(1); _Pragma("unroll") for (int m = 0; m < 4; ++m) _Pragma("unroll") for (int n = 0; n < 2; ++n) _Pragma("unroll") for (int k = 0; k < 2; ++k) \
        acc[ai][bj][m][n] = __builtin_amdgcn_mfma_f32_16x16x32_bf16(Bt[n][k], At[m][k], acc[ai][bj][m][n], 0, 0, 0); __builtin_amdgcn_s_setprio(0); } while (0)
#define PG8_WAIT_V(n) asm volatile("s_waitcnt vmcnt(" #n ")" ::: "memory")
#define PG8_WAIT_L(n) asm volatile("s_waitcnt lgkmcnt(" #n ")" ::: "memory")
#define PG8_BAR __builtin_amdgcn_s_barrier()
#define PG8_SCHED __builtin_amdgcn_sched_barrier(0)
    Unit cur, nxt; int ui = 0;
    if (!S.next(0, cur)) return;
    unsigned oA[2][2], noA[2][2];
#pragma unroll
    for (int h = 0; h < 2; ++h)
#pragma unroll
        for (int i = 0; i < 2; ++i) oA[h][i] = Sched::GATHER ? S.aoff(cur, 0, h, sR[i], sC[i]) : 0u;
    f32x4 acc[2][2][4][2];
#pragma unroll
    for (int a = 0; a < 2; ++a)
#pragma unroll
        for (int b = 0; b < 2; ++b)
#pragma unroll
            for (int m = 0; m < 4; ++m)
#pragma unroll
                for (int n = 0; n < 2; ++n) acc[a][b][m][n] = (f32x4){0.f, 0.f, 0.f, 0.f};
    bf16x8 At[4][2], B0[2][2], B1[2][2];
    const char* cA = cur.A; const char* cB = cur.B;
    PG8_STAGE(PG8_SB(0, 0), cB, voffB); PG8_STAGE(PG8_SB(0, 1), cB + hstepB, voffB); PG8_STAGE_A(PG8_SA(0, 0), cA, 0, oA); PG8_STAGE_A(PG8_SA(0, 1), cA, 1, oA);
    if (wr == 1) PG8_BAR;
    PG8_WAIT_V(2); PG8_BAR;
    PG8_STAGE(PG8_SB(1, 0), cB + kstep, voffB); PG8_STAGE_A(PG8_SA(1, 0), cA + kstep, 0, oA); PG8_STAGE(PG8_SB(1, 1), cB + hstepB + kstep, voffB);
    PG8_WAIT_V(6); PG8_BAR;
    for (;;) {
        const bool has_next = S.next(ui + 1, nxt);
        const char* nA = has_next ? nxt.A : cA; const char* nB = has_next ? nxt.B : cB;
#pragma unroll
        for (int h = 0; h < 2; ++h)
#pragma unroll
            for (int i = 0; i < 2; ++i) noA[h][i] = Sched::GATHER ? (has_next ? S.aoff(nxt, ui + 1, h, sR[i], sC[i]) : oA[h][i]) : 0u;
#pragma unroll 1
        for (int t = 0; t < nt; t += 2) {
            const bool last = (t == nt - 2);
            const char* a1 = cA + (size_t)(t + 1) * kstep;
            const char* a2 = last ? nA : cA + (size_t)(t + 2) * kstep; const char* b2 = last ? nB : cB + (size_t)(t + 2) * kstep;
            const char* a3 = a2 + kstep; const char* b3 = b2 + kstep;
            unsigned o2[2][2];
#pragma unroll
            for (int h = 0; h < 2; ++h)
#pragma unroll
                for (int i = 0; i < 2; ++i) o2[h][i] = Sched::GATHER ? (last ? noA[h][i] : oA[h][i]) : 0u;
            PG8_LDB(B0, 0, 0); PG8_LDB(B1, 0, 1); PG8_SCHED; PG8_LDA(At, 0, 0); PG8_STAGE_A(PG8_SA(1, 1), a1, 1, oA);
            PG8_WAIT_V(8); PG8_WAIT_L(0); PG8_BAR; PG8_MMA(0, 0, At, B0); PG8_MMA(0, 1, At, B1); PG8_BAR; PG8_SCHED;
            PG8_LDA(At, 0, 1); PG8_STAGE(PG8_SB(0, 0), b2, voffB); PG8_STAGE(PG8_SB(0, 1), b2 + hstepB, voffB); PG8_STAGE_A(PG8_SA(0, 0), a2, 0, o2);
            PG8_WAIT_V(8); PG8_WAIT_L(0); PG8_BAR; PG8_MMA(1, 0, At, B0); PG8_MMA(1, 1, At, B1); PG8_BAR; PG8_SCHED;
            PG8_LDB(B0, 1, 0); PG8_LDB(B1, 1, 1); PG8_SCHED; PG8_LDA(At, 1, 0); PG8_STAGE_A(PG8_SA(0, 1), a2, 1, o2);
            PG8_WAIT_V(8); PG8_WAIT_L(0); PG8_BAR; PG8_MMA(0, 0, At, B0); PG8_MMA(0, 1, At, B1); PG8_BAR; PG8_SCHED;
            PG8_LDA(At, 1, 1); PG8_STAGE(PG8_SB(1, 0), b3, voffB); PG8_STAGE(PG8_SB(1, 1), b3 + hstepB, voffB); PG8_STAGE_A(PG8_SA(1, 0), a3, 0, o2);
            PG8_WAIT_V(8); PG8_WAIT_L(0); PG8_BAR; PG8_MMA(1, 0, At, B0); PG8_MMA(1, 1, At, B1); PG8_BAR; PG8_SCHED;
        }
        if constexpr (ALIGN_EPI) { if (wr == 0) PG8_BAR; }
        E(acc, cur, wr, wc, fr, fq);
        if (!has_next) break;
#pragma unroll
        for (int a = 0; a < 2; ++a)
#pragma unroll
            for (int b = 0; b < 2; ++b)
#pragma unroll
                for (int m = 0; m < 4; ++m)
#pragma unroll
                    for (int n = 0; n < 2; ++n) acc[a][b][m][n] = (f32x4){0.f, 0.f, 0.f, 0.f};
        cur = nxt; cA = nA; cB = nB; ++ui;
#pragma unroll
        for (int h = 0; h < 2; ++h)
#pragma unroll
            for (int i = 0; i < 2; ++i) oA[h][i] = noA[h][i];
        if constexpr (ALIGN_EPI) { if (wr == 1) PG8_BAR; }
    }
    PG8_WAIT_V(0);
    if constexpr (!ALIGN_EPI) { if (wr == 0) PG8_BAR; }
    PG8_BAR;
#undef PG8_SA
#undef PG8_SB
#undef PG8_STAGE
#undef PG8_STAGE_A
#undef PG8_LDA
#undef PG8_LDB
#undef PG8_MMA
#undef PG8_WAIT_V
#undef PG8_WAIT_L
#undef PG8_BAR
#undef PG8_SCHED
}
}
using pg8::Unit;
using pg8::TileOrder;

struct Frame {
    LAS unsigned char* lds;
    int tid, lane, wave, G, bid;
    const float *x, *meta, *ln0_g, *ln0_b, *w_in, *b_gate, *sink, *w_attn_o, *w_four_o, *w_out, *ln1_g, *ln1_b, *w_router, *w_e_gate, *w_e_up, *w_e_down, *ln2_g, *ln2_b;
    float* out; unsigned char* ws;
};
#define WSP(T_, off) ((T_*)(F.ws + (off)))

struct SchedReg {
    static constexpr bool GATHER = false;
    TileOrder o; const char* A; const char* B; int lda, ldb;
    __device__ __forceinline__ bool next(int i, Unit& u) const { int pm, pn; if (!o.tile(i, pm, pn)) return false; u.pm = pm; u.pn = pn;
        u.A = A + (size_t)pm * 256 * lda * 2; u.B = B + (size_t)pn * 256 * ldb * 2; return true; }
    __device__ __forceinline__ unsigned aoff(const Unit&, int, int h, int R, int C) const { return (unsigned)((h * 128 + R) * lda + C) * 2u; }
};
struct SchedDown {
    static constexpr bool GATHER = false; static constexpr int lda = FF;
    TileOrder o; const char* HID; const char* WD;
    __device__ __forceinline__ bool next(int i, Unit& u) const { int pm, pn; if (!o.tile(i, pm, pn)) return false; u.pm = pm; u.pn = pn; const int e = pm / 17;
        u.A = HID + (size_t)pm * 256 * FF * 2; u.B = WD + ((size_t)e * D + (size_t)pn * 256) * FF * 2; return true; }
    __device__ __forceinline__ unsigned aoff(const Unit&, int, int h, int R, int C) const { return (unsigned)((h * 128 + R) * FF + C) * 2u; }
};
struct SchedGU {
    static constexpr bool GATHER = true; static constexpr int lda = D;
    TileOrder o; const char* HB; const char* WGU; const LAS int* idxtab;
    __device__ __forceinline__ bool next(int i, Unit& u) const { int pm, pn; if (!o.tile(i, pm, pn)) return false; u.pm = pm; u.pn = pn; const int e = pm / 17;
        u.A = HB; u.B = WGU + ((size_t)e * (2 * FF) + (size_t)pn * 256) * D * 2; return true; }
    __device__ __forceinline__ unsigned aoff(const Unit&, int i, int h, int R, int C) const { return (unsigned)idxtab[i * 256 + h * 128 + R] * (unsigned)(D * 2) + (unsigned)C * 2u; }
};
struct SchedChan {
    static constexpr bool GATHER = true; static constexpr int lda = FW;
    TileOrder o; const char* UF; const char* CSM;
    __device__ __forceinline__ bool next(int i, Unit& u) const { int pm, pn; if (!o.tile(i, pm, pn)) return false; u.pm = pm; u.pn = 0; const int bg = pm / 17, g = bg & 3, b = bg >> 2;
        u.A = UF + ((size_t)b * LSEQ * FW + (size_t)g * 128) * 2; u.B = CSM; return true; }
    __device__ __forceinline__ unsigned aoff(const Unit& u, int, int h, int R, int C) const { const int lt = u.pm % 17, l = lt * 128 + R; int tok = h ? LSEQ - l : l; if (tok >= LSEQ) tok = 0;
        return (unsigned)(tok * FW + C) * 2u; }
};

typedef const f32x4 (&AccRef)[2][2][4][2];
__device__ __forceinline__ u32x4 pack8(const f32x4 a, const f32x4 b) { u32x4 w; w.x = cvtpk(a[0], a[1]); w.y = cvtpk(a[2], a[3]); w.z = cvtpk(b[0], b[1]); w.w = cvtpk(b[2], b[3]); return w; }

struct EpiInProj {
    static constexpr bool PERM = true;
    bf16_t *Q, *KB, *VT, *UF, *G; const float* bgate;
    __device__ __forceinline__ void operator()(AccRef acc, const Unit& u, int wr, int wc, int fr, int fq) const {
        const int pn = u.pn, rbase = u.pm * 256 + wr * 64 + fr, c8 = wc * 32 + 8 * fq;
#pragma unroll
        for (int ai = 0; ai < 2; ++ai)
#pragma unroll
            for (int m = 0; m < 4; ++m) { const int row = rbase + ai * 128 + m * 16; if (row >= T) continue;
#pragma unroll
                for (int bj = 0; bj < 2; ++bj) { f32x4 v0 = acc[ai][bj][m][0], v1 = acc[ai][bj][m][1]; const int colt = bj * 128 + c8;
                    if (pn < 2) { v0 = v0 * QSCALE; v1 = v1 * QSCALE; *(u32x4*)(Q + (size_t)row * AW + pn * 256 + colt) = pack8(v0, v1); }
                    else if (pn == 2) {
                        if (bj == 0) { *(u32x4*)(KB + (size_t)row * 128 + c8) = pack8(v0, v1); }
                        else { const int b = row / LSEQ, p = row - b * LSEQ; const int kvh = c8 >> 6, d0 = c8 & 63;
                            bf16_t* vp = VT + ((size_t)((b * NKV + kvh) * HD + d0)) * VT_LD + VT_OFF + p;
#pragma unroll
                            for (int j = 0; j < 4; ++j) { vp[(size_t)j * VT_LD] = f2bf(v0[j]); vp[(size_t)(4 + j) * VT_LD] = f2bf(v1[j]); } } }
                    else if (pn < 5) { *(u32x4*)(UF + (size_t)row * FW + (pn - 3) * 256 + colt) = pack8(v0, v1); }
                    else { const int gc = (pn - 5) * 256 + colt; const f32x4 b0 = *(const f32x4*)(bgate + gc), b1 = *(const f32x4*)(bgate + gc + 4);
#pragma unroll
                        for (int j = 0; j < 4; ++j) { v0[j] = fast_sigmoid(v0[j] + b0[j]); v1[j] = fast_sigmoid(v1[j] + b1[j]); }
                        *(u32x4*)(G + (size_t)row * (2 * D) + gc) = pack8(v0, v1); } } }
    }
};
struct EpiChan {
    static constexpr bool PERM = false;
    bf16_t* PQT;
    __device__ __forceinline__ void operator()(AccRef acc, const Unit& u, int wr, int wc, int fr, int fq) const {
        const int lt = u.pm % 17, bg = u.pm / 17, lb = lt * 128 + wr * 64 + fr;
        bf16_t* base = PQT + (size_t)(bg * 128 + wc * 32 + 4 * fq) * DK + lb;
#pragma unroll
        for (int n = 0; n < 2; ++n)
#pragma unroll
            for (int i = 0; i < 4; ++i) { bf16_t* dst = base + (size_t)(16 * n + i) * DK;
#pragma unroll
                for (int m = 0; m < 4; ++m) { const int l = lb + 16 * m; const bool pair = (l >= 1 && l <= HALFL - 1), own = (l <= HALFL);
                    float pe = own ? acc[0][0][m][n][i] : 0.f; float qo = 0.f;
                    if (pair) { pe += acc[1][0][m][n][i]; qo = acc[0][1][m][n][i] - acc[1][1][m][n][i]; }
                    dst[16 * m] = f2bf(pe); dst[QOFF + 16 * m] = f2bf(qo); }
                __builtin_amdgcn_sched_barrier(0); }
    }
};
struct EpiSeq {
    static constexpr bool PERM = true;
    bf16_t* FOUR;
    __device__ __forceinline__ void operator()(AccRef acc, const Unit& u, int wr, int wc, int fr, int fq) const {
#pragma unroll
        for (int ai = 0; ai < 2; ++ai)
#pragma unroll
            for (int m = 0; m < 4; ++m) { const int k = u.pm * 256 + ai * 128 + wr * 64 + 16 * m + fr; if (k >= LSEQ) continue;
#pragma unroll
                for (int bj = 0; bj < 2; ++bj) { const int n = u.pn * 256 + bj * 128 + wc * 32 + 8 * fq, b = n >> 9, cc = n & 511;
                    *(u32x4*)(FOUR + (size_t)(b * LSEQ + k) * FW + cc) = pack8(acc[ai][bj][m][0], acc[ai][bj][m][1]); } }
    }
};
__device__ __forceinline__ void unpack8(const u32x4 w, f32x4& a, f32x4& b) { a = (f32x4){bflo(w.x), bfhi(w.x), bflo(w.y), bfhi(w.y)}; b = (f32x4){bflo(w.z), bfhi(w.z), bflo(w.w), bfhi(w.w)}; }
struct EpiAttnO {
    static constexpr bool PERM = true;
    bf16_t* P1; const bf16_t* G;
    __device__ __forceinline__ void operator()(AccRef acc, const Unit& u, int wr, int wc, int fr, int fq) const {
#pragma unroll
        for (int ai = 0; ai < 2; ++ai)
#pragma unroll
            for (int m = 0; m < 4; ++m) { const int row = u.pm * 256 + ai * 128 + wr * 64 + 16 * m + fr; if (row >= T) continue;
#pragma unroll
                for (int bj = 0; bj < 2; ++bj) { const int col = u.pn * 256 + bj * 128 + wc * 32 + 8 * fq; f32x4 g0, g1; unpack8(*(const u32x4*)(G + (size_t)row * (2 * D) + col), g0, g1);
                    *(u32x4*)(P1 + (size_t)row * D + col) = pack8(acc[ai][bj][m][0] * g0, acc[ai][bj][m][1] * g1); } }
    }
};
struct EpiFourO {
    static constexpr bool PERM = true;
    bf16_t* MG; const bf16_t* P1; const bf16_t* G;
    __device__ __forceinline__ void operator()(AccRef acc, const Unit& u, int wr, int wc, int fr, int fq) const {
#pragma unroll
        for (int ai = 0; ai < 2; ++ai)
#pragma unroll
            for (int m = 0; m < 4; ++m) { const int row = u.pm * 256 + ai * 128 + wr * 64 + 16 * m + fr; if (row >= T) continue;
#pragma unroll
                for (int bj = 0; bj < 2; ++bj) { const int col = u.pn * 256 + bj * 128 + wc * 32 + 8 * fq; f32x4 g0, g1, p0, p1;
                    unpack8(*(const u32x4*)(G + (size_t)row * (2 * D) + D + col), g0, g1); unpack8(*(const u32x4*)(P1 + (size_t)row * D + col), p0, p1);
                    *(u32x4*)(MG + (size_t)row * D + col) = pack8(p0 + acc[ai][bj][m][0] * g0, p1 + acc[ai][bj][m][1] * g1); } }
    }
};
struct EpiWout {
    static constexpr bool PERM = false;
    float* H;
    __device__ __forceinline__ void operator()(AccRef acc, const Unit& u, int wr, int wc, int fr, int fq) const {
#pragma unroll
        for (int ai = 0; ai < 2; ++ai)
#pragma unroll
            for (int m = 0; m < 4; ++m) { const int row = u.pm * 256 + ai * 128 + wr * 64 + 16 * m + fr; if (row >= T) continue;
#pragma unroll
                for (int bj = 0; bj < 2; ++bj)
#pragma unroll
                    for (int n = 0; n < 2; ++n) { float* p = H + (size_t)row * D + u.pn * 256 + bj * 128 + wc * 32 + 16 * n + 4 * fq;
                        const f32x4 h = *(const f32x4*)p; *(f32x4*)p = h * ALPHA + acc[ai][bj][m][n]; } }
    }
};
struct EpiGU {
    static constexpr bool PERM = true;
    bf16_t* HID;
    __device__ __forceinline__ void operator()(AccRef acc, const Unit& u, int wr, int wc, int fr, int fq) const {
#pragma unroll
        for (int ai = 0; ai < 2; ++ai)
#pragma unroll
            for (int m = 0; m < 4; ++m) { const int row = u.pm * 256 + ai * 128 + wr * 64 + 16 * m + fr; f32x4 o[2];
#pragma unroll
                for (int n = 0; n < 2; ++n)
#pragma unroll
                    for (int j = 0; j < 4; ++j) { const float a = acc[ai][0][m][n][j]; o[n][j] = a * fast_sigmoid(a) * acc[ai][1][m][n][j]; }
                *(u32x4*)(HID + (size_t)row * FF + u.pn * 128 + wc * 32 + 8 * fq) = pack8(o[0], o[1]); }
    }
};
struct EpiDown {
    static constexpr bool PERM = true;
    bf16_t* Y; const float* GATE;
    __device__ __forceinline__ void operator()(AccRef acc, const Unit& u, int wr, int wc, int fr, int fq) const {
#pragma unroll
        for (int ai = 0; ai < 2; ++ai)
#pragma unroll
            for (int m = 0; m < 4; ++m) { const int row = u.pm * 256 + ai * 128 + wr * 64 + 16 * m + fr; const float g = GATE[row];
#pragma unroll
                for (int bj = 0; bj < 2; ++bj) { const int col = u.pn * 256 + bj * 128 + wc * 32 + 8 * fq;
                    *(u32x4*)(Y + (size_t)row * D + col) = pack8(acc[ai][bj][m][0] * g, acc[ai][bj][m][1] * g); } }
    }
};

__device__ __forceinline__ void transpose_item(const float* W, int K, int N, int k0, int n0, bf16_t* WT, int drow0, LAS float* scr, int lane) {
#pragma unroll 8
    for (int kk = 0; kk < 64; ++kk) scr[kk * 65 + lane] = W[(size_t)(k0 + kk) * N + n0 + lane];
    LDS_WAIT(); asm volatile("" ::: "memory");
    const int c = lane & 7;
#pragma unroll
    for (int j = 0; j < 8; ++j) { const int n = (lane >> 3) + 8 * j; const LAS float* s = scr + (8 * c) * 65 + n;
        u32x4 o; o.x = cvtpk(s[0 * 65], s[1 * 65]); o.y = cvtpk(s[2 * 65], s[3 * 65]); o.z = cvtpk(s[4 * 65], s[5 * 65]); o.w = cvtpk(s[6 * 65], s[7 * 65]);
        *(u32x4*)(WT + (size_t)(drow0 + n) * K + k0 + 8 * c) = o; }
    LDS_WAIT(); asm volatile("" ::: "memory");
}
__device__ __forceinline__ void ln_row(f32x4 (&v)[4], const f32x4 (&gm)[4], const f32x4 (&bt)[4]) {
    float s = 0.f;
#pragma unroll
    for (int j = 0; j < 4; ++j) s += (v[j][0] + v[j][1]) + (v[j][2] + v[j][3]);
    const float mean = wave_sum(s) * (1.f / D); float s2 = 0.f;
#pragma unroll
    for (int j = 0; j < 4; ++j) { v[j] = v[j] - mean; s2 += (v[j][0] * v[j][0] + v[j][1] * v[j][1]) + (v[j][2] * v[j][2] + v[j][3] * v[j][3]); }
    const float rstd = 1.0f / sqrtf(wave_sum(s2) * (1.f / D) + LN_EPS);
#pragma unroll
    for (int j = 0; j < 4; ++j) v[j] = v[j] * rstd * gm[j] + bt[j];
}
__device__ __forceinline__ void store_row(const f32x4 (&v)[4], float* hrow, bf16_t* hbrow, int lane) {
#pragma unroll
    for (int j = 0; j < 4; ++j) { *(f32x4*)(hrow + 4 * lane + 256 * j) = v[j]; u32x2 w; w.x = cvtpk(v[j][0], v[j][1]); w.y = cvtpk(v[j][2], v[j][3]); *(u32x2*)(hbrow + 4 * lane + 256 * j) = w; }
}

__device__ __forceinline__ void p0_prologue(Frame& F) {
    const int gw = F.bid * 8 + F.wave, NGW = F.G * 8, gt = F.bid * 512 + F.tid, NGT = F.G * 512;
    {
        LAS float* scr = (LAS float*)(F.lds + F.wave * 16640);
        constexpr int I_IN = 16 * 52, I_A = 8 * 16, I_O = 16 * 16, I_E = 16 * 24  , I_D = 24 * 16  ;
        constexpr int PER_LAYER = I_IN + 2 * I_A + I_O + NE * (2 * I_E + I_D);
        for (int it = gw; it < DEPTH * PER_LAYER; it += NGW) {
            const int l = it / PER_LAYER; int r = it % PER_LAYER;
            if (r < I_IN) { const int kb = r / 52, nb = r % 52; transpose_item(F.w_in + (size_t)l * D * INW, D, INW, kb * 64, nb * 64, WSP(bf16_t, WS_WIN) + (size_t)l * INW * D, nb * 64, scr, F.lane); continue; } r -= I_IN;
            if (r < I_A) { const int kb = r / 16, nb = r % 16; transpose_item(F.w_attn_o + (size_t)l * AW * D, AW, D, kb * 64, nb * 64, WSP(bf16_t, WS_WA) + (size_t)l * D * AW, nb * 64, scr, F.lane); continue; } r -= I_A;
            if (r < I_A) { const int kb = r / 16, nb = r % 16; transpose_item(F.w_four_o + (size_t)l * FW * D, FW, D, kb * 64, nb * 64, WSP(bf16_t, WS_WF) + (size_t)l * D * FW, nb * 64, scr, F.lane); continue; } r -= I_A;
            if (r < I_O) { const int kb = r / 16, nb = r % 16; transpose_item(F.w_out + (size_t)l * D * D, D, D, kb * 64, nb * 64, WSP(bf16_t, WS_WOUT) + (size_t)l * D * D, nb * 64, scr, F.lane); continue; } r -= I_O;
            const int e = r / (2 * I_E + I_D); r %= (2 * I_E + I_D);
            if (r < 2 * I_E) { const int up = r / I_E; r %= I_E; const int kb = r / 24, nb = r % 24, n0 = nb * 64;
                const float* W = (up ? F.w_e_up : F.w_e_gate) + ((size_t)l * NE + e) * D * FF;
                transpose_item(W, D, FF, kb * 64, n0, WSP(bf16_t, WS_WGU) + ((size_t)l * NE + e) * (2 * FF) * D, (n0 >> 7) * 256 + up * 128 + (n0 & 127), scr, F.lane); continue; }
            r -= 2 * I_E;
            { const int kb = r / 16, nb = r % 16; transpose_item(F.w_e_down + ((size_t)l * NE + e) * FF * D, FF, D, kb * 64, nb * 64, WSP(bf16_t, WS_WD) + ((size_t)l * NE + e) * D * FF, nb * 64, scr, F.lane); }
        }
    }
    {
        const float sc = 1.0f / sqrtf(128.0f * (float)LSEQ), invL = 1.0f / (float)LSEQ;
        bf16_t* M = WSP(bf16_t, WS_DFTM);
        for (int ch = gt; ch < DK * (DK / 8); ch += NGT) { const int k = ch / (DK / 8), j0 = (ch % (DK / 8)) * 8; float v[8];
#pragma unroll
            for (int jj = 0; jj < 8; ++jj) { const int j = j0 + jj; float val = 0.f;
                if (k < LSEQ) { if (j <= HALFL) val = __builtin_amdgcn_cosf((float)((k * j) % LSEQ) * invL) * sc;
                                else if (j >= QOFF && j - QOFF <= HALFL) val = -__builtin_amdgcn_sinf((float)((k * (j - QOFF)) % LSEQ) * invL) * sc; }
                v[jj] = val; }
            u32x4 o; o.x = cvtpk(v[0], v[1]); o.y = cvtpk(v[2], v[3]); o.z = cvtpk(v[4], v[5]); o.w = cvtpk(v[6], v[7]);
            *(u32x4*)(M + (size_t)k * DK + j0) = o; }
        bf16_t* C = WSP(bf16_t, WS_CSM);
        for (int idx = gt; idx < 256 * 256; idx += NGT) { const int n = idx >> 8, c = idx & 255; float val = 0.f;
            if (c < 128) { const float ph = (float)(((n & 127) * c) & 127) * (1.0f / 128.0f); val = (n < 128) ? __builtin_amdgcn_cosf(ph) : __builtin_amdgcn_sinf(ph); }
            C[idx] = f2bf(val); }
    }
    {
        u32x4 z = {0u, 0u, 0u, 0u};
        u32x4* vt = WSP(u32x4, WS_VT); for (int i = gt; i < (int)((size_t)BATCH * NKV * HD * VT_LD * 2 / 16); i += NGT) vt[i] = z;
        u32x4* ri = WSP(u32x4, WS_ROWIDX); for (int i = gt; i < NSLOT * 4 / 16; i += NGT) ri[i] = z;
        u32x4* ga = WSP(u32x4, WS_GATE); for (int i = gt; i < NSLOT * 4 / 16; i += NGT) ga[i] = z;
        u32x4* hp = (u32x4*)(WSP(bf16_t, WS_HB) + (size_t)T * D); for (int i = gt; i < (TP - T) * D * 2 / 16; i += NGT) hp[i] = z;
    }
    {
        f32x4 gm[4], bt[4];
#pragma unroll
        for (int j = 0; j < 4; ++j) { gm[j] = *(const f32x4*)(F.ln0_g + 4 * F.lane + 256 * j); bt[j] = *(const f32x4*)(F.ln0_b + 4 * F.lane + 256 * j); }
        float* H = WSP(float, WS_H); bf16_t* HB = WSP(bf16_t, WS_HB);
        for (int row = gw; row < T; row += NGW) { const int b = row / LSEQ, p = row - b * LSEQ;
            const float* src = (p < NMETA) ? F.meta + (size_t)p * D : F.x + ((size_t)b * SEQ + (p - NMETA)) * D;
            f32x4 v[4];
#pragma unroll
            for (int j = 0; j < 4; ++j) v[j] = *(const f32x4*)(src + 4 * F.lane + 256 * j);
            ln_row(v, gm, bt); store_row(v, H + (size_t)row * D, HB + (size_t)row * D, F.lane); }
    }
}

__device__ __forceinline__ void attn_phase(Frame& F, int layer) {
    const bf16_t* Q = WSP(bf16_t, WS_Q); const bf16_t* KB = WSP(bf16_t, WS_KB); const bf16_t* VT = WSP(bf16_t, WS_VT); bf16_t* ATT = WSP(bf16_t, WS_ATT);
    LAS unsigned char* Ks = F.lds; LAS unsigned char* Vs = F.lds + 40960;
    int tid_ = F.tid; asm volatile("" : "+v"(tid_)); const int tid = tid_, lane = tid & 63, r32 = lane & 31, hi = lane >> 5, w = F.wave;
    for (int u = F.bid; u < BATCH * NKV * 65; u += F.G) {
        const int qt = u % 65, bk = u / 65, kvh = bk & 1, b = bk >> 1, q0 = qt * 64, kb = q0 - 128;
#pragma unroll
        for (int i = 0; i < 5; ++i) { const int c = tid + 512 * i, row = c >> 3, ch = c & 7; int pos = kb + row; pos = pos < 0 ? 0 : (pos > LSEQ - 1 ? LSEQ - 1 : pos);
            const u32x4 v = *(const u32x4*)(KB + (size_t)(b * LSEQ + pos) * 128 + kvh * 64 + ch * 8);
            *(LAS u32x4*)(Ks + row * 128 + ((ch ^ ((row >> 1) & 7)) << 4)) = v; }
#pragma unroll
        for (int i = 0; i < 5; ++i) { const int c = tid + 512 * i, d = c / 40, ch = c - d * 40;
            const u32x4 v = *(const u32x4*)(VT + (size_t)((b * NKV + kvh) * HD + d) * VT_LD + VT_OFF + kb + ch * 8);
            const int x = (d >> 1) & 15, g0 = 2 * ch;
            *(LAS u32x2*)(Vs + d * 640 + ((g0 ^ x) << 3)) = (u32x2){v.x, v.y};
            *(LAS u32x2*)(Vs + d * 640 + (((g0 + 1) ^ x) << 3)) = (u32x2){v.z, v.w}; }
        __syncthreads();
        {
            const int hq = kvh * 4 + (w >> 1), sub = w & 1, qpos = q0 + 32 * sub + r32, qrow = qpos < LSEQ ? qpos : LSEQ - 1;
            bf16x8 qf[4];
#pragma unroll
            for (int d0 = 0; d0 < 4; ++d0) qf[d0] = *(const bf16x8*)(Q + (size_t)(b * LSEQ + qrow) * AW + hq * 64 + 16 * d0 + 8 * hi);
            const float slope2 = __builtin_amdgcn_exp2f(-(float)(hq + 1)) * LOG2E;
            float mrun = F.sink[layer * NH + hq] * LOG2E, lsum = hi == 0 ? 1.0f : 0.0f;
            f32x16 o0 = {}, o1 = {};
            const int kbase = kb + 4 * hi; const float frel = (float)(kbase - qpos);
            const int sw = (r32 >> 1) & 7;
            LAS unsigned char* kp = Ks + r32 * 128;
            const int x0 = (r32 >> 1) & 15, x1 = ((32 + r32) >> 1) & 15;
            LAS unsigned char* vp0 = Vs + r32 * 640; LAS unsigned char* vp1 = Vs + (32 + r32) * 640;
#pragma unroll 1
            for (int t = 0; t < 5; ++t) {
                f32x16 p0 = {}, p1 = {};
                LAS unsigned char* kt = kp + t * 8192;
#pragma unroll
                for (int d0 = 0; d0 < 4; ++d0) { const int c = 2 * d0 + hi;
                    const bf16x8 kf0 = *(const LAS bf16x8*)(kt + ((c ^ sw) << 4));
                    const bf16x8 kf1 = *(const LAS bf16x8*)(kt + 4096 + ((c ^ sw) << 4));
                    p0 = __builtin_amdgcn_mfma_f32_32x32x16_bf16(kf0, qf[d0], p0, 0, 0, 0);
                    p1 = __builtin_amdgcn_mfma_f32_32x32x16_bf16(kf1, qf[d0], p1, 0, 0, 0); }
                float tmax = -1e30f; const float ft = frel + (float)(64 * t); const int kt0 = kbase + 64 * t;
#pragma unroll
                for (int r = 0; r < 16; ++r) { const int cst = (r & 3) + 8 * (r >> 2);
                    const float d0f = ft + (float)cst, d1f = ft + (float)(cst + 32);
                    const bool v0 = (fabsf(d0f) <= 128.0f) && ((unsigned)(kt0 + cst) < (unsigned)LSEQ);
                    const bool v1 = (fabsf(d1f) <= 128.0f) && ((unsigned)(kt0 + cst + 32) < (unsigned)LSEQ);
                    p0[r] = v0 ? p0[r] - slope2 * fabsf(d0f) : -1e30f; p1[r] = v1 ? p1[r] - slope2 * fabsf(d1f) : -1e30f;
                    tmax = fmaxf(tmax, fmaxf(p0[r], p1[r])); }
                tmax = fmaxf(tmax, __shfl_xor(tmax, 32));
                const float mnew = fmaxf(mrun, tmax), alpha = __builtin_amdgcn_exp2f(mrun - mnew); mrun = mnew;
                lsum *= alpha; o0 = o0 * alpha; o1 = o1 * alpha;
                float ps = 0.f;
#pragma unroll
                for (int r = 0; r < 16; ++r) { p0[r] = __builtin_amdgcn_exp2f(p0[r] - mnew); p1[r] = __builtin_amdgcn_exp2f(p1[r] - mnew); ps += p0[r] + p1[r]; }
                lsum += ps;
                u32x4 pw[4];
                pw[0] = (u32x4){cvtpk(p0[0], p0[1]), cvtpk(p0[2], p0[3]), cvtpk(p0[4], p0[5]), cvtpk(p0[6], p0[7])};
                pw[1] = (u32x4){cvtpk(p0[8], p0[9]), cvtpk(p0[10], p0[11]), cvtpk(p0[12], p0[13]), cvtpk(p0[14], p0[15])};
                pw[2] = (u32x4){cvtpk(p1[0], p1[1]), cvtpk(p1[2], p1[3]), cvtpk(p1[4], p1[5]), cvtpk(p1[6], p1[7])};
                pw[3] = (u32x4){cvtpk(p1[8], p1[9]), cvtpk(p1[10], p1[11]), cvtpk(p1[12], p1[13]), cvtpk(p1[14], p1[15])};
                LAS unsigned char* vt0 = vp0 + t * 128; LAS unsigned char* vt1 = vp1 + t * 128;
#pragma unroll
                for (int ks = 0; ks < 4; ++ks) { const int gl = 4 * ks + hi;
                    { const u32x2 lo = *(const LAS u32x2*)(vt0 + ((gl ^ x0) << 3)), h8 = *(const LAS u32x2*)(vt0 + (((gl + 2) ^ x0) << 3));
                      const u32x4 vf = {lo.x, lo.y, h8.x, h8.y}; o0 = __builtin_amdgcn_mfma_f32_32x32x16_bf16(__builtin_bit_cast(bf16x8, vf), __builtin_bit_cast(bf16x8, pw[ks]), o0, 0, 0, 0); }
                    { const u32x2 lo = *(const LAS u32x2*)(vt1 + ((gl ^ x1) << 3)), h8 = *(const LAS u32x2*)(vt1 + (((gl + 2) ^ x1) << 3));
                      const u32x4 vf = {lo.x, lo.y, h8.x, h8.y}; o1 = __builtin_amdgcn_mfma_f32_32x32x16_bf16(__builtin_bit_cast(bf16x8, vf), __builtin_bit_cast(bf16x8, pw[ks]), o1, 0, 0, 0); } }
            }
            const float ltot = lsum + __shfl_xor(lsum, 32), inv = 1.0f / ltot;
            if (qpos < LSEQ) { bf16_t* orow = ATT + (size_t)(b * LSEQ + qpos) * AW + hq * 64 + 4 * hi;
#pragma unroll
                for (int rq = 0; rq < 4; ++rq) {
                    u32x2 w0; w0.x = cvtpk(o0[4 * rq] * inv, o0[4 * rq + 1] * inv); w0.y = cvtpk(o0[4 * rq + 2] * inv, o0[4 * rq + 3] * inv); *(u32x2*)(orow + 8 * rq) = w0;
                    u32x2 w1; w1.x = cvtpk(o1[4 * rq] * inv, o1[4 * rq + 1] * inv); w1.y = cvtpk(o1[4 * rq + 2] * inv, o1[4 * rq + 3] * inv); *(u32x2*)(orow + 32 + 8 * rq) = w1; } }
        }
        __syncthreads();
    }
}

template <int S> struct RedScat { static __device__ __forceinline__ void run(float (&a)[32], int lane) { const bool up = (lane & S) != 0;
#pragma unroll
    for (int i = 0; i < S; ++i) { const float keep = up ? a[i + S] : a[i], send = up ? a[i] : a[i + S]; a[i] = keep + __shfl_xor(send, S); }
    RedScat<S / 2>::run(a, lane); } };
template <> struct RedScat<0> { static __device__ __forceinline__ void run(float (&)[32], int) {} };
__device__ __forceinline__ void ln1_router_phase(Frame& F, int layer) {
    LAS float* WrL = (LAS float*)F.lds;
    int tid_ = F.tid; asm volatile("" : "+v"(tid_)); const int lane = tid_ & 63;
    { const float* wr = F.w_router + (size_t)layer * D * NE;
      for (int idx = tid_; idx < D * NE; idx += 512) { const int d = idx >> 4, e = idx & 15, ln = (d & 255) >> 2, j = d >> 8, i = d & 3; WrL[ln * 260 + (j * 4 + i) * 16 + e] = wr[idx]; } }
    __syncthreads();
    f32x4 gm[4], bt[4];
#pragma unroll
    for (int j = 0; j < 4; ++j) { gm[j] = *(const f32x4*)(F.ln1_g + (size_t)layer * D + 4 * lane + 256 * j); bt[j] = *(const f32x4*)(F.ln1_b + (size_t)layer * D + 4 * lane + 256 * j); }
    float* H = WSP(float, WS_H); bf16_t* HB = WSP(bf16_t, WS_HB); float* AFFT = WSP(float, WS_AFFT);
    const int gw = F.bid * 8 + F.wave, NGW = F.G * 8;
#pragma unroll 1
    for (int grp = gw; grp < T / 2; grp += NGW) {
        const int row0 = grp * 2;
        f32x4 y[2][4];
#pragma unroll
        for (int tk = 0; tk < 2; ++tk) {
#pragma unroll
            for (int j = 0; j < 4; ++j) y[tk][j] = *(const f32x4*)(H + (size_t)(row0 + tk) * D + 4 * lane + 256 * j);
            ln_row(y[tk], gm, bt); store_row(y[tk], H + (size_t)(row0 + tk) * D, HB + (size_t)(row0 + tk) * D, lane); }
        float acc[32];
#pragma unroll
        for (int i = 0; i < 32; ++i) acc[i] = 0.f;
#pragma unroll
        for (int ji = 0; ji < 16; ++ji) { if ((ji & 1) == 0) asm volatile("" ::: "memory");
            const LAS f32x4* wp = (const LAS f32x4*)(WrL + lane * 260 + ji * 16); const f32x4 w0 = wp[0], w1 = wp[1], w2 = wp[2], w3 = wp[3];
#pragma unroll
            for (int tk = 0; tk < 2; ++tk) { const float yv = y[tk][ji >> 2][ji & 3];
#pragma unroll
                for (int e = 0; e < 4; ++e) { acc[tk * 16 + e] += yv * w0[e]; acc[tk * 16 + 4 + e] += yv * w1[e]; acc[tk * 16 + 8 + e] += yv * w2[e]; acc[tk * 16 + 12 + e] += yv * w3[e]; } } }
#pragma unroll
        for (int i = 0; i < 32; ++i) acc[i] += __shfl_xor(acc[i], 32);
        RedScat<16>::run(acc, lane);
        const float logit = acc[0]; float mx = logit;
#pragma unroll
        for (int o = 1; o < 16; o <<= 1) mx = fmaxf(mx, __shfl_xor(mx, o));
        const float ex = __expf(logit - mx); float sm = ex;
#pragma unroll
        for (int o = 1; o < 16; o <<= 1) sm += __shfl_xor(sm, o);
        if (lane < 32) { const int row = row0 + (lane >> 4), e = lane & 15, b = row / LSEQ, p = row - b * LSEQ;
            AFFT[(size_t)(b * NE + e) * AFF_LD + p] = ex / sm; }
    }
}

__device__ __forceinline__ void topk_phase(Frame& F) {
    LAS unsigned* cnt = (LAS unsigned*)F.lds; LAS unsigned* pre = cnt + 32;
    const float* AFFT = WSP(float, WS_AFFT); int* ROWIDX = WSP(int, WS_ROWIDX); float* GATE = WSP(float, WS_GATE); int* SLOTMAP = WSP(int, WS_SLOTMAP);
    int tid_ = F.tid; asm volatile("" : "+v"(tid_)); const int tid = tid_, lane = tid & 63, wave = F.wave;
    for (int item = F.bid; item < BATCH * NE; item += F.G) {
        const int b = item >> 4, e = item & 15; const float* a = AFFT + (size_t)item * AFF_LD;
        unsigned key[9];
#pragma unroll
        for (int i = 0; i < 9; ++i) { const int p = tid * 9 + i; key[i] = p < LSEQ ? __float_as_uint(a[p]) : 0u; }
        unsigned thr = 0u;
        for (int bit = 30; bit >= 0; --bit) { const unsigned cand = thr | (1u << bit); unsigned c = 0;
#pragma unroll
            for (int i = 0; i < 9; ++i) c += (unsigned)__popcll(__ballot(key[i] >= cand));
            if (lane == 0) cnt[(bit & 1) * 8 + wave] = c;
            __syncthreads();
            unsigned tot = 0;
#pragma unroll
            for (int w2 = 0; w2 < 8; ++w2) tot += cnt[(bit & 1) * 8 + w2];
            if (tot >= (unsigned)CAP) thr = cand; }
        unsigned pg = 0, pe = 0;
#pragma unroll
        for (int i = 0; i < 9; ++i) { pg += key[i] > thr ? 1u : 0u; pe += key[i] == thr ? 1u : 0u; }
        unsigned v = pg | (pe << 16);
#pragma unroll
        for (int o = 1; o < 64; o <<= 1) { const unsigned t2 = __shfl_up(v, o); if (lane >= o) v += t2; }
        if (lane == 63) pre[wave] = v;
        __syncthreads();
        unsigned woff = 0, tot = 0;
#pragma unroll
        for (int w2 = 0; w2 < 8; ++w2) { const unsigned x = pre[w2]; if (w2 < wave) woff += x; tot += x; }
        const unsigned need = (unsigned)CAP - (tot & 0xffffu);
        unsigned excl = v - (pg | (pe << 16)) + woff; unsigned gtb = excl & 0xffffu, eqb = excl >> 16;
#pragma unroll
        for (int i = 0; i < 9; ++i) { const int p = tid * 9 + i; const bool isgt = key[i] > thr, iseq = key[i] == thr, sel = isgt || (iseq && eqb < need);
            if (p < LSEQ) { const int row = b * LSEQ + p; int s = -1;
                if (sel) { s = e * ESLOTS + b * CAP + (int)(gtb + (eqb < need ? eqb : need)); ROWIDX[s] = row; GATE[s] = __uint_as_float(key[i]); }
                SLOTMAP[(size_t)row * NE + e] = s; }
            gtb += isgt ? 1u : 0u; eqb += iseq ? 1u : 0u; }
        __syncthreads();
    }
}

__device__ __forceinline__ void combine_ln2_phase(Frame& F, int layer) {
    int lane_ = F.lane; asm volatile("" : "+v"(lane_)); const int lane = lane_;
    f32x4 gm[4], bt[4];
#pragma unroll
    for (int j = 0; j < 4; ++j) { gm[j] = *(const f32x4*)(F.ln2_g + (size_t)layer * D + 4 * lane + 256 * j); bt[j] = *(const f32x4*)(F.ln2_b + (size_t)layer * D + 4 * lane + 256 * j); }
    float* H = WSP(float, WS_H); bf16_t* HB = WSP(bf16_t, WS_HB); const bf16_t* Y = WSP(bf16_t, WS_Y); const int* SLOTMAP = WSP(int, WS_SLOTMAP);
    const int gw = F.bid * 8 + F.wave, NGW = F.G * 8;
    for (int row = gw; row < T; row += NGW) {
        f32x4 v[4];
#pragma unroll
        for (int j = 0; j < 4; ++j) v[j] = *(const f32x4*)(H + (size_t)row * D + 4 * lane + 256 * j) * ALPHA;
        const int sm = SLOTMAP[(size_t)row * NE + (lane & 15)];
#pragma unroll
        for (int e = 0; e < NE; ++e) { const int s = __builtin_amdgcn_readlane(sm, e);
            if (s >= 0) { const bf16_t* yr = Y + (size_t)s * D + 4 * lane;
#pragma unroll
                for (int j = 0; j < 4; ++j) { const u32x2 w = *(const u32x2*)(yr + 256 * j); v[j] += (f32x4){bflo(w.x), bfhi(w.x), bflo(w.y), bfhi(w.y)}; } } }
        ln_row(v, gm, bt); store_row(v, H + (size_t)row * D, HB + (size_t)row * D, lane);
        if (layer == DEPTH - 1) { const int b = row / LSEQ, p = row - b * LSEQ;
            if (p >= NMETA) { float* o = F.out + ((size_t)b * SEQ + (p - NMETA)) * D;
#pragma unroll
                for (int j = 0; j < 4; ++j) *(f32x4*)(o + 4 * lane + 256 * j) = v[j]; } }
    }
}

#ifndef PHASE_MASK
#define PHASE_MASK 0xFFFF
#endif
#define EN(k) ((PHASE_MASK >> (k)) & 1)
constexpr int PH_PER_LAYER = 10, N_PHASES = 1 + DEPTH * PH_PER_LAYER;
struct Args { const float* in[18]; float* out; unsigned char* ws; int ph_lo, ph_hi; };
template <bool ALL>
__global__ void __launch_bounds__(512, 2) mk_fwd(Args args) {
    extern __shared__ __attribute__((aligned(16))) unsigned char lds_raw[];
    Frame F;
    F.lds = (LAS unsigned char*)lds_raw;
    F.tid = threadIdx.x; F.lane = F.tid & 63; F.wave = __builtin_amdgcn_readfirstlane(F.tid >> 6); F.G = gridDim.x; F.bid = blockIdx.x;
    F.x = args.in[0]; F.meta = args.in[1]; F.ln0_g = args.in[2]; F.ln0_b = args.in[3]; F.w_in = args.in[4]; F.b_gate = args.in[5]; F.sink = args.in[6];
    F.w_attn_o = args.in[7]; F.w_four_o = args.in[8]; F.w_out = args.in[9]; F.ln1_g = args.in[10]; F.ln1_b = args.in[11]; F.w_router = args.in[12];
    F.w_e_gate = args.in[13]; F.w_e_up = args.in[14]; F.w_e_down = args.in[15]; F.ln2_g = args.in[16]; F.ln2_b = args.in[17];
    F.out = args.out; F.ws = args.ws;
    volatile LAS unsigned* MISC = (volatile LAS unsigned*)(F.lds + MISC_OFF);
    if (F.tid < 64) MISC[F.tid] = 0u;
    __syncthreads();
    const int lo = ALL ? 0 : args.ph_lo, hi = ALL ? N_PHASES : args.ph_hi;
    unsigned* ctl = (unsigned*)(F.ws + WS_CTL);
    XcdBarrier bar; bar.bar = ctl + CW_BAR; bar.x = 0; bar.st = nullptr;
    if (hi - lo > 1) bar = xcd_barrier_post(ctl + CW_BAR, MISC + 8);
#define IN(k) (ALL || (lo <= (k) && (k) < hi))
#define SEAM(k) do { if (IN(k) && IN((k) + 1)) xcd_barrier(bar); } while (0)
    LAS unsigned char* ring = F.lds;

    if (EN(0) && IN(0)) { p0_prologue(F); }
    SEAM(0);
    for (int layer = 0; layer < DEPTH; ++layer) {
        const int pb = 1 + layer * PH_PER_LAYER;
        if (EN(1) && IN(pb + 0)) {
            SchedReg S; S.o.init(TP / 256, INW / 256, F.G, F.bid); S.A = (const char*)WSP(bf16_t, WS_HB); S.B = (const char*)(WSP(bf16_t, WS_WIN) + (size_t)layer * INW * D); S.lda = D; S.ldb = D;
            EpiInProj E{WSP(bf16_t, WS_Q), WSP(bf16_t, WS_KB), WSP(bf16_t, WS_VT), WSP(bf16_t, WS_UF), WSP(bf16_t, WS_G), F.b_gate + (size_t)layer * 2 * D};
            pg8::gemm_phase<EpiInProj, SchedReg, true>(ring, S, E, D, D);
        }
        SEAM(pb + 0);
        if (EN(2) && IN(pb + 1)) {
#ifndef NO_ATTN
            attn_phase(F, layer);
#endif
#ifndef NO_CHAN
            SchedChan S; S.o.init(BATCH * 4 * 17, 1, F.G, F.bid); S.UF = (const char*)WSP(bf16_t, WS_UF); S.CSM = (const char*)WSP(bf16_t, WS_CSM);
            EpiChan E{WSP(bf16_t, WS_PQT)};
            pg8::gemm_phase<EpiChan, SchedChan, true>(ring, S, E, 256, 256);
#endif
        }
        SEAM(pb + 1);
        if (EN(3) && IN(pb + 2)) {
            { SchedReg S; S.o.init(DK / 256, 4096 / 256, F.G, F.bid); S.A = (const char*)WSP(bf16_t, WS_DFTM); S.B = (const char*)WSP(bf16_t, WS_PQT); S.lda = DK; S.ldb = DK;
              EpiSeq E{WSP(bf16_t, WS_FOUR)};
              pg8::gemm_phase<EpiSeq, SchedReg, true>(ring, S, E, DK, DK); }
            { SchedReg S; S.o.init(TP / 256, D / 256, F.G, F.bid); S.A = (const char*)WSP(bf16_t, WS_ATT); S.B = (const char*)(WSP(bf16_t, WS_WA) + (size_t)layer * D * AW); S.lda = AW; S.ldb = AW;
              EpiAttnO E{WSP(bf16_t, WS_P1), WSP(bf16_t, WS_G)};
              pg8::gemm_phase<EpiAttnO, SchedReg, true>(ring, S, E, AW, AW); }
        }
        SEAM(pb + 2);
        if (EN(4) && IN(pb + 3)) {
            SchedReg S; S.o.init(TP / 256, D / 256, F.G, F.bid); S.A = (const char*)WSP(bf16_t, WS_FOUR); S.B = (const char*)(WSP(bf16_t, WS_WF) + (size_t)layer * D * FW); S.lda = FW; S.ldb = FW;
            EpiFourO E{WSP(bf16_t, WS_MG), WSP(bf16_t, WS_P1), WSP(bf16_t, WS_G)};
            pg8::gemm_phase<EpiFourO, SchedReg, true>(ring, S, E, FW, FW);
        }
        SEAM(pb + 3);
        if (EN(5) && IN(pb + 4)) {
            SchedReg S; S.o.init(TP / 256, D / 256, F.G, F.bid); S.A = (const char*)WSP(bf16_t, WS_MG); S.B = (const char*)(WSP(bf16_t, WS_WOUT) + (size_t)layer * D * D); S.lda = D; S.ldb = D;
            EpiWout E{WSP(float, WS_H)};
            pg8::gemm_phase<EpiWout, SchedReg, true>(ring, S, E, D, D);
        }
        SEAM(pb + 4);
        if (EN(6) && IN(pb + 5)) { ln1_router_phase(F, layer); }
        SEAM(pb + 5);
        if (EN(7) && IN(pb + 6)) { topk_phase(F); }
        SEAM(pb + 6);
        if (EN(8) && IN(pb + 7)) {
            SchedGU S; S.o.init(NE * 17, (2 * FF) / 256, F.G, F.bid); S.HB = (const char*)WSP(bf16_t, WS_HB); S.WGU = (const char*)(WSP(bf16_t, WS_WGU) + (size_t)layer * NE * (2 * FF) * D);
            LAS int* idxtab = (LAS int*)(F.lds + IDXTAB_OFF); S.idxtab = idxtab;
            const int* ROWIDX = WSP(int, WS_ROWIDX);
            { int t_ = F.tid; asm volatile("" : "+v"(t_));
              for (int i = 0; i < IDXTAB_UNITS; ++i) { int pm, pn; if (!S.o.tile(i, pm, pn)) break; if (t_ < 256) idxtab[i * 256 + t_] = ROWIDX[pm * 256 + t_]; } }
            __syncthreads();
            EpiGU E{WSP(bf16_t, WS_HID)};
            pg8::gemm_phase<EpiGU, SchedGU, true>(ring, S, E, D, D);
        }
        SEAM(pb + 7);
        if (EN(9) && IN(pb + 8)) {
            SchedDown S; S.o.init(NE * 17, D / 256, F.G, F.bid); S.HID = (const char*)WSP(bf16_t, WS_HID); S.WD = (const char*)(WSP(bf16_t, WS_WD) + (size_t)layer * NE * D * FF);
            EpiDown E{WSP(bf16_t, WS_Y), WSP(float, WS_GATE)};
            pg8::gemm_phase<EpiDown, SchedDown, true>(ring, S, E, FF, FF);
        }
        SEAM(pb + 8);
        if (EN(10) && IN(pb + 9)) { combine_ln2_phase(F, layer); }
        SEAM(pb + 9);
    }
#undef IN
#undef SEAM
}


extern "C" void kernel_launch(void* const* d_in, const int* in_sizes, int n_in, void* d_out, int out_size, void* d_ws, size_t ws_size, hipStream_t stream) {
#if MK_DEBUG || defined(MK_PER_PHASE)
    auto MKF = mk_fwd<false>;
#else
    auto MKF = mk_fwd<true>;
#endif
    static int grid = 0;
    if (grid == 0) {
        int dev = 0, cus = 0, per_cu = 0;
        if (hipGetDevice(&dev) != hipSuccess || hipDeviceGetAttribute(&cus, hipDeviceAttributeMultiprocessorCount, dev) != hipSuccess) { fprintf(stderr, "kernel_launch: device query failed\n"); grid = -1; return; }
        if (hipFuncSetAttribute((const void*)MKF, hipFuncAttributeMaxDynamicSharedMemorySize, LDS_BYTES) != hipSuccess) { fprintf(stderr, "kernel_launch: hipFuncSetAttribute failed\n"); grid = -1; return; }
        if (hipOccupancyMaxActiveBlocksPerMultiprocessor(&per_cu, (const void*)MKF, 512, LDS_BYTES) != hipSuccess || per_cu < 1) fprintf(stderr, "kernel_launch: occupancy query reports %d\n", per_cu);
        (void)hipGetLastError();
        if (ws_size < WS_END) fprintf(stderr, "kernel_launch: workspace %zu < %zu\n", ws_size, (size_t)WS_END);
        grid = cus;
    }
    if (grid < 0) return;
    (void)hipMemsetAsync((char*)d_ws + WS_CTL, 0, CTL_BYTES, stream);
    Args a{};
    for (int i = 0; i < 18; ++i) a.in[i] = (const float*)d_in[i];
    a.out = (float*)d_out; a.ws = (unsigned char*)d_ws;
#if MK_DEBUG
    debug_driver(a, grid, stream, out_size);
#elif defined(MK_PER_PHASE)
    for (int p = 0; p < N_PHASES; ++p) { a.ph_lo = p; a.ph_hi = p + 1; hipLaunchKernelGGL(MKF, dim3(grid), dim3(512), LDS_BYTES, stream, a); }
#else
    a.ph_lo = 0; a.ph_hi = N_PHASES;
    hipLaunchKernelGGL(MKF, dim3(grid), dim3(512), LDS_BYTES, stream, a);
#endif
}
```

```cpp
#include <hip/hip_runtime.h>
#include <cstdio>
#include <cstdint>

#ifndef MK_DEBUG
#define MK_DEBUG 0
#endif

#define LAS __attribute__((address_space(3)))
#define GAS __attribute__((address_space(1)))
typedef unsigned short bf16_t;
typedef short bf16x8 __attribute__((ext_vector_type(8)));
typedef int v8i_t __attribute__((ext_vector_type(8)));
typedef int v4i_t __attribute__((ext_vector_type(4)));
typedef short s16x4 __attribute__((ext_vector_type(4)));
typedef float f32x4 __attribute__((ext_vector_type(4)));
typedef float f32x16 __attribute__((ext_vector_type(16)));
typedef unsigned u32x4 __attribute__((ext_vector_type(4)));
typedef unsigned u32x2 __attribute__((ext_vector_type(2)));
typedef float f32x2_t __attribute__((ext_vector_type(2)));
typedef __bf16 bf16x2_t __attribute__((ext_vector_type(2)));

constexpr int D = 1024, BATCH = 8, SEQ = 4096, DEPTH = 4, NMETA = 16;
constexpr int LSEQ = SEQ + NMETA;
constexpr int T = BATCH * LSEQ;
constexpr int TP = 33024;
constexpr int NH = 8, NKV = 2, HD = 64, AW = 512, FW = 512, INW = 3328;
constexpr int NE = 16, CAP = 514, FF = 1536;
constexpr int ESLOTS = 4352;
constexpr int NSLOT = NE * ESLOTS;
constexpr int DK = 4352, QOFF = 2176;
constexpr int HALFL = LSEQ / 2;
constexpr int VT_LD = 4480, VT_OFF = 128;
constexpr int AFF_LD = 4128;
constexpr float LN_EPS = 1e-5f;
constexpr float ALPHA = 1.681792830507429f;
constexpr float LOG2E = 1.4426950408889634f;
#ifndef CONV_P0_LAYERS
#define CONV_P0_LAYERS 1
#endif
constexpr float SX = 20.0f;
constexpr float SW = 739.0f;
constexpr float SPQ = 1.75f;
constexpr int DFT_SHIFT = 9;
constexpr int WIN_SHIFT = 5;
constexpr int WGU_SHIFT = 5;
constexpr int WAF_SHIFT = 6;
constexpr int WOUT_SHIFT = 6;
constexpr int WD_SHIFT = 6;
constexpr float QSCALE = 0.125f * LOG2E;

constexpr size_t al(size_t x) { return (x + 4095) & ~(size_t)4095; }
constexpr size_t WS_CTL = 0, CTL_BYTES = 1u << 20;
constexpr size_t WS_WIN = WS_CTL + CTL_BYTES;
constexpr size_t WS_WA = WS_WIN + al((size_t)DEPTH * INW * D * 2);
constexpr size_t WS_WF = WS_WA + al((size_t)DEPTH * D * AW * 2);
constexpr size_t WS_WOUT = WS_WF + al((size_t)DEPTH * D * FW * 2);
constexpr size_t WS_WGU = WS_WOUT + al((size_t)DEPTH * D * D * 2);
constexpr size_t WS_WD = WS_WGU + al((size_t)DEPTH * NE * 2 * FF * D * 2);
constexpr size_t WS_DFTM = WS_WD + al((size_t)DEPTH * NE * D * FF * 2);
constexpr size_t WS_CSM = WS_DFTM + al((size_t)DK * DK * 2);
constexpr size_t WS_H = WS_CSM + al(256 * 256 * 2);
constexpr size_t WS_HB = WS_H + al((size_t)TP * D * 4);
constexpr size_t WS_VT = WS_HB + al((size_t)TP * D * 2);
constexpr size_t WS_ROWIDX = WS_VT + al((size_t)BATCH * NKV * HD * VT_LD * 2);
constexpr size_t WS_GATE = WS_ROWIDX + al((size_t)NSLOT * 4);
constexpr size_t WS_HB8 = WS_GATE + al((size_t)NSLOT * 4);
constexpr size_t WS_MIXB = WS_HB8 + al((size_t)TP * D);
constexpr size_t WS_STATS = WS_MIXB + al((size_t)TP * D * 2);
constexpr size_t WS_TMP = WS_STATS + al((size_t)TP * 8);
constexpr size_t WS_Q = WS_TMP;
constexpr size_t WS_KB = WS_Q + al((size_t)TP * AW * 2);
constexpr size_t WS_UF = WS_KB + al((size_t)TP * 128 * 2);
constexpr size_t WS_G = WS_UF + al((size_t)TP * FW * 2 + 4096);
constexpr size_t WS_ATT = WS_G + al((size_t)TP * 2 * D * 2);
constexpr size_t WS_PQT = WS_ATT + al((size_t)TP * AW * 2);
constexpr size_t WS_FOUR = WS_PQT + al((size_t)4096 * DK * 2);
constexpr size_t WS_P1 = WS_FOUR + al((size_t)TP * FW * 2);
constexpr size_t WS_MG = WS_P1 + al((size_t)TP * D * 2);
constexpr size_t WS_MIX_END = WS_MG + al((size_t)TP * D * 2);
constexpr size_t WS_AFFT = WS_TMP;
constexpr size_t WS_SLOTMAP = WS_AFFT + al((size_t)BATCH * NE * AFF_LD * 4);
constexpr size_t WS_HID = WS_SLOTMAP + al((size_t)T * NE * 4);
constexpr size_t WS_Y = WS_HID + al((size_t)NSLOT * FF * 2);
constexpr size_t WS_MOE_END = WS_Y + al((size_t)NSLOT * D * 2);
constexpr size_t WS_END = (WS_MIX_END > WS_MOE_END ? WS_MIX_END : WS_MOE_END);
static_assert(WS_END <= (size_t)1536 * 1024 * 1024, "d_ws map exceeds the guaranteed workspace");

constexpr int CW_BAR = 4096;
constexpr int CW_ERR = 1024;

constexpr int RING_BYTES = 131072;
constexpr int IDXTAB_OFF = RING_BYTES;
constexpr int IDXTAB_UNITS = 14;
constexpr int MISC_OFF = IDXTAB_OFF + IDXTAB_UNITS * 1024;
constexpr int LDS_BYTES = 147456;
static_assert(MISC_OFF + 256 <= LDS_BYTES, "LDS map");

#define LDS_WAIT() asm volatile("s_waitcnt lgkmcnt(0)" ::: "memory")
#define VM_WAIT() asm volatile("s_waitcnt vmcnt(0)" ::: "memory")
__device__ __forceinline__ unsigned cvtpk(float lo, float hi) { f32x2_t v = {lo, hi}; bf16x2_t b = __builtin_convertvector(v, bf16x2_t); return __builtin_bit_cast(unsigned, b); }
__device__ __forceinline__ bf16_t f2bf(float f) { return (bf16_t)(cvtpk(f, 0.f) & 0xffffu); }
__device__ __forceinline__ float bf2f(unsigned b) { return __uint_as_float(b << 16); }
__device__ __forceinline__ float bflo(unsigned w) { return __uint_as_float(w << 16); }
__device__ __forceinline__ float bfhi(unsigned w) { return __uint_as_float(w & 0xffff0000u); }
__device__ __forceinline__ u32x2 pack4(const f32x4 a) { u32x2 w; w.x = cvtpk(a[0], a[1]); w.y = cvtpk(a[2], a[3]); return w; }
__device__ __forceinline__ f32x4 unpack4(const u32x2 w) { return (f32x4){bflo(w.x), bfhi(w.x), bflo(w.y), bfhi(w.y)}; }
__device__ __forceinline__ unsigned pack4_fp8(float a, float b, float c, float d) { unsigned w = 0; w = __builtin_amdgcn_cvt_pk_fp8_f32(a, b, w, false); w = __builtin_amdgcn_cvt_pk_fp8_f32(c, d, w, true); return w; }
__device__ __forceinline__ unsigned pack4_i8(float a, float b, float c, float d) {
    const float M = 12582912.0f;
    const unsigned ua = __float_as_uint(__builtin_amdgcn_fmed3f(a, -127.f, 127.f) + M), ub = __float_as_uint(__builtin_amdgcn_fmed3f(b, -127.f, 127.f) + M);
    const unsigned uc = __float_as_uint(__builtin_amdgcn_fmed3f(c, -127.f, 127.f) + M), ud = __float_as_uint(__builtin_amdgcn_fmed3f(d, -127.f, 127.f) + M);
    const unsigned ab = __builtin_amdgcn_perm(ub, ua, 0x0c0c0400u), cd = __builtin_amdgcn_perm(ud, uc, 0x0c0c0400u);
    return __builtin_amdgcn_perm(cd, ab, 0x05040100u); }
__device__ __forceinline__ unsigned pack4_u8(float a, float b, float c, float d) {
    const float M = 12582912.0f;
    const unsigned ua = __float_as_uint(a + M), ub = __float_as_uint(b + M), uc = __float_as_uint(c + M), ud = __float_as_uint(d + M);
    const unsigned ab = __builtin_amdgcn_perm(ub, ua, 0x0c0c0400u), cd = __builtin_amdgcn_perm(ud, uc, 0x0c0c0400u);
    return __builtin_amdgcn_perm(cd, ab, 0x05040100u); }
__device__ __forceinline__ f32x4 unpack4_u8(unsigned w) { return (f32x4){(float)(w & 0xffu), (float)((w >> 8) & 0xffu), (float)((w >> 16) & 0xffu), (float)(w >> 24)}; }
__device__ __forceinline__ f32x4 unpack4_fp8(unsigned w) { const f32x2_t lo = __builtin_amdgcn_cvt_pk_f32_fp8(w, false), hi = __builtin_amdgcn_cvt_pk_f32_fp8(w, true); return (f32x4){lo[0], lo[1], hi[0], hi[1]}; }
__device__ __forceinline__ float fast_sigmoid(float x) { return __builtin_amdgcn_rcpf(1.0f + __builtin_amdgcn_exp2f(-LOG2E * x)); }
__device__ __forceinline__ float dpp_xor8(float x) { return __builtin_bit_cast(float, __builtin_amdgcn_update_dpp(0, __builtin_bit_cast(int, x), 0x128, 0xF, 0xF, true)); }
__device__ __forceinline__ float dpp_xor2(float x) { return __builtin_bit_cast(float, __builtin_amdgcn_update_dpp(0, __builtin_bit_cast(int, x), 0x4E, 0xF, 0xF, true)); }
__device__ __forceinline__ float dpp_xor1(float x) { return __builtin_bit_cast(float, __builtin_amdgcn_update_dpp(0, __builtin_bit_cast(int, x), 0xB1, 0xF, 0xF, true)); }
__device__ __forceinline__ float dpp_xor4(float x) { const int xi = __builtin_bit_cast(int, x); int t = __builtin_amdgcn_update_dpp(0, xi, 0x104, 0xF, 0x5, false); t = __builtin_amdgcn_update_dpp(t, xi, 0x114, 0xF, 0xA, false); return __builtin_bit_cast(float, t); }
__device__ __forceinline__ float swap_sum16(float x) { unsigned a = __builtin_bit_cast(unsigned, x), b = a; asm volatile("" : "+v"(b)); const auto r = __builtin_amdgcn_permlane16_swap(a, b, false, false);
    unsigned r0 = r[0], r1 = r[1]; asm volatile("" : "+v"(r0), "+v"(r1)); return __builtin_bit_cast(float, r0) + __builtin_bit_cast(float, r1); }
__device__ __forceinline__ float swap_sum32(float x) { unsigned a = __builtin_bit_cast(unsigned, x), b = a; asm volatile("" : "+v"(b)); const auto r = __builtin_amdgcn_permlane32_swap(a, b, false, false);
    unsigned r0 = r[0], r1 = r[1]; asm volatile("" : "+v"(r0), "+v"(r1)); return __builtin_bit_cast(float, r0) + __builtin_bit_cast(float, r1); }
__device__ __forceinline__ float wave_sum(float v) {
    v += dpp_xor1(v); v += dpp_xor2(v); v += dpp_xor4(v); v += dpp_xor8(v);
    return swap_sum32(swap_sum16(v));
}

#define XB_TMO      128
#define XB_XCNT(j)  (256  + 64 * (j))
#define XB_XSUB(j)  (1280 + 64 * (j))
#define XB_XGEN(j)  (2304 + 64 * (j))
#define XB_TOP      3328
#define XB_TOPGEN   3392
#define XCD_BAR_WORDS 3456
#define XB_SPIN_CAP (1u << 18)
__device__ __forceinline__ unsigned xb_ld(unsigned* p)              { return __hip_atomic_load(p, __ATOMIC_RELAXED, __HIP_MEMORY_SCOPE_AGENT); }
__device__ __forceinline__ unsigned xb_add(unsigned* p, unsigned v) { return __hip_atomic_fetch_add(p, v, __ATOMIC_RELAXED, __HIP_MEMORY_SCOPE_AGENT); }
__device__ __forceinline__ unsigned xb_xcc_id() { return (unsigned)__builtin_amdgcn_s_getreg((3 << 11) | 20) & 0xFu; }
#define XB_SPIN(cond, bar) do { unsigned _sp = 0; while (cond) { __builtin_amdgcn_s_sleep(1); \
    if ((++_sp & 255u) == 0u) { if (xb_ld(&(bar)[XB_TMO])) break; if (_sp > XB_SPIN_CAP) { atomicAdd(&(bar)[XB_TMO], 1u); break; } } } } while (0)
struct XcdBarrier { unsigned* bar; unsigned x; volatile LAS unsigned* st; };
__device__ __forceinline__ XcdBarrier xcd_barrier_post(unsigned* bar, volatile LAS unsigned* st) {
    XcdBarrier b; b.bar = bar; b.x = (unsigned)__builtin_amdgcn_readfirstlane((int)xb_xcc_id()); b.st = st;
    if (threadIdx.x == 0) (void)xb_add(&bar[XB_XCNT(b.x)], 1u);
    return b;
}
__device__ __forceinline__ void xcd_barrier_complete(unsigned* bar, unsigned x, unsigned& nloc, unsigned& nx) {
    const unsigned G = gridDim.x * gridDim.y * gridDim.z;
    unsigned sum, cnt, mine, sp = 0u;
    for (;;) {
        sum = 0u; cnt = 0u; mine = 0u;
#pragma unroll
        for (unsigned j = 0; j < 16; ++j) { const unsigned c = xb_ld(&bar[XB_XCNT(j)]); sum += c; cnt += (c > 0u) ? 1u : 0u; mine = (j == x) ? c : mine; }
        if (sum == G) break;
        __builtin_amdgcn_s_sleep(1);
        if ((++sp & 255u) == 0u) { if (xb_ld(&bar[XB_TMO])) break; if (sp > XB_SPIN_CAP) { atomicAdd(&bar[XB_TMO], 1u); break; } }
    }
    nloc = mine > 0u ? mine : 1u; nx = cnt > 0u ? cnt : 1u;
}
__device__ __forceinline__ void xcd_barrier(const XcdBarrier& b) {
    asm volatile("s_waitcnt vmcnt(0)" ::: "memory");
    __syncthreads();
    if (threadIdx.x == 0) {
        unsigned* bar = b.bar; unsigned bx = b.x; asm volatile("" : "+s"(bx));
        __builtin_amdgcn_s_waitcnt(0);
        unsigned nloc = b.st[0], nx = b.st[1];
        if (nloc == 0u) { xcd_barrier_complete(bar, bx, nloc, nx); b.st[0] = nloc; b.st[1] = nx; }
        const unsigned old = xb_add(&bar[XB_XSUB(bx)], 1u);
        const unsigned gen = old / nloc;
        if (old + 1u == (gen + 1u) * nloc) {
            __builtin_amdgcn_fence(__ATOMIC_RELEASE, "agent");
            asm volatile("s_waitcnt vmcnt(0)" ::: "memory");
            const unsigned og = xb_add(&bar[XB_TOP], 1u);
            const unsigned tg = og / nx;
            if (og + 1u == (tg + 1u) * nx) xb_add(&bar[XB_TOPGEN], 1u);
            else XB_SPIN(xb_ld(&bar[XB_TOPGEN]) == tg, bar);
            __builtin_amdgcn_fence(__ATOMIC_ACQUIRE, "agent");
            xb_add(&bar[XB_XGEN(bx)], 1u);
            asm volatile("s_waitcnt vmcnt(0)" ::: "memory");
        } else {
            XB_SPIN(xb_ld(&bar[XB_XGEN(bx)]) == gen, bar);
            __builtin_amdgcn_fence(__ATOMIC_ACQUIRE, "agent");
            asm volatile("s_waitcnt vmcnt(0)" ::: "memory");
        }
    }
    __syncthreads();
}

namespace pg8 {
constexpr int BM = 256, BK = 64, HALF = 128, HTB = HALF * BK * 2, STAGE_BYTES = 8 * HTB, NXCD = 8, WGM = 8;
__host__ __device__ __forceinline__ int lds_byte(int r, int c) { const int st = (r >> 4) * 2 + (c >> 5), rr = r & 15, cc = c & 31, ob = rr * 64 + cc * 2; return st * 1024 + (ob ^ (((ob >> 9) & 1) << 5)); }
__host__ __device__ __forceinline__ void stage_rc(int b, int& R, int& C) { const int st = b / 1024, sb = b % 1024, swz = sb ^ (((sb >> 9) & 1) << 5); R = (st >> 1) * 16 + swz / 64; C = (st & 1) * 32 + (swz % 64) / 2; }
__host__ __device__ __forceinline__ int perm32(int rho) { const int n = rho >> 4, i = rho & 15; return 8 * (i >> 2) + 4 * n + (i & 3); }

struct Unit { int pm, pn; const char* A; const char* B; int part; };

struct TileOrder {
    int nM, nN, nwg, G, c;
    __device__ __forceinline__ void init(int nM_, int nN_, int G_, int c_) { nM = nM_; nN = nN_; nwg = nM * nN; G = G_; c = c_; }
    __device__ __forceinline__ bool tile(int i, int& pm, int& pn) const {
        const long L = (long)i * G + c; if (L >= nwg) return false;
        int wgid = (int)L; { const int q = nwg / NXCD, r = nwg % NXCD, xcd = wgid % NXCD, off = wgid / NXCD; wgid = (xcd < r ? xcd * (q + 1) : r * (q + 1) + (xcd - r) * q) + off; }
        const int nig = WGM * nN, gid = wgid / nig, fm = gid * WGM, gsz = (nM - fm) < WGM ? (nM - fm) : WGM;
        pm = fm + ((wgid % nig) % gsz); pn = (wgid % nig) / gsz; return true;
    }
};

template <class Epi, class Sched, bool ALIGN_EPI, int MODE = 0, int SCALE_W = 127>
__device__ __forceinline__ void gemm_phase(LAS unsigned char* lds, const Sched& S, const Epi& E, const int K, const int ldb) {
    int tid_ = threadIdx.x; asm volatile("" : "+v"(tid_));
    const int tid = tid_, wid = __builtin_amdgcn_readfirstlane(tid >> 6), lane = tid & 63, wr = wid >> 2, wc = wid & 3, fr = lane & 15, fq = lane >> 4;
    constexpr bool FP8 = (MODE == 1), I8 = (MODE == 2);
    int nt = K / (BK * 2); asm volatile("" : "+s"(nt));
    int sR[2], sC[2]; unsigned voffB[2];
#pragma unroll
    for (int i = 0; i < 2; ++i) { stage_rc(tid * 16 + i * 8192, sR[i], sC[i]); const int Rb = Epi::PERM ? ((sR[i] & ~31) + perm32(sR[i] & 31)) : sR[i];
        voffB[i] = (unsigned)(Rb * ldb + sC[i] * 2); }
    const size_t kstep = (size_t)(BK * 2);
    const size_t hstepB = (size_t)HALF * ldb;
    unsigned voffA[2]; size_t hstepA = 0;
    if constexpr (!Sched::GATHER) { hstepA = (size_t)HALF * S.lda;
#pragma unroll
        for (int i = 0; i < 2; ++i) voffA[i] = (unsigned)(sR[i] * S.lda + sC[i] * 2); }
    const unsigned ldsw = (unsigned)wid * 1024u;
    const int aoff = lds_byte(wr * 64 + fr, fq * 8), boff = lds_byte(wc * 32 + fr, fq * 8);
#define PG8_SA(b, h) (((b) * 2 + (h)) * HTB)
#define PG8_SB(b, h) ((4 + (b) * 2 + (h)) * HTB)
#define PG8_STAGE(bufoff, gbase, voff) do { _Pragma("unroll") for (int _i = 0; _i < 2; ++_i) \
        __builtin_amdgcn_global_load_lds((const unsigned*)((const char*)(gbase) + (voff)[_i]), (LAS unsigned*)(lds + (bufoff) + ldsw + _i * 8192), 16, 0, 0); } while (0)
#define PG8_STAGE_A(bufoff, gbase, h, OFFS) do { if constexpr (Sched::GATHER) PG8_STAGE(bufoff, gbase, OFFS[h]); else PG8_STAGE(bufoff, (gbase) + (h) * hstepA, voffA); } while (0)
#define PG8_LD32(p) __builtin_shufflevector(*(const LAS u32x4*)(p), *(const LAS u32x4*)((p) + 1024), 0, 1, 2, 3, 4, 5, 6, 7)
#define PG8_STAGE_B(bufoff, gbase, h, OFFS) do { if constexpr (Sched::GATHER_B) PG8_STAGE(bufoff, gbase, OFFS[h]); else PG8_STAGE(bufoff, (gbase) + (h) * hstepB, voffB); } while (0)
#define PG8_LDA(dst, b, h) do { if constexpr (FP8) { _Pragma("unroll") for (int m = 0; m < 4; ++m) dst##8[m] = __builtin_bit_cast(v8i_t, PG8_LD32(lds + PG8_SA(b, h) + aoff + m * 2048)); } \
        else { _Pragma("unroll") for (int m = 0; m < 4; ++m) _Pragma("unroll") for (int k = 0; k < 2; ++k) dst[m][k] = *(const LAS bf16x8*)(lds + PG8_SA(b, h) + aoff + m * 2048 + k * 1024); } } while (0)
#define PG8_LDB(dst, b, h) do { if constexpr (FP8) { _Pragma("unroll") for (int n = 0; n < 2; ++n) dst##8[n] = __builtin_bit_cast(v8i_t, PG8_LD32(lds + PG8_SB(b, h) + boff + n * 2048)); } \
        else { _Pragma("unroll") for (int n = 0; n < 2; ++n) _Pragma("unroll") for (int k = 0; k < 2; ++k) dst[n][k] = *(const LAS bf16x8*)(lds + PG8_SB(b, h) + boff + n * 2048 + k * 1024); } } while (0)
#define PG8_MMA(ai, bj, At, Bt) do { __builtin_amdgcn_s_setprio(1); \
        if constexpr (FP8) { _Pragma("unroll") for (int m = 0; m < 4; ++m) _Pragma("unroll") for (int n = 0; n < 2; ++n) \
            asm volatile("v_mfma_scale_f32_16x16x128_f8f6f4 %0, %1, %2, %0, %3, %4 op_sel_hi:[0,0,0]" : "+v"(acc[ai][bj][m][n]) : "v"(Bt##8[n]), "v"(At##8[m]), "v"(sc_w), "v"(sc_a)); } \
        else if constexpr (I8) { _Pragma("unroll") for (int m = 0; m < 4; ++m) _Pragma("unroll") for (int n = 0; n < 2; ++n) _Pragma("unroll") for (int k = 0; k < 2; ++k) \
            acc[ai][bj][m][n] = __builtin_bit_cast(f32x4, __builtin_amdgcn_mfma_i32_16x16x64_i8(__builtin_bit_cast(v4i_t, Bt[n][k]), __builtin_bit_cast(v4i_t, At[m][k]), __builtin_bit_cast(v4i_t, acc[ai][bj][m][n]), 0, 0, 0)); } \
        else { _Pragma("unroll") for (int m = 0; m < 4; ++m) _Pragma("unroll") for (int n = 0; n < 2; ++n) _Pragma("unroll") for (int k = 0; k < 2; ++k) \
            acc[ai][bj][m][n] = __builtin_amdgcn_mfma_f32_16x16x32_bf16(Bt[n][k], At[m][k], acc[ai][bj][m][n], 0, 0, 0); } \
        __builtin_amdgcn_s_setprio(0); } while (0)
#define PG8_WAIT_V(n) asm volatile("s_waitcnt vmcnt(" #n ")" ::: "memory")
#define PG8_WAIT_L(n) asm volatile("s_waitcnt lgkmcnt(" #n ")" ::: "memory")
#define PG8_BAR __builtin_amdgcn_s_barrier()
#define PG8_SCHED __builtin_amdgcn_sched_barrier(0)
    Unit cur, nxt; int ui = 0;
    if (!S.next(0, cur)) return;
    unsigned oA[2][2], noA[2][2], oB[2][2], noB[2][2];
    int sRb[2];
#pragma unroll
    for (int i = 0; i < 2; ++i) sRb[i] = Epi::PERM ? ((sR[i] & ~31) + perm32(sR[i] & 31)) : sR[i];
#pragma unroll
    for (int h = 0; h < 2; ++h)
#pragma unroll
        for (int i = 0; i < 2; ++i) { oA[h][i] = Sched::GATHER ? S.aoff(cur, 0, h, sR[i], sC[i]) : 0u; oB[h][i] = Sched::GATHER_B ? S.boff(cur, 0, h, sRb[i], sC[i]) : 0u; }
    f32x4 acc[2][2][4][2];
#pragma unroll
    for (int a = 0; a < 2; ++a)
#pragma unroll
        for (int b = 0; b < 2; ++b)
#pragma unroll
            for (int m = 0; m < 4; ++m)
#pragma unroll
                for (int n = 0; n < 2; ++n) acc[a][b][m][n] = (f32x4){0.f, 0.f, 0.f, 0.f};
    const int sc_w = SCALE_W * 0x01010101, sc_a = 0x7f7f7f7f;
    bf16x8 At[4][2], B0[2][2], B1[2][2]; v8i_t At8[4], B08[2], B18[2];
    const char* cA = cur.A; const char* cB = cur.B;
    PG8_STAGE_B(PG8_SB(0, 0), cB, 0, oB); PG8_STAGE_B(PG8_SB(0, 1), cB, 1, oB); PG8_STAGE_A(PG8_SA(0, 0), cA, 0, oA); PG8_STAGE_A(PG8_SA(0, 1), cA, 1, oA);
    if (wr == 1) PG8_BAR;
    PG8_WAIT_V(2); PG8_BAR;
    PG8_STAGE_B(PG8_SB(1, 0), cB + kstep, 0, oB); PG8_STAGE_A(PG8_SA(1, 0), cA + kstep, 0, oA); PG8_STAGE_B(PG8_SB(1, 1), cB + kstep, 1, oB);
    PG8_WAIT_V(6); PG8_BAR;
    for (;;) {
        const bool has_next = S.next(ui + 1, nxt);
        const char* nA = has_next ? nxt.A : cA; const char* nB = has_next ? nxt.B : cB;
#pragma unroll
        for (int h = 0; h < 2; ++h)
#pragma unroll
            for (int i = 0; i < 2; ++i) { noA[h][i] = Sched::GATHER ? (has_next ? S.aoff(nxt, ui + 1, h, sR[i], sC[i]) : oA[h][i]) : 0u; noB[h][i] = Sched::GATHER_B ? (has_next ? S.boff(nxt, ui + 1, h, sRb[i], sC[i]) : oB[h][i]) : 0u; }
#pragma unroll 1
        for (int t = 0; t < nt; t += 2) {
            const bool last = (t == nt - 2);
            const char* a1 = cA + (size_t)(t + 1) * kstep;
            const char* a2 = last ? nA : cA + (size_t)(t + 2) * kstep; const char* b2 = last ? nB : cB + (size_t)(t + 2) * kstep;
            const char* a3 = a2 + kstep; const char* b3 = b2 + kstep;
            unsigned o2[2][2], o2B[2][2];
#pragma unroll
            for (int h = 0; h < 2; ++h)
#pragma unroll
                for (int i = 0; i < 2; ++i) { o2[h][i] = Sched::GATHER ? (last ? noA[h][i] : oA[h][i]) : 0u; o2B[h][i] = Sched::GATHER_B ? (last ? noB[h][i] : oB[h][i]) : 0u; }
            PG8_LDB(B0, 0, 0); PG8_LDB(B1, 0, 1); PG8_SCHED; PG8_LDA(At, 0, 0); PG8_STAGE_A(PG8_SA(1, 1), a1, 1, oA);
            PG8_WAIT_V(8); PG8_WAIT_L(0); PG8_BAR; PG8_MMA(0, 0, At, B0); PG8_MMA(0, 1, At, B1); PG8_BAR; PG8_SCHED;
            PG8_LDA(At, 0, 1); PG8_STAGE_B(PG8_SB(0, 0), b2, 0, o2B); PG8_STAGE_B(PG8_SB(0, 1), b2, 1, o2B); PG8_STAGE_A(PG8_SA(0, 0), a2, 0, o2);
            PG8_WAIT_V(8); PG8_WAIT_L(0); PG8_BAR; PG8_MMA(1, 0, At, B0); PG8_MMA(1, 1, At, B1); PG8_BAR; PG8_SCHED;
            PG8_LDB(B0, 1, 0); PG8_LDB(B1, 1, 1); PG8_SCHED; PG8_LDA(At, 1, 0); PG8_STAGE_A(PG8_SA(0, 1), a2, 1, o2);
            PG8_WAIT_V(8); PG8_WAIT_L(0); PG8_BAR; PG8_MMA(0, 0, At, B0); PG8_MMA(0, 1, At, B1); PG8_BAR; PG8_SCHED;
            PG8_LDA(At, 1, 1); PG8_STAGE_B(PG8_SB(1, 0), b3, 0, o2B); PG8_STAGE_B(PG8_SB(1, 1), b3, 1, o2B); PG8_STAGE_A(PG8_SA(1, 0), a3, 0, o2);
            PG8_WAIT_V(8); PG8_WAIT_L(0); PG8_BAR; PG8_MMA(1, 0, At, B0); PG8_MMA(1, 1, At, B1); PG8_BAR; PG8_SCHED;
        }
        if constexpr (ALIGN_EPI) { if (wr == 0) PG8_BAR; }
        if constexpr (FP8) asm volatile("s_nop 15\n\ts_nop 15\n\ts_nop 15\n\ts_nop 15" ::: "memory");
        bool keep_acc = false;
        int fr_e = fr, fq_e = fq; asm volatile("" : "+v"(fr_e), "+v"(fq_e));
        if constexpr (Epi::TWO_PART) { if (cur.part == 0) { E.mid(acc, cur, wr, wc, fr_e, fq_e); keep_acc = true; } else E(acc, cur, wr, wc, fr_e, fq_e); }
        else E(acc, cur, wr, wc, fr_e, fq_e);
        if constexpr (Sched::HAS_HOOK) S.hook(ui);
        if (!has_next) break;
        if (!keep_acc) {
#pragma unroll
        for (int a = 0; a < 2; ++a)
#pragma unroll
            for (int b = 0; b < 2; ++b)
#pragma unroll
                for (int m = 0; m < 4; ++m)
#pragma unroll
                    for (int n = 0; n < 2; ++n) acc[a][b][m][n] = (f32x4){0.f, 0.f, 0.f, 0.f};
        }
        cur = nxt; cA = nA; cB = nB; ++ui;
#pragma unroll
        for (int h = 0; h < 2; ++h)
#pragma unroll
            for (int i = 0; i < 2; ++i) { oA[h][i] = noA[h][i]; oB[h][i] = noB[h][i]; }
        if constexpr (ALIGN_EPI) { if (wr == 1) PG8_BAR; }
    }
    PG8_WAIT_V(0);
    if constexpr (!ALIGN_EPI) { if (wr == 0) PG8_BAR; }
    PG8_BAR;
#undef PG8_SA
#undef PG8_SB
#undef PG8_STAGE
#undef PG8_STAGE_A
#undef PG8_STAGE_B
#undef PG8_LDA
#undef PG8_LDB
#undef PG8_MMA
#undef PG8_LD32
#undef PG8_WAIT_V
#undef PG8_WAIT_L
#undef PG8_BAR
#undef PG8_SCHED
}
}
using pg8::Unit;
using pg8::TileOrder;

struct Frame {
    LAS unsigned char* lds;
    int tid, lane, wave, G, bid;
    const float *x, *meta, *ln0_g, *ln0_b, *w_in, *b_gate, *sink, *w_attn_o, *w_four_o, *w_out, *ln1_g, *ln1_b, *w_router, *w_e_gate, *w_e_up, *w_e_down, *ln2_g, *ln2_b;
    float* out; unsigned char* ws;
};
#define WSP(T_, off) ((T_*)(F.ws + (off)))

__device__ __forceinline__ void conv_share_regs(const Frame& F, int cl);
struct SchedReg {
    static constexpr bool GATHER = false, GATHER_B = false, HAS_HOOK = false;
    TileOrder o; const char* A; const char* B; int lda, ldb;
    __device__ __forceinline__ bool next(int i, Unit& u) const { int pm, pn; if (!o.tile(i, pm, pn)) return false; u.pm = pm; u.pn = pn; u.part = 1;
        u.A = A + (size_t)pm * 256 * lda; u.B = B + (size_t)pn * 256 * ldb; return true; }
    __device__ __forceinline__ unsigned aoff(const Unit&, int, int h, int R, int C) const { return (unsigned)((h * 128 + R) * lda + C * 2); }
    __device__ __forceinline__ unsigned boff(const Unit&, int, int, int, int) const { return 0u; }
};
struct SchedInProj {
    static constexpr bool GATHER = false, GATHER_B = false, HAS_HOOK = false;
    TileOrder o, o1, o2; bool bal; const char* A; const char* B; int lda, ldb;
    __device__ __forceinline__ bool next(int i, Unit& u) const { int pm, pn;
        if (!bal) { if (!o.tile(i, pm, pn)) return false; }
        else if (i < 4) { o1.tile(i, pm, pn); pn += 5; }
        else { const int L = (i - 4) * 256 + o2.c; if (L < 645) o2.tile(i - 4, pm, pn); else if (L < 653) { pm = 128; pn = 5 + (L - 645); } else return false; }
        u.pm = pm; u.pn = pn; u.part = 1; u.A = A + (size_t)pm * 256 * lda; u.B = B + (size_t)pn * 256 * ldb; return true; }
    __device__ __forceinline__ unsigned aoff(const Unit&, int, int h, int R, int C) const { return (unsigned)((h * 128 + R) * lda + C * 2); }
    __device__ __forceinline__ unsigned boff(const Unit&, int, int, int, int) const { return 0u; }
};
struct SchedMerge {
    static constexpr bool GATHER = false, GATHER_B = false, HAS_HOOK = false; static constexpr int lda = AW;
    TileOrder o; const char* ATT; const char* FOUR; const char* WA; const char* WF;
    __device__ __forceinline__ bool next(int i, Unit& u) const { int pm, pn; if (!o.tile(i >> 1, pm, pn)) return false; u.pm = pm; u.pn = pn; u.part = i & 1;
        u.A = ((i & 1) ? FOUR : ATT) + (size_t)pm * 256 * AW; u.B = ((i & 1) ? WF : WA) + (size_t)pn * 256 * AW; return true; }
    __device__ __forceinline__ unsigned aoff(const Unit&, int, int h, int R, int C) const { return (unsigned)((h * 128 + R) * AW + C) * 2u; }
    __device__ __forceinline__ unsigned boff(const Unit&, int, int, int, int) const { return 0u; }
};
struct SchedDown {
    static constexpr bool GATHER = false, GATHER_B = false, HAS_HOOK = false; static constexpr int lda = FF;
    TileOrder o; const char* HID; const char* WD;
    __device__ __forceinline__ bool next(int i, Unit& u) const { int pm, pn; if (!o.tile(i, pm, pn)) return false; u.pm = pm; u.pn = pn; u.part = 1; const int e = pm >> 4;
        u.A = HID + (size_t)(e * ESLOTS + (pm & 15) * 256) * FF; u.B = WD + ((size_t)e * D + (size_t)pn * 256) * FF; return true; }
    __device__ __forceinline__ unsigned aoff(const Unit&, int, int h, int R, int C) const { return (unsigned)((h * 128 + R) * FF + C * 2); }
    __device__ __forceinline__ unsigned boff(const Unit&, int, int, int, int) const { return 0u; }
};
struct SchedGU {
    static constexpr bool GATHER = true, GATHER_B = false, HAS_HOOK = true; static constexpr int lda = D;
    TileOrder o; const char* HB; const char* WGU; const LAS int* idxtab; const Frame* Fp; int conv_layer, conv_slot;
    __device__ __forceinline__ void hook(int ui) const { if (conv_layer >= 0 && ui == conv_slot) conv_share_regs(*Fp, conv_layer); }
    __device__ __forceinline__ bool next(int i, Unit& u) const { int pm, pn; if (!o.tile(i, pm, pn)) return false; u.pm = pm; u.pn = pn; u.part = 1; const int e = pm >> 4;
        u.A = HB; u.B = WGU + ((size_t)e * (2 * FF) + (size_t)pn * 256) * D; return true; }
    __device__ __forceinline__ unsigned aoff(const Unit&, int i, int h, int R, int C) const { return (unsigned)idxtab[i * 256 + h * 128 + R] * (unsigned)D + (unsigned)C * 2u; }
    __device__ __forceinline__ unsigned boff(const Unit&, int, int, int, int) const { return 0u; }
};
struct SchedChan {
    static constexpr bool GATHER = false, GATHER_B = true, HAS_HOOK = false; static constexpr int lda = 512;
    TileOrder o; const char* UF; const char* CSM;
    __device__ __forceinline__ bool next(int i, Unit& u) const { int pm, pn; if (!o.tile(i, pm, pn)) return false; u.pm = pm; u.pn = 0; u.part = 1; const int bg = pm / 17, g = bg & 3, b = bg >> 2;
        u.A = CSM; u.B = UF + ((size_t)b * LSEQ * FW + (size_t)g * 128) * 2; return true; }
    __device__ __forceinline__ unsigned aoff(const Unit&, int, int, int, int) const { return 0u; }
    __device__ __forceinline__ unsigned boff(const Unit& u, int, int h, int R, int C) const { const int lt = u.pm % 17, l = lt * 128 + R; int tok = h ? LSEQ - l : l; if (tok >= LSEQ) tok = 0;
        return (unsigned)(tok * FW + C) * 2u; }
};

typedef const f32x4 (&AccRef)[2][2][4][2];
__device__ __forceinline__ f32x4 i2f(const f32x4 a, float sc) { const v4i_t i = __builtin_bit_cast(v4i_t, a); return (f32x4){(float)i[0], (float)i[1], (float)i[2], (float)i[3]} * sc; }
__device__ __forceinline__ u32x4 pack8(const f32x4 a, const f32x4 b) { u32x4 w; w.x = cvtpk(a[0], a[1]); w.y = cvtpk(a[2], a[3]); w.z = cvtpk(b[0], b[1]); w.w = cvtpk(b[2], b[3]); return w; }

#ifndef EPI_WT
#define EPI_WT 0
#endif
__device__ __forceinline__ void st16(void* p, const u32x4 v) {
#if EPI_WT
    asm volatile("global_store_dwordx4 %0, %1, off sc1\n\ts_nop 1" :: "v"(p), "v"(v) : "memory");
#elif defined(EPI_NT)
    __builtin_nontemporal_store(v, (u32x4*)p);
#else
    *(u32x4*)p = v;
#endif
}
__device__ __forceinline__ u32x4 pair16(const u32x2 a, const u32x2 b) {
    const auto r0 = __builtin_amdgcn_permlane16_swap(a.x, b.x, false, false), r1 = __builtin_amdgcn_permlane16_swap(a.y, b.y, false, false);
    return (u32x4){r0[0], r1[0], r0[1], r1[1]};
}
__device__ __forceinline__ void store_rows8(unsigned char* base, size_t pitch, const u32x2 (&pk)[4], int fq) {
#pragma unroll
    for (int mp = 0; mp < 2; ++mp) st16(base + (size_t)(32 * mp + 16 * (fq & 1)) * pitch + 16 * (fq >> 1), pair16(pk[2 * mp], pk[2 * mp + 1]));
}
struct EpiInProj { static constexpr bool TWO_PART = false;
    static constexpr bool PERM = true;
    bf16_t *Q, *KB, *VT, *UF; unsigned char* G; const float* bgate; bool active;
    __device__ __forceinline__ void operator()(AccRef acc, const Unit& u, int wr, int wc, int fr, int fq) const {
        if (!active) return;
        const int pn = u.pn, rbase = u.pm * 256 + wr * 64 + fr, c8 = wc * 32 + 8 * fq;
        constexpr float dq = 1.0f / (SX * SW);
#pragma unroll
        for (int ai = 0; ai < 2; ++ai) { if (u.pm * 256 + ai * 128 >= T) continue;
#pragma unroll
            for (int bj = 0; bj < 2; ++bj) { const int colt = bj * 128 + c8;
                if (pn >= 5) {
                    const int gc = (pn - 5) * 256 + colt; const f32x4 b0 = *(const f32x4*)(bgate + gc) * -LOG2E, b1 = *(const f32x4*)(bgate + gc + 4) * -LOG2E; u32x2 pk[4];
#pragma unroll
                    for (int m = 0; m < 4; ++m) { f32x4 v0 = i2f(acc[ai][bj][m][0], -LOG2E * dq), v1 = i2f(acc[ai][bj][m][1], -LOG2E * dq);
#pragma unroll
                        for (int j = 0; j < 4; ++j) { v0[j] = __builtin_amdgcn_rcpf(__builtin_fmaf(__builtin_amdgcn_exp2f(v0[j] + b0[j]), 1.0f / 255.0f, 1.0f / 255.0f));
                                                      v1[j] = __builtin_amdgcn_rcpf(__builtin_fmaf(__builtin_amdgcn_exp2f(v1[j] + b1[j]), 1.0f / 255.0f, 1.0f / 255.0f)); }
                        pk[m] = (u32x2){pack4_u8(v0[0], v0[1], v0[2], v0[3]), pack4_u8(v1[0], v1[1], v1[2], v1[3])}; }
                    store_rows8(G + (size_t)(rbase + ai * 128) * (2 * D) + (pn - 5) * 256 + bj * 128 + wc * 32, 2 * D, pk, fq);
                } else {
#pragma unroll
                    for (int m = 0; m < 4; ++m) { const int row = rbase + ai * 128 + m * 16; f32x4 v0 = i2f(acc[ai][bj][m][0], dq), v1 = i2f(acc[ai][bj][m][1], dq);
                        if (pn < 2) { v0 = v0 * QSCALE; v1 = v1 * QSCALE; st16(Q + (size_t)row * AW + pn * 256 + colt, pack8(v0, v1)); }
                        else if (pn == 2) {
                            if (bj == 0) { st16(KB + (size_t)row * 128 + c8, pack8(v0, v1)); }
                            else { const int b = row / LSEQ, p = row - b * LSEQ; const int kvh = c8 >> 6, d0 = c8 & 63;
                                bf16_t* vp = VT + ((size_t)((b * NKV + kvh) * HD + d0)) * VT_LD + VT_OFF + p;
#pragma unroll
                                for (int j = 0; j < 4; ++j) { vp[(size_t)j * VT_LD] = f2bf(v0[j]); vp[(size_t)(4 + j) * VT_LD] = f2bf(v1[j]); } } }
                        else { st16(UF + (size_t)row * FW + (pn - 3) * 256 + colt, pack8(v0, v1)); } } } } }
    }
};
struct EpiChan { static constexpr bool TWO_PART = false;
    static constexpr bool PERM = true;
    unsigned char* PQT;
    __device__ __forceinline__ void operator()(AccRef acc, const Unit& u, int wr, int wc, int fr, int fq) const {
        const int lt = u.pm % 17, bg = u.pm / 17, l8 = lt * 128 + wc * 32 + 8 * fq;
        u32x2 pp[4], pq[4];
#pragma unroll
        for (int m = 0; m < 4; ++m) { float pe[8], qo[8];
#pragma unroll
            for (int n = 0; n < 2; ++n)
#pragma unroll
                for (int j = 0; j < 4; ++j) { const int l = l8 + 4 * n + j; const bool pair = (l >= 1 && l <= HALFL - 1), own = (l <= HALFL);
                    float p = own ? acc[0][0][m][n][j] : 0.f, q = 0.f;
                    if (pair) { p += acc[0][1][m][n][j]; q = acc[1][0][m][n][j] - acc[1][1][m][n][j]; }
                    pe[4 * n + j] = p; qo[4 * n + j] = q; }
            pp[m] = (u32x2){pack4_i8(pe[0] * SPQ, pe[1] * SPQ, pe[2] * SPQ, pe[3] * SPQ), pack4_i8(pe[4] * SPQ, pe[5] * SPQ, pe[6] * SPQ, pe[7] * SPQ)};
            pq[m] = (u32x2){pack4_i8(qo[0] * SPQ, qo[1] * SPQ, qo[2] * SPQ, qo[3] * SPQ), pack4_i8(qo[4] * SPQ, qo[5] * SPQ, qo[6] * SPQ, qo[7] * SPQ)}; }
        unsigned char* base = PQT + (size_t)(bg * 128 + wr * 64 + fr) * DK + lt * 128 + wc * 32;
        store_rows8(base, DK, pp, fq); store_rows8(base + QOFF, DK, pq, fq);
    }
};
struct EpiSeq { static constexpr bool TWO_PART = false;
    static constexpr bool PERM = true;
    unsigned char* FOUR;
    __device__ __forceinline__ void operator()(AccRef acc, const Unit& u, int wr, int wc, int fr, int fq) const {
        const float us = 1.0f / (127.0f * sqrtf(128.0f * (float)LSEQ) * SPQ);
#pragma unroll
        for (int ai = 0; ai < 2; ++ai)
#pragma unroll
            for (int bj = 0; bj < 2; ++bj) { const int n = u.pn * 256 + bj * 128 + wc * 32, b = n >> 9, cc = n & 511, k0 = u.pm * 256 + ai * 128 + wr * 64 + fr; u32x2 pk[4];
#pragma unroll
                for (int m = 0; m < 4; ++m) { const f32x4 z0 = i2f(acc[ai][bj][m][0], us), z1 = i2f(acc[ai][bj][m][1], us);
                    pk[m] = (u32x2){pack4_fp8(z0[0], z0[1], z0[2], z0[3]), pack4_fp8(z1[0], z1[1], z1[2], z1[3])}; }
                store_rows8(FOUR + (size_t)(b * LSEQ + k0) * FW + cc, FW, pk, fq); }
    }
};
__device__ __forceinline__ void unpack8(const u32x4 w, f32x4& a, f32x4& b) { a = (f32x4){bflo(w.x), bfhi(w.x), bflo(w.y), bfhi(w.y)}; b = (f32x4){bflo(w.z), bfhi(w.z), bflo(w.w), bfhi(w.w)}; }
__device__ __forceinline__ f32x4 fmaxv(const f32x4 a) { return (f32x4){fmaxf(a[0], 0.5f), fmaxf(a[1], 0.5f), fmaxf(a[2], 0.5f), fmaxf(a[3], 0.5f)}; }
struct EpiMerge {
    static constexpr bool PERM = true, TWO_PART = true;
    unsigned char* MG; const unsigned char* G;
    typedef f32x4 (&AccMut)[2][2][4][2];
    __device__ __forceinline__ void mid(AccMut acc, const Unit& u, int wr, int wc, int fr, int fq) const {
#pragma unroll
        for (int ai = 0; ai < 2; ++ai)
#pragma unroll
            for (int m = 0; m < 4; ++m) { int row = u.pm * 256 + ai * 128 + wr * 64 + 16 * m + fr; if (row >= T) row = T - 1;
#pragma unroll
                for (int bj = 0; bj < 2; ++bj) { const int col = u.pn * 256 + bj * 128 + wc * 32 + 8 * fq;
                    const u32x2 wa = *(const u32x2*)(G + (size_t)row * (2 * D) + col), wb = *(const u32x2*)(G + (size_t)row * (2 * D) + D + col);
                    const f32x4 a0 = unpack4_u8(wa.x), a1 = unpack4_u8(wa.y), b0 = unpack4_u8(wb.x), b1 = unpack4_u8(wb.y);
#pragma unroll
                    for (int j = 0; j < 4; ++j) { acc[ai][bj][m][0][j] *= a0[j] * __builtin_amdgcn_rcpf(fmaxf(b0[j], 0.5f)); acc[ai][bj][m][1][j] *= a1[j] * __builtin_amdgcn_rcpf(fmaxf(b1[j], 0.5f)); } } }
    }
    __device__ __forceinline__ void operator()(AccRef acc, const Unit& u, int wr, int wc, int fr, int fq) const {
#pragma unroll
        for (int ai = 0; ai < 2; ++ai)
#pragma unroll
            for (int bj = 0; bj < 2; ++bj) { const int row0 = u.pm * 256 + ai * 128 + wr * 64 + fr, colg = u.pn * 256 + bj * 128 + wc * 32; u32x2 pk[4];
#pragma unroll
                for (int m = 0; m < 4; ++m) { const u32x2 wb = *(const u32x2*)(G + (size_t)(row0 + 16 * m) * (2 * D) + D + colg + 8 * fq);
                    const f32x4 g0 = fmaxv(unpack4_u8(wb.x)) * (1.0f / 255.0f), g1 = fmaxv(unpack4_u8(wb.y)) * (1.0f / 255.0f);
                    const f32x4 o0 = acc[ai][bj][m][0] * g0, o1 = acc[ai][bj][m][1] * g1;
                    pk[m] = (u32x2){pack4_fp8(o0[0], o0[1], o0[2], o0[3]), pack4_fp8(o1[0], o1[1], o1[2], o1[3])}; }
                store_rows8(MG + (size_t)row0 * D + colg, D, pk, fq); }
    }
};
struct EpiWout { static constexpr bool TWO_PART = false;
    static constexpr bool PERM = true;
    unsigned char* MIXB;
    __device__ __forceinline__ void operator()(AccRef acc, const Unit& u, int wr, int wc, int fr, int fq) const {
#pragma unroll
        for (int ai = 0; ai < 2; ++ai)
#pragma unroll
            for (int bj = 0; bj < 2; ++bj) { u32x2 pk[4];
#pragma unroll
                for (int m = 0; m < 4; ++m) { const f32x4 a0 = acc[ai][bj][m][0], a1 = acc[ai][bj][m][1]; pk[m] = (u32x2){pack4_fp8(a0[0], a0[1], a0[2], a0[3]), pack4_fp8(a1[0], a1[1], a1[2], a1[3])}; }
                store_rows8(MIXB + (size_t)(u.pm * 256 + ai * 128 + wr * 64 + fr) * D + u.pn * 256 + bj * 128 + wc * 32, D, pk, fq); }
    }
};
struct EpiGU { static constexpr bool TWO_PART = false;
    static constexpr bool PERM = true;
    bf16_t* HID; bool active;
    __device__ __forceinline__ void operator()(AccRef acc, const Unit& u, int wr, int wc, int fr, int fq) const {
        if (!active) return;
        constexpr float dq = 1.0f / (SX * SW);
#pragma unroll
        for (int ai = 0; ai < 2; ++ai) { u32x2 pk[4];
#pragma unroll
            for (int m = 0; m < 4; ++m) { f32x4 o[2];
#pragma unroll
                for (int n = 0; n < 2; ++n)
                    { const f32x4 ga = i2f(acc[ai][0][m][n], 1.0f), up = i2f(acc[ai][1][m][n], 1.0f);
#pragma unroll
                    for (int j = 0; j < 4; ++j) o[n][j] = (ga[j] * up[j]) * __builtin_amdgcn_rcpf(__builtin_fmaf(__builtin_amdgcn_exp2f(ga[j] * (-LOG2E * dq)), 1.0f / (dq * dq), 1.0f / (dq * dq))); }
                pk[m] = (u32x2){pack4_fp8(o[0][0], o[0][1], o[0][2], o[0][3]), pack4_fp8(o[1][0], o[1][1], o[1][2], o[1][3])}; }
            store_rows8((unsigned char*)HID + (size_t)((u.pm >> 4) * ESLOTS + (u.pm & 15) * 256 + ai * 128 + wr * 64 + fr) * FF + u.pn * 128 + wc * 32, FF, pk, fq); }
    }
};
struct EpiDown { static constexpr bool TWO_PART = false;
    static constexpr bool PERM = true;
    unsigned char* Y; const float* GATE; bool active;
    __device__ __forceinline__ void operator()(AccRef acc, const Unit& u, int wr, int wc, int fr, int fq) const {
        if (!active) return;
#pragma unroll
        for (int ai = 0; ai < 2; ++ai) { const int row0 = (u.pm >> 4) * ESLOTS + (u.pm & 15) * 256 + ai * 128 + wr * 64 + fr; float g[4];
#pragma unroll
            for (int m = 0; m < 4; ++m) g[m] = GATE[row0 + 16 * m];
#pragma unroll
            for (int bj = 0; bj < 2; ++bj) { u32x2 pk[4];
#pragma unroll
                for (int m = 0; m < 4; ++m) { const f32x4 y0 = acc[ai][bj][m][0] * g[m], y1 = acc[ai][bj][m][1] * g[m]; pk[m] = (u32x2){pack4_fp8(y0[0], y0[1], y0[2], y0[3]), pack4_fp8(y1[0], y1[1], y1[2], y1[3])}; }
                store_rows8(Y + (size_t)row0 * D + u.pn * 256 + bj * 128 + wc * 32, D, pk, fq); } }
    }
};

__device__ __forceinline__ void transpose_item(const float* W, int K, int N, int k0, int n0, bf16_t* WT, int drow0, LAS float* scr, int lane) {
    float r[64];
#pragma unroll
    for (int kk = 0; kk < 64; ++kk) r[kk] = __builtin_nontemporal_load(W + (size_t)(k0 + kk) * N + n0 + lane);
#pragma unroll
    for (int kk = 0; kk < 64; ++kk) scr[kk * 65 + lane] = r[kk];
    LDS_WAIT(); asm volatile("" ::: "memory");
    const int c = lane & 7;
#pragma unroll
    for (int j = 0; j < 8; ++j) { const int n = (lane >> 3) + 8 * j; const LAS float* s = scr + (8 * c) * 65 + n;
        u32x4 o; o.x = cvtpk(s[0 * 65], s[1 * 65]); o.y = cvtpk(s[2 * 65], s[3 * 65]); o.z = cvtpk(s[4 * 65], s[5 * 65]); o.w = cvtpk(s[6 * 65], s[7 * 65]);
        *(u32x4*)(WT + (size_t)(drow0 + n) * K + k0 + 8 * c) = o; }
    LDS_WAIT(); asm volatile("" ::: "memory");
}
template <bool I8>
__device__ __forceinline__ void transpose_item_q(const float* W, int K, int N, int k0, int n0, unsigned char* WT, int drow0, float sc, LAS float* scr, int lane) {
    float r[64];
#pragma unroll
    for (int kk = 0; kk < 64; ++kk) r[kk] = __builtin_nontemporal_load(W + (size_t)(k0 + kk) * N + n0 + lane);
#pragma unroll
    for (int kk = 0; kk < 64; ++kk) scr[kk * 65 + lane] = r[kk] * sc;
    LDS_WAIT(); asm volatile("" ::: "memory");
    const int c = lane & 7;
#pragma unroll
    for (int j = 0; j < 8; ++j) { const int n = (lane >> 3) + 8 * j; const LAS float* s = scr + (8 * c) * 65 + n;
        u32x2 o; if constexpr (I8) { o.x = pack4_i8(s[0 * 65], s[1 * 65], s[2 * 65], s[3 * 65]); o.y = pack4_i8(s[4 * 65], s[5 * 65], s[6 * 65], s[7 * 65]); }
        else { o.x = pack4_fp8(s[0 * 65], s[1 * 65], s[2 * 65], s[3 * 65]); o.y = pack4_fp8(s[4 * 65], s[5 * 65], s[6 * 65], s[7 * 65]); }
        *(u32x2*)(WT + (size_t)(drow0 + n) * K + k0 + 8 * c) = o; }
    LDS_WAIT(); asm volatile("" ::: "memory");
}
__device__ __forceinline__ void ln_row(f32x4 (&v)[4], const f32x4 (&gm)[4], const f32x4 (&bt)[4], float& mean_o, float& rstd_o) {
    float s = 0.f;
#pragma unroll
    for (int j = 0; j < 4; ++j) s += (v[j][0] + v[j][1]) + (v[j][2] + v[j][3]);
    const float mean = wave_sum(s) * (1.f / D); float s2 = 0.f;
#pragma unroll
    for (int j = 0; j < 4; ++j) { v[j] = v[j] - mean; s2 += (v[j][0] * v[j][0] + v[j][1] * v[j][1]) + (v[j][2] * v[j][2] + v[j][3] * v[j][3]); }
    const float rstd = 1.0f / sqrtf(wave_sum(s2) * (1.f / D) + LN_EPS);
#pragma unroll
    for (int j = 0; j < 4; ++j) v[j] = v[j] * rstd * gm[j] + bt[j];
    mean_o = mean; rstd_o = rstd;
}
__device__ __forceinline__ void ln_row(f32x4 (&v)[4], const f32x4 (&gm)[4], const f32x4 (&bt)[4]) { float a, b; ln_row(v, gm, bt, a, b); }
__device__ __forceinline__ void ln_apply(f32x4 (&v)[4], const f32x4 (&gm)[4], const f32x4 (&bt)[4], float mean, float rstd) {
#pragma unroll
    for (int j = 0; j < 4; ++j) { v[j] = v[j] - mean; v[j] = v[j] * rstd * gm[j] + bt[j]; }
}
typedef _Float16 f16x4 __attribute__((ext_vector_type(4)));
__device__ __forceinline__ f32x4 h2f(const f16x4 h) { return __builtin_convertvector(h, f32x4); }
__device__ __forceinline__ void store_row(const f32x4 (&v)[4], _Float16* hrow, unsigned char* h8row, int lane) {
#pragma unroll
    for (int j = 0; j < 4; ++j) { *(f16x4*)(hrow + 4 * lane + 256 * j) = __builtin_convertvector(v[j], f16x4); *(unsigned*)(h8row + 4 * lane + 256 * j) = pack4_i8(v[j][0] * SX, v[j][1] * SX, v[j][2] * SX, v[j][3] * SX); }
}

constexpr int CV_IN = 16 * 52, CV_A = 8 * 16, CV_O = 16 * 16, CV_E = 16 * 24  , CV_D = 24 * 16  ;
constexpr int CV_PER_LAYER = CV_IN + 2 * CV_A + CV_O + NE * (2 * CV_E + CV_D);
struct ConvDesc { const float* src; unsigned char* dst; int N, K; float sc; bool i8; };
__device__ __forceinline__ ConvDesc conv_desc(const Frame& F, int it) { ConvDesc d; const int l = it / CV_PER_LAYER; int r = it % CV_PER_LAYER;
    if (r < CV_IN) { const int kb = r / 52, nb = r % 52; d.N = INW; d.K = D; d.src = F.w_in + (size_t)l * D * INW + (size_t)(kb * 64) * INW + nb * 64; d.dst = WSP(unsigned char, WS_WIN) + (size_t)l * INW * D + (size_t)(nb * 64) * D + kb * 64; d.sc = SW; d.i8 = true; return d; } r -= CV_IN;
    if (r < CV_A) { const int kb = r / 16, nb = r % 16; d.N = D; d.K = AW; d.src = F.w_attn_o + (size_t)l * AW * D + (size_t)(kb * 64) * D + nb * 64; d.dst = WSP(unsigned char, WS_WA) + (size_t)l * D * AW + (size_t)(nb * 64) * AW + kb * 64; d.sc = (float)(1 << WAF_SHIFT); d.i8 = false; return d; } r -= CV_A;
    if (r < CV_A) { const int kb = r / 16, nb = r % 16; d.N = D; d.K = FW; d.src = F.w_four_o + (size_t)l * FW * D + (size_t)(kb * 64) * D + nb * 64; d.dst = WSP(unsigned char, WS_WF) + (size_t)l * D * FW + (size_t)(nb * 64) * FW + kb * 64; d.sc = (float)(1 << WAF_SHIFT); d.i8 = false; return d; } r -= CV_A;
    if (r < CV_O) { const int kb = r / 16, nb = r % 16; d.N = D; d.K = D; d.src = F.w_out + (size_t)l * D * D + (size_t)(kb * 64) * D + nb * 64; d.dst = WSP(unsigned char, WS_WOUT) + (size_t)l * D * D + (size_t)(nb * 64) * D + kb * 64; d.sc = (float)(1 << WOUT_SHIFT); d.i8 = false; return d; } r -= CV_O;
    const int e = r / (2 * CV_E + CV_D); r %= (2 * CV_E + CV_D);
    if (r < 2 * CV_E) { const int up = r / CV_E; r %= CV_E; const int kb = r / 24, nb = r % 24, n0 = nb * 64; d.N = FF; d.K = D;
        d.src = (up ? F.w_e_up : F.w_e_gate) + ((size_t)l * NE + e) * D * FF + (size_t)(kb * 64) * FF + n0;
        d.dst = WSP(unsigned char, WS_WGU) + ((size_t)l * NE + e) * (2 * FF) * D + (size_t)((n0 >> 7) * 256 + up * 128 + (n0 & 127)) * D + kb * 64; d.sc = SW; d.i8 = true; return d; }
    r -= 2 * CV_E;
    { const int kb = r / 16, nb = r % 16; d.N = D; d.K = FF; d.src = F.w_e_down + ((size_t)l * NE + e) * FF * D + (size_t)(kb * 64) * D + nb * 64;
      d.dst = WSP(unsigned char, WS_WD) + ((size_t)l * NE + e) * D * FF + (size_t)(nb * 64) * FF + kb * 64; d.sc = (float)(1 << WD_SHIFT); d.i8 = false; return d; } }
__device__ __forceinline__ void conv_item_regs(const ConvDesc& d, int lane) {
    float r[64];
#pragma unroll
    for (int kk = 0; kk < 64; ++kk) r[kk] = __builtin_nontemporal_load(d.src + (size_t)kk * d.N + lane);
    unsigned char* o = d.dst + (size_t)lane * d.K;
#pragma unroll
    for (int j = 0; j < 4; ++j) { u32x4 w;
        if (d.i8) { w.x = pack4_i8(r[16 * j] * d.sc, r[16 * j + 1] * d.sc, r[16 * j + 2] * d.sc, r[16 * j + 3] * d.sc); w.y = pack4_i8(r[16 * j + 4] * d.sc, r[16 * j + 5] * d.sc, r[16 * j + 6] * d.sc, r[16 * j + 7] * d.sc);
                    w.z = pack4_i8(r[16 * j + 8] * d.sc, r[16 * j + 9] * d.sc, r[16 * j + 10] * d.sc, r[16 * j + 11] * d.sc); w.w = pack4_i8(r[16 * j + 12] * d.sc, r[16 * j + 13] * d.sc, r[16 * j + 14] * d.sc, r[16 * j + 15] * d.sc); }
        else { w.x = pack4_fp8(r[16 * j] * d.sc, r[16 * j + 1] * d.sc, r[16 * j + 2] * d.sc, r[16 * j + 3] * d.sc); w.y = pack4_fp8(r[16 * j + 4] * d.sc, r[16 * j + 5] * d.sc, r[16 * j + 6] * d.sc, r[16 * j + 7] * d.sc);
               w.z = pack4_fp8(r[16 * j + 8] * d.sc, r[16 * j + 9] * d.sc, r[16 * j + 10] * d.sc, r[16 * j + 11] * d.sc); w.w = pack4_fp8(r[16 * j + 12] * d.sc, r[16 * j + 13] * d.sc, r[16 * j + 14] * d.sc, r[16 * j + 15] * d.sc); }
        *(u32x4*)(o + 16 * j) = w; }
}
__device__ __forceinline__ void conv_range_regs(const Frame& F, int cl, int first, int stride, int count) {
    int lane_ = F.lane; asm volatile("" : "+v"(lane_));
#pragma unroll 1
    for (int i = 0; i < count; ++i) { const int it = first + i * stride; if (it >= CV_PER_LAYER) break; const ConvDesc d = conv_desc(F, cl * CV_PER_LAYER + it); conv_item_regs(d, lane_); }
    asm volatile("s_waitcnt vmcnt(0)" ::: "memory");
}
#ifndef CV_NA
#define CV_NA 2
#endif
#ifndef CV_NB
#define CV_NB 2
#endif
constexpr int CV_SLOT_A = CV_NA * (256 - 141) * 8, CV_SLOT_B = CV_NB * 128 * 8;
__device__ __forceinline__ void conv_share_regs(const Frame& F, int cl) {
    const int pre = (F.G == 256) ? CV_SLOT_A + CV_SLOT_B : 0;
    conv_range_regs(F, cl, pre + F.bid * 8 + F.wave, F.G * 8, CV_PER_LAYER);
}
__device__ __forceinline__ void p0_prologue(Frame& F) {
    const int gw = F.bid * 8 + F.wave, NGW = F.G * 8, gt = F.bid * 512 + F.tid, NGT = F.G * 512;
    {
        LAS float* scr = (LAS float*)(F.lds + F.wave * 16640);
        constexpr int TOTAL = CV_PER_LAYER * CONV_P0_LAYERS;
        typedef ConvDesc Desc;
        auto make = [&](int it) -> Desc { return conv_desc(F, it); };
#define P0_LOAD(d, r) do { _Pragma("unroll") for (int kk = 0; kk < 64; ++kk) r[kk] = __builtin_nontemporal_load((d).src + (size_t)kk * (d).N + F.lane); } while (0)
#define P0_FINISH(d, r) do { _Pragma("unroll") for (int kk = 0; kk < 64; ++kk) scr[kk * 65 + F.lane] = r[kk] * (d).sc; \
            LDS_WAIT(); asm volatile("" ::: "memory"); const int c_ = F.lane & 7; \
            _Pragma("unroll") for (int j = 0; j < 8; ++j) { const int n_ = (F.lane >> 3) + 8 * j; const LAS float* s_ = scr + (8 * c_) * 65 + n_; u32x2 o_; \
                if ((d).i8) { o_.x = pack4_i8(s_[0 * 65], s_[1 * 65], s_[2 * 65], s_[3 * 65]); o_.y = pack4_i8(s_[4 * 65], s_[5 * 65], s_[6 * 65], s_[7 * 65]); } \
                else { o_.x = pack4_fp8(s_[0 * 65], s_[1 * 65], s_[2 * 65], s_[3 * 65]); o_.y = pack4_fp8(s_[4 * 65], s_[5 * 65], s_[6 * 65], s_[7 * 65]); } \
                *(u32x2*)((d).dst + (size_t)n_ * (d).K + 8 * c_) = o_; } \
            LDS_WAIT(); asm volatile("" ::: "memory"); } while (0)
        float r0[64], r1[64]; Desc d0, d1;
        if (gw < TOTAL) { d0 = make(gw); P0_LOAD(d0, r0); }
#pragma unroll 1
        for (int it = gw; it < TOTAL; it += 2 * NGW) {
            const bool v1 = it + NGW < TOTAL; if (v1) { d1 = make(it + NGW); P0_LOAD(d1, r1); }
            P0_FINISH(d0, r0);
            if (it + 2 * NGW < TOTAL) { d0 = make(it + 2 * NGW); P0_LOAD(d0, r0); }
            if (v1) P0_FINISH(d1, r1);
        }
#undef P0_LOAD
#undef P0_FINISH
    }
    {
        const float sc = 127.0f, invL = 1.0f / (float)LSEQ;
        unsigned char* M = WSP(unsigned char, WS_DFTM);
        for (int ch = gt; ch < DK * (DK / 16); ch += NGT) { const int k = ch / (DK / 16), j0 = (ch % (DK / 16)) * 16; float v[16];
#pragma unroll
            for (int jj = 0; jj < 16; ++jj) { const int j = j0 + jj; float val = 0.f;
                if (k < LSEQ) { if (j <= HALFL) val = __builtin_amdgcn_cosf((float)((k * j) % LSEQ) * invL) * sc;
                                else if (j >= QOFF && j - QOFF <= HALFL) val = -__builtin_amdgcn_sinf((float)((k * (j - QOFF)) % LSEQ) * invL) * sc; }
                v[jj] = val; }
            u32x4 o; o.x = pack4_i8(v[0], v[1], v[2], v[3]); o.y = pack4_i8(v[4], v[5], v[6], v[7]); o.z = pack4_i8(v[8], v[9], v[10], v[11]); o.w = pack4_i8(v[12], v[13], v[14], v[15]);
            *(u32x4*)(M + (size_t)k * DK + j0) = o; }
        bf16_t* C = WSP(bf16_t, WS_CSM);
        for (int idx = gt; idx < 256 * 256; idx += NGT) { const int n = idx >> 8, c = idx & 255; float val = 0.f;
            if (c < 128) { const float ph = (float)(((n & 127) * c) & 127) * (1.0f / 128.0f); val = (n < 128) ? __builtin_amdgcn_cosf(ph) : __builtin_amdgcn_sinf(ph); }
            C[idx] = f2bf(val); }
    }
    {
        u32x4 z = {0u, 0u, 0u, 0u};
        u32x4* vt = WSP(u32x4, WS_VT); for (int i = gt; i < (int)((size_t)BATCH * NKV * HD * VT_LD * 2 / 16); i += NGT) vt[i] = z;
        u32x4* ri = WSP(u32x4, WS_ROWIDX); for (int i = gt; i < NSLOT * 4 / 16; i += NGT) ri[i] = z;
        u32x4* ga = WSP(u32x4, WS_GATE); for (int i = gt; i < NSLOT * 4 / 16; i += NGT) ga[i] = z;
        u32x4* hp = (u32x4*)(WSP(unsigned char, WS_HB8) + (size_t)T * D); for (int i = gt; i < (TP - T) * D / 16; i += NGT) hp[i] = z;
    }
    {
        f32x4 gm[4], bt[4];
#pragma unroll
        for (int j = 0; j < 4; ++j) { gm[j] = *(const f32x4*)(F.ln0_g + 4 * F.lane + 256 * j); bt[j] = *(const f32x4*)(F.ln0_b + 4 * F.lane + 256 * j); }
        _Float16* H = WSP(_Float16, WS_H); unsigned char* HB = WSP(unsigned char, WS_HB8);
        for (int row = gw; row < T; row += NGW) { const int b = row / LSEQ, p = row - b * LSEQ;
            const float* src = (p < NMETA) ? F.meta + (size_t)p * D : F.x + ((size_t)b * SEQ + (p - NMETA)) * D;
            f32x4 v[4];
#pragma unroll
            for (int j = 0; j < 4; ++j) v[j] = *(const f32x4*)(src + 4 * F.lane + 256 * j);
            ln_row(v, gm, bt); store_row(v, H + (size_t)row * D, HB + (size_t)row * D, F.lane); }
    }
}

constexpr float RESCALE_THR = 8.0f;
__device__ __forceinline__ void attn_phase(Frame& F, int layer) {
    const bf16_t* Q = WSP(bf16_t, WS_Q); const bf16_t* KB = WSP(bf16_t, WS_KB); const bf16_t* VT = WSP(bf16_t, WS_VT); unsigned char* ATT = WSP(unsigned char, WS_ATT);
    LAS unsigned char* Ks = F.lds; LAS unsigned char* Vs = F.lds + 40960;
    int tid_ = F.tid; asm volatile("" : "+v"(tid_)); const int tid = tid_, lane = tid & 63, r32 = lane & 31, hi = lane >> 5, w = F.wave;
    u32x4 kreg[5], vreg[5];
#define ATT_LOAD(uu) do { const int qt_ = (uu) < 1024 ? ((uu) & 63) : 64, bk_ = (uu) < 1024 ? ((uu) >> 6) : (uu) - 1024, kvh_ = bk_ & 1, b_ = bk_ >> 1, kb_ = qt_ * 64 - 128; \
        _Pragma("unroll") for (int i = 0; i < 5; ++i) { const int c = tid + 512 * i, row = c >> 3, ch = c & 7; int pos = kb_ + row; pos = pos < 0 ? 0 : (pos > LSEQ - 1 ? LSEQ - 1 : pos); \
            kreg[i] = *(const u32x4*)(KB + (size_t)(b_ * LSEQ + pos) * 128 + kvh_ * 64 + ch * 8); } \
        _Pragma("unroll") for (int i = 0; i < 5; ++i) { const int c = tid + 512 * i, d = c / 40, ch = c - d * 40; \
            vreg[i] = *(const u32x4*)(VT + (size_t)((b_ * NKV + kvh_) * HD + d) * VT_LD + VT_OFF + kb_ + ch * 8); } } while (0)
    bf16x8 qf[4];
#define ATT_LOADQ(uu) do { const int qt_ = (uu) < 1024 ? ((uu) & 63) : 64, bk_ = (uu) < 1024 ? ((uu) >> 6) : (uu) - 1024, kvh_ = bk_ & 1, b_ = bk_ >> 1; \
        const int qp_ = qt_ * 64 + 32 * (w & 1) + r32, qr_ = qp_ < LSEQ ? qp_ : LSEQ - 1; \
        _Pragma("unroll") for (int d0 = 0; d0 < 4; ++d0) qf[d0] = *(const bf16x8*)(Q + (size_t)(b_ * LSEQ + qr_) * AW + (kvh_ * 4 + (w >> 1)) * 64 + 16 * d0 + 8 * hi); } while (0)
    const float snk0 = __builtin_bit_cast(float, __builtin_amdgcn_readfirstlane(__builtin_bit_cast(int, F.sink[layer * NH + (w >> 1)])));
    const float snk1 = __builtin_bit_cast(float, __builtin_amdgcn_readfirstlane(__builtin_bit_cast(int, F.sink[layer * NH + 4 + (w >> 1)])));
    if (F.bid < BATCH * NKV * 65) { ATT_LOAD(F.bid); ATT_LOADQ(F.bid); }
#pragma unroll 1
    for (int u = F.bid; u < BATCH * NKV * 65; u += F.G) {
        const int qt = u < 1024 ? (u & 63) : 64, bk = u < 1024 ? (u >> 6) : u - 1024, kvh = bk & 1, b = bk >> 1, q0 = qt * 64, kb = q0 - 128;
        int tw = tid; asm volatile("" : "+v"(tw));
#pragma unroll
        for (int i = 0; i < 5; ++i) { const int c = tw + 512 * i, row = c >> 3, ch = c & 7;
            *(LAS u32x4*)(Ks + row * 128 + ((ch ^ ((row >> 1) & 7)) << 4)) = kreg[i]; }
#pragma unroll
        for (int i = 0; i < 5; ++i) { const int c = tw + 512 * i, d = c / 40, ch = c - d * 40; const u32x4 v = vreg[i];
            const int x = (d >> 1) & 15, g0 = 2 * ch;
            *(LAS u32x2*)(Vs + d * 640 + ((g0 ^ x) << 3)) = (u32x2){v.x, v.y};
            *(LAS u32x2*)(Vs + d * 640 + (((g0 + 1) ^ x) << 3)) = (u32x2){v.z, v.w}; }
        __syncthreads();
        asm volatile("" :: "v"(qf[0]), "v"(qf[1]), "v"(qf[2]), "v"(qf[3]));
        if (u + F.G < BATCH * NKV * 65) ATT_LOAD(u + F.G);
        if (q0 + 32 * (w & 1) < LSEQ) {
            const int hq = kvh * 4 + (w >> 1), sub = w & 1, qpos = q0 + 32 * sub + r32;
            const float slope2 = __builtin_amdgcn_exp2f(-(float)(hq + 1)) * LOG2E;
            float mrun = (kvh ? snk1 : snk0) * LOG2E, lsum = hi == 0 ? 1.0f : 0.0f;
            f32x16 o0 = {}, o1 = {};
            const int kbase = kb + 4 * hi; const float frel = (float)(kbase - qpos);
            const float dlo = (float)(qpos < 128 ? -qpos : -128), dhi = (float)((LSEQ - 1 - qpos) < 128 ? (LSEQ - 1 - qpos) : 128), dmid = 0.5f * (dlo + dhi), dhalf = 0.5f * (dhi - dlo);
            const bool inner = (q0 >= 128) && (q0 + 63 + 128 <= LSEQ - 1);
            const int sw = (r32 >> 1) & 7;
            LAS unsigned char* kp = Ks + r32 * 128;
            const int x0 = (r32 >> 1) & 15;
            LAS unsigned char* vp0 = Vs + r32 * 640;
            if (w >= 4) __builtin_amdgcn_s_sleep(10);
#pragma unroll
            for (int t = 0; t < 5; ++t) {
                f32x16 p0 = {}, p1 = {};
                LAS unsigned char* kt = kp + t * 8192;
#pragma unroll
                for (int d0 = 0; d0 < 4; ++d0) { const int c = 2 * d0 + hi;
                    const bf16x8 kf0 = *(const LAS bf16x8*)(kt + ((c ^ sw) << 4));
                    const bf16x8 kf1 = *(const LAS bf16x8*)(kt + 4096 + ((c ^ sw) << 4));
                    p0 = __builtin_amdgcn_mfma_f32_32x32x16_bf16(kf0, qf[d0], p0, 0, 0, 0);
                    p1 = __builtin_amdgcn_mfma_f32_32x32x16_bf16(kf1, qf[d0], p1, 0, 0, 0); }
                float tmax = -1e30f; float ft = frel + (float)(64 * t); asm volatile("" : "+v"(ft));
                if (inner && t >= 1 && t <= 3) {
                    float fa = ft; asm volatile("" : "+v"(fa));
#pragma unroll
                    for (int r = 0; r < 16; ++r) { const float cst = (float)((r & 3) + 8 * (r >> 2));
                        const float d0f = fa + cst, d1f = fa + (cst + 32.0f);
                        p0[r] = p0[r] - slope2 * fabsf(d0f); p1[r] = p1[r] - slope2 * fabsf(d1f);
                        tmax = fmaxf(tmax, fmaxf(p0[r], p1[r])); }
                } else {
                    float fb = ft; asm volatile("" : "+v"(fb)); const float fe = fb - dmid;
#pragma unroll
                    for (int r = 0; r < 16; ++r) { const float cst = (float)((r & 3) + 8 * (r >> 2));
                        const float d0f = fb + cst, d1f = fb + (cst + 32.0f), e0f = fe + cst, e1f = fe + (cst + 32.0f);
                        p0[r] = (fabsf(e0f) <= dhalf) ? p0[r] - slope2 * fabsf(d0f) : -1e30f; p1[r] = (fabsf(e1f) <= dhalf) ? p1[r] - slope2 * fabsf(d1f) : -1e30f;
                        tmax = fmaxf(tmax, fmaxf(p0[r], p1[r])); }
                }
                tmax = fmaxf(tmax, __shfl_xor(tmax, 32));
                const float mnew = (tmax - mrun > RESCALE_THR) ? tmax : mrun, alpha = __builtin_amdgcn_exp2f(mrun - mnew); mrun = mnew;
                if (__any(alpha != 1.0f)) { lsum *= alpha; o0 = o0 * alpha; o1 = o1 * alpha; }
                float ps = 0.f;
#pragma unroll
                for (int r = 0; r < 16; ++r) { p0[r] = __builtin_amdgcn_exp2f(p0[r] - mnew); p1[r] = __builtin_amdgcn_exp2f(p1[r] - mnew); ps += p0[r] + p1[r]; }
                lsum += ps;
                u32x4 pw[4];
                pw[0] = (u32x4){cvtpk(p0[0], p0[1]), cvtpk(p0[2], p0[3]), cvtpk(p0[4], p0[5]), cvtpk(p0[6], p0[7])};
                pw[1] = (u32x4){cvtpk(p0[8], p0[9]), cvtpk(p0[10], p0[11]), cvtpk(p0[12], p0[13]), cvtpk(p0[14], p0[15])};
                pw[2] = (u32x4){cvtpk(p1[0], p1[1]), cvtpk(p1[2], p1[3]), cvtpk(p1[4], p1[5]), cvtpk(p1[6], p1[7])};
                pw[3] = (u32x4){cvtpk(p1[8], p1[9]), cvtpk(p1[10], p1[11]), cvtpk(p1[12], p1[13]), cvtpk(p1[14], p1[15])};
                LAS unsigned char* vt0 = vp0 + t * 128;
#pragma unroll
                for (int ks = 0; ks < 4; ++ks) { const int gl = 4 * ks + hi; const int ol = (gl ^ x0) << 3, oh = ((gl + 2) ^ x0) << 3;
                    { const u32x2 lo = *(const LAS u32x2*)(vt0 + ol), h8 = *(const LAS u32x2*)(vt0 + oh);
                      const u32x4 vf = {lo.x, lo.y, h8.x, h8.y}; o0 = __builtin_amdgcn_mfma_f32_32x32x16_bf16(__builtin_bit_cast(bf16x8, vf), __builtin_bit_cast(bf16x8, pw[ks]), o0, 0, 0, 0); }
                    { const u32x2 lo = *(const LAS u32x2*)(vt0 + ol + 32 * 640), h8 = *(const LAS u32x2*)(vt0 + oh + 32 * 640);
                      const u32x4 vf = {lo.x, lo.y, h8.x, h8.y}; o1 = __builtin_amdgcn_mfma_f32_32x32x16_bf16(__builtin_bit_cast(bf16x8, vf), __builtin_bit_cast(bf16x8, pw[ks]), o1, 0, 0, 0); } }
            }
            if (u + F.G < BATCH * NKV * 65) ATT_LOADQ(u + F.G);
            const float ltot = lsum + __shfl_xor(lsum, 32), inv = 1.0f / ltot;
            if (qpos < LSEQ) { unsigned char* orow = ATT + (size_t)(b * LSEQ + qpos) * AW + hq * 64 + 4 * hi;
#pragma unroll
                for (int rq = 0; rq < 4; ++rq) {
                    *(unsigned*)(orow + 8 * rq) = pack4_fp8(o0[4 * rq] * inv, o0[4 * rq + 1] * inv, o0[4 * rq + 2] * inv, o0[4 * rq + 3] * inv);
                    *(unsigned*)(orow + 32 + 8 * rq) = pack4_fp8(o1[4 * rq] * inv, o1[4 * rq + 1] * inv, o1[4 * rq + 2] * inv, o1[4 * rq + 3] * inv); } }
        }
        __syncthreads();
    }
#undef ATT_LOAD
#undef ATT_LOADQ
}

__device__ __forceinline__ void reduce_scatter32(float (&a)[32], int lane) {
#pragma unroll
    for (int i = 0; i < 16; ++i) { const auto r = __builtin_amdgcn_permlane32_swap(__builtin_bit_cast(unsigned, a[i]), __builtin_bit_cast(unsigned, a[i + 16]), false, false);
        unsigned r0 = r[0], r1 = r[1]; asm volatile("" : "+v"(r0), "+v"(r1));
        a[i] = __builtin_bit_cast(float, r0) + __builtin_bit_cast(float, r1); }
#pragma unroll
    for (int i = 0; i < 8; ++i) { const auto r = __builtin_amdgcn_permlane16_swap(__builtin_bit_cast(unsigned, a[i]), __builtin_bit_cast(unsigned, a[i + 8]), false, false);
        unsigned r0 = r[0], r1 = r[1]; asm volatile("" : "+v"(r0), "+v"(r1));
        a[i] = __builtin_bit_cast(float, r0) + __builtin_bit_cast(float, r1); }
    { const bool up = (lane & 8) != 0;
#pragma unroll
      for (int i = 0; i < 4; ++i) { const float keep = up ? a[i + 4] : a[i], send = up ? a[i] : a[i + 4]; a[i] = keep + dpp_xor8(send); } }
    { const bool up = (lane & 4) != 0;
#pragma unroll
      for (int i = 0; i < 2; ++i) { const float keep = up ? a[i + 2] : a[i], send = up ? a[i] : a[i + 2]; a[i] = keep + dpp_xor4(send); } }
    { const bool up = (lane & 2) != 0; const float keep = up ? a[1] : a[0], send = up ? a[0] : a[1]; a[0] = keep + dpp_xor2(send); }
    a[0] += dpp_xor1(a[0]);
}
__device__ __forceinline__ void ln1_router_phase(Frame& F, int layer, unsigned char* HBo) {
    LAS float* WrL = (LAS float*)F.lds;
    int tid_ = F.tid; asm volatile("" : "+v"(tid_)); const int lane = tid_ & 63;
    { const float* wr = F.w_router + (size_t)layer * D * NE;
      for (int idx = tid_; idx < D * NE; idx += 512) { const int d = idx >> 4, e = idx & 15, ln = (d & 255) >> 2, j = d >> 8, i = d & 3; WrL[ln * 260 + (j * 4 + i) * 16 + e] = wr[idx]; } }
    __syncthreads();
    f32x4 gm[4], bt[4];
#pragma unroll
    for (int j = 0; j < 4; ++j) { gm[j] = *(const f32x4*)(F.ln1_g + (size_t)layer * D + 4 * lane + 256 * j); bt[j] = *(const f32x4*)(F.ln1_b + (size_t)layer * D + 4 * lane + 256 * j); }
    const _Float16* H = WSP(_Float16, WS_H); _Float16* Hw = WSP(_Float16, WS_H); const unsigned char* MIXB = WSP(unsigned char, WS_MIXB); float* AFFT = WSP(float, WS_AFFT);
    const int gw = F.bid * 8 + F.wave, NGW = F.G * 8;
    f16x4 yn[2][4]; unsigned mn[2][4];
#define LN1_LOAD(g_) do { _Pragma("unroll") for (int tk = 0; tk < 2; ++tk) _Pragma("unroll") for (int j = 0; j < 4; ++j) { \
        yn[tk][j] = *(const f16x4*)(H + (size_t)((g_) * 2 + tk) * D + 4 * lane + 256 * j); mn[tk][j] = *(const unsigned*)(MIXB + (size_t)((g_) * 2 + tk) * D + 4 * lane + 256 * j); } } while (0)
    if (gw < T / 2) LN1_LOAD(gw);
#pragma unroll 1
    for (int grp = gw; grp < T / 2; grp += NGW) {
        const int row0 = grp * 2;
        f32x4 y[2][4];
#pragma unroll
        for (int tk = 0; tk < 2; ++tk)
#pragma unroll
            for (int j = 0; j < 4; ++j) y[tk][j] = h2f(yn[tk][j]) * ALPHA + unpack4_fp8(mn[tk][j]);
        if (grp + NGW < T / 2) LN1_LOAD(grp + NGW);
#pragma unroll
        for (int tk = 0; tk < 2; ++tk) { ln_row(y[tk], gm, bt);
#pragma unroll
            for (int j = 0; j < 4; ++j) *(f16x4*)(Hw + (size_t)(row0 + tk) * D + 4 * lane + 256 * j) = __builtin_convertvector(y[tk][j], f16x4);
#pragma unroll
            for (int j = 0; j < 4; ++j) *(unsigned*)(HBo + (size_t)(row0 + tk) * D + 4 * lane + 256 * j) = pack4_i8(y[tk][j][0] * SX, y[tk][j][1] * SX, y[tk][j][2] * SX, y[tk][j][3] * SX); }
        f32x2_t acc2[16];
#pragma unroll
        for (int i = 0; i < 16; ++i) acc2[i] = (f32x2_t){0.f, 0.f};
#pragma unroll
        for (int ji = 0; ji < 16; ++ji) { if ((ji & 1) == 0) asm volatile("" ::: "memory");
            const LAS f32x4* wp = (const LAS f32x4*)(WrL + lane * 260 + ji * 16); const f32x4 w0 = wp[0], w1 = wp[1], w2 = wp[2], w3 = wp[3];
#pragma unroll
            for (int tk = 0; tk < 2; ++tk) { const float yv = y[tk][ji >> 2][ji & 3];
                { const f32x2_t y2 = {yv, yv};
                  acc2[tk * 8 + 0] += y2 * (f32x2_t){w0[0], w0[1]}; acc2[tk * 8 + 1] += y2 * (f32x2_t){w0[2], w0[3]}; acc2[tk * 8 + 2] += y2 * (f32x2_t){w1[0], w1[1]}; acc2[tk * 8 + 3] += y2 * (f32x2_t){w1[2], w1[3]};
                  acc2[tk * 8 + 4] += y2 * (f32x2_t){w2[0], w2[1]}; acc2[tk * 8 + 5] += y2 * (f32x2_t){w2[2], w2[3]}; acc2[tk * 8 + 6] += y2 * (f32x2_t){w3[0], w3[1]}; acc2[tk * 8 + 7] += y2 * (f32x2_t){w3[2], w3[3]}; } } }
        float acc[32];
#pragma unroll
        for (int i = 0; i < 16; ++i) { acc[2 * i] = acc2[i][0]; acc[2 * i + 1] = acc2[i][1]; }
        reduce_scatter32(acc, lane);
        const float logit = acc[0]; float mx = logit;
        mx = fmaxf(mx, dpp_xor2(mx)); mx = fmaxf(mx, dpp_xor4(mx)); mx = fmaxf(mx, dpp_xor8(mx)); mx = fmaxf(mx, __shfl_xor(mx, 16));
        const float ex = __expf(logit - mx); float sm = ex;
        sm += dpp_xor2(sm); sm += dpp_xor4(sm); sm += dpp_xor8(sm); sm += __shfl_xor(sm, 16);
        if ((lane & 1) == 0) { const int row = row0 + (lane >> 5), e = (lane >> 1) & 15, b = row / LSEQ, p = row - b * LSEQ;
            AFFT[(size_t)(b * NE + e) * AFF_LD + p] = ex / sm; }
    }
#undef LN1_LOAD
}

__device__ __forceinline__ void topk_phase(Frame& F) {
    LAS unsigned* cnt = (LAS unsigned*)F.lds; LAS unsigned* pre = cnt + 64;
    const float* AFFT = WSP(float, WS_AFFT); int* ROWIDX = WSP(int, WS_ROWIDX); float* GATE = WSP(float, WS_GATE); int* SLOTMAP = WSP(int, WS_SLOTMAP);
    int tid_ = F.tid; asm volatile("" : "+v"(tid_)); const int tid = tid_, lane = tid & 63, wave = F.wave;
    for (int item = F.bid; item < BATCH * NE; item += F.G) {
        const int b = item >> 4, e = item & 15; const float* a = AFFT + (size_t)item * AFF_LD;
        unsigned key[9];
#pragma unroll
        for (int i = 0; i < 9; ++i) { const int p = tid * 9 + i; key[i] = p < LSEQ ? __float_as_uint(a[p]) : 0u; }
        unsigned thr = 0u;
#pragma unroll 1
        for (int it = 0; it < 15; ++it) { const unsigned hb = 1u << (30 - 2 * it), lb = hb >> 1, c10 = thr | hb, c01 = thr | lb, c11 = c10 | lb; unsigned n10 = 0, n01 = 0, n11 = 0;
#pragma unroll
            for (int i = 0; i < 9; ++i) { n10 += (unsigned)__popcll(__ballot(key[i] >= c10)); n01 += (unsigned)__popcll(__ballot(key[i] >= c01)); n11 += (unsigned)__popcll(__ballot(key[i] >= c11)); }
            if (lane == 0) { cnt[(it & 1) * 24 + wave * 3 + 0] = n10; cnt[(it & 1) * 24 + wave * 3 + 1] = n01; cnt[(it & 1) * 24 + wave * 3 + 2] = n11; }
            __syncthreads();
            unsigned t10 = 0, t01 = 0, t11 = 0;
#pragma unroll
            for (int w2 = 0; w2 < 8; ++w2) { t10 += cnt[(it & 1) * 24 + w2 * 3 + 0]; t01 += cnt[(it & 1) * 24 + w2 * 3 + 1]; t11 += cnt[(it & 1) * 24 + w2 * 3 + 2]; }
            if (t10 >= (unsigned)CAP) thr = (t11 >= (unsigned)CAP) ? c11 : c10; else if (t01 >= (unsigned)CAP) thr = c01; }
        { const unsigned cand = thr | 1u; unsigned c = 0;
#pragma unroll
            for (int i = 0; i < 9; ++i) c += (unsigned)__popcll(__ballot(key[i] >= cand));
            if (lane == 0) cnt[24 + wave * 3] = c;
            __syncthreads();
            unsigned tot = 0;
#pragma unroll
            for (int w2 = 0; w2 < 8; ++w2) tot += cnt[24 + w2 * 3];
            if (tot >= (unsigned)CAP) thr = cand; }
        unsigned pg = 0, pe = 0;
#pragma unroll
        for (int i = 0; i < 9; ++i) { pg += key[i] > thr ? 1u : 0u; pe += key[i] == thr ? 1u : 0u; }
        unsigned v = pg | (pe << 16);
#pragma unroll
        for (int o = 1; o < 64; o <<= 1) { const unsigned t2 = __shfl_up(v, o); if (lane >= o) v += t2; }
        if (lane == 63) pre[wave] = v;
        __syncthreads();
        unsigned woff = 0, tot = 0;
#pragma unroll
        for (int w2 = 0; w2 < 8; ++w2) { const unsigned x = pre[w2]; if (w2 < wave) woff += x; tot += x; }
        const unsigned need = (unsigned)CAP - (tot & 0xffffu);
        unsigned excl = v - (pg | (pe << 16)) + woff; unsigned gtb = excl & 0xffffu, eqb = excl >> 16;
#pragma unroll
        for (int i = 0; i < 9; ++i) { const int p = tid * 9 + i; const bool isgt = key[i] > thr, iseq = key[i] == thr, sel = isgt || (iseq && eqb < need);
            if (p < LSEQ) { const int row = b * LSEQ + p; int s = -1;
                if (sel) { s = e * ESLOTS + b * CAP + (int)(gtb + (eqb < need ? eqb : need)); ROWIDX[s] = row; GATE[s] = __uint_as_float(key[i]); }
                SLOTMAP[(size_t)row * NE + e] = s; }
            gtb += isgt ? 1u : 0u; eqb += iseq ? 1u : 0u; }
        __syncthreads();
    }
}

__device__ __forceinline__ void combine_ln2_phase(Frame& F, int layer, _Float16* Ho, unsigned char* HBo) {
    int lane_ = F.lane; asm volatile("" : "+v"(lane_)); const int lane = lane_;
    f32x4 gm[4], bt[4];
#pragma unroll
    for (int j = 0; j < 4; ++j) { gm[j] = *(const f32x4*)(F.ln2_g + (size_t)layer * D + 4 * lane + 256 * j); bt[j] = *(const f32x4*)(F.ln2_b + (size_t)layer * D + 4 * lane + 256 * j); }
    const _Float16* H = WSP(_Float16, WS_H); const unsigned char* Y = WSP(unsigned char, WS_Y); const int* SLOTMAP = WSP(int, WS_SLOTMAP);
    const int gw = F.bid * 8 + F.wave, NGW = F.G * 8;
    f16x4 hvN[2][4]; unsigned mskN[2]; int slN[2][4]; unsigned ywN[2][4][4]; int smN[2];
    int smA[2] = {0, 0};
#define P10_SEL(r0_, sm_) do { _Pragma("unroll") for (int q = 0; q < 2; ++q) { const int row_ = (q == 0 || (r0_) + NGW >= T) ? (r0_) : (r0_) + NGW; sm_[q] = SLOTMAP[(size_t)row_ * NE + (lane & 15)]; } } while (0)
#define P10_LOAD(r0_, sm_) do { _Pragma("unroll") for (int q = 0; q < 2; ++q) { const int row_ = (q == 0 || (r0_) + NGW >= T) ? (r0_) : (r0_) + NGW; \
        _Pragma("unroll") for (int j = 0; j < 4; ++j) hvN[q][j] = *(const f16x4*)(H + (size_t)row_ * D + 4 * lane + 256 * j); \
        smN[q] = sm_[q]; \
        unsigned mm_ = (unsigned)__ballot(sm_[q] >= 0) & 0xffffu; \
        _Pragma("unroll") for (int k = 0; k < 4; ++k) { int s_ = -1; if (mm_) { const int e_ = __builtin_ctz(mm_); mm_ &= mm_ - 1; s_ = __builtin_amdgcn_readlane(sm_[q], e_); } slN[q][k] = s_; \
            const unsigned char* yr_ = Y + (size_t)(s_ >= 0 ? s_ : 0) * D + 4 * lane; \
            _Pragma("unroll") for (int j = 0; j < 4; ++j) ywN[q][k][j] = *(const unsigned*)(yr_ + 256 * j); } \
        mskN[q] = mm_; } } while (0)
    int rc = gw, rn = gw + 2 * NGW;
    { int sm0[2]; P10_SEL(rc, sm0); P10_LOAD(rc, sm0); }
    if (rn < T) P10_SEL(rn, smA);
#pragma unroll 1
    for (;;) {
        int rows[2]; rows[0] = rc; rows[1] = (rc + NGW < T) ? rc + NGW : rc;
        f32x4 v[2][4]; unsigned msk[2]; int sl[2][4]; int sm[2]; unsigned yw[2][4][4];
#pragma unroll
        for (int q = 0; q < 2; ++q) { msk[q] = mskN[q]; sm[q] = smN[q];
#pragma unroll
            for (int j = 0; j < 4; ++j) v[q][j] = h2f(hvN[q][j]) * ALPHA;
#pragma unroll
            for (int k = 0; k < 4; ++k) { sl[q][k] = slN[q][k];
#pragma unroll
                for (int j = 0; j < 4; ++j) yw[q][k][j] = ywN[q][k][j]; } }
        const bool has_next = rn < T; const int rnn = rn + 2 * NGW;
        if (has_next) { P10_LOAD(rn, smA); if (rnn < T) P10_SEL(rnn, smA); }
#pragma unroll
        for (int q = 0; q < 2; ++q) {
#pragma unroll
            for (int k = 0; k < 4; ++k) { const float wgt = sl[q][k] >= 0 ? 1.0f : 0.0f;
#pragma unroll
                for (int j = 0; j < 4; ++j) v[q][j] += unpack4_fp8(yw[q][k][j]) * wgt; }
            unsigned mm = msk[q];
            while (mm) { const int e = __builtin_ctz(mm); mm &= mm - 1; const int s = __builtin_amdgcn_readlane(sm[q], e); const unsigned char* yr = Y + (size_t)s * D + 4 * lane;
#pragma unroll
                for (int j = 0; j < 4; ++j) v[q][j] += unpack4_fp8(*(const unsigned*)(yr + 256 * j)); }
            ln_row(v[q], gm, bt);
            if (q == 0 || rows[1] != rows[0]) {
                if (layer < DEPTH - 1) store_row(v[q], Ho + (size_t)rows[q] * D, HBo + (size_t)rows[q] * D, lane);
                else { const int b = rows[q] / LSEQ, p = rows[q] - b * LSEQ;
                    if (p >= NMETA) { float* o = F.out + ((size_t)b * SEQ + (p - NMETA)) * D;
#pragma unroll
                        for (int j = 0; j < 4; ++j) *(f32x4*)(o + 4 * lane + 256 * j) = v[q][j]; } } }
        }
        if (!has_next) break;
        rc = rn; rn = rnn;
    }
#undef P10_SEL
#undef P10_LOAD
}

template <class Dsc>
__device__ __forceinline__ void skinny_phase(Frame& F, const Dsc& S) {
    constexpr int NB = Dsc::NB;
    int tid_ = F.tid; asm volatile("" : "+v"(tid_)); const int tid = tid_, lane = tid & 63, fr = lane & 15, fq = lane >> 4, w = F.wave;
    LAS f32x4* red = (LAS f32x4*)F.lds;
#pragma unroll 1
    for (int t0 = F.bid; t0 < S.ntasks; t0 += F.G * NB) {
        f32x4 acc[NB][4];
#pragma unroll
        for (int b = 0; b < NB; ++b)
#pragma unroll
            for (int j = 0; j < 4; ++j) acc[b][j] = (f32x4){0.f, 0.f, 0.f, 0.f};
        const int ns = S.ksteps(w);
        if constexpr (Dsc::MODE == 2) {
            const unsigned char* ap[NB]; const unsigned char* bp[NB][4]; v4i_t ia[NB][4];
#pragma unroll
            for (int b = 0; b < NB; ++b) { int t = t0 + b * F.G; if (t >= S.ntasks) t = t0;
                ap[b] = S.a_ptr(t, w, fr) + 32 * fq;
#pragma unroll
                for (int j = 0; j < 4; ++j) { bp[b][j] = S.b_ptr(t, w, 16 * j + fr) + 32 * fq; ia[b][j] = (v4i_t){0, 0, 0, 0}; } }
#pragma unroll
            for (int s = 0; s < ns; ++s)
#pragma unroll
                for (int b = 0; b < NB; ++b) { const v4i_t a0 = *(const v4i_t*)(ap[b] + 128 * s), a1 = *(const v4i_t*)(ap[b] + 128 * s + 16);
#pragma unroll
                    for (int j = 0; j < 4; ++j) { const v4i_t b0 = *(const v4i_t*)(bp[b][j] + 128 * s), b1 = *(const v4i_t*)(bp[b][j] + 128 * s + 16);
                        ia[b][j] = __builtin_amdgcn_mfma_i32_16x16x64_i8(b0, a0, ia[b][j], 0, 0, 0); ia[b][j] = __builtin_amdgcn_mfma_i32_16x16x64_i8(b1, a1, ia[b][j], 0, 0, 0); } }
#pragma unroll
            for (int b = 0; b < NB; ++b)
#pragma unroll
                for (int j = 0; j < 4; ++j) acc[b][j] = (f32x4){(float)ia[b][j][0], (float)ia[b][j][1], (float)ia[b][j][2], (float)ia[b][j][3]};
        } else if constexpr (Dsc::MODE == 1) {
            static_assert(NB == 1, "batched passes: int8 descriptors only");
            const unsigned char* ap = S.a_ptr(t0, w, fr) + 32 * fq;
            const unsigned char* bp[4];
#pragma unroll
            for (int j = 0; j < 4; ++j) bp[j] = S.b_ptr(t0, w, 16 * j + fr) + 32 * fq;
#pragma unroll
            for (int s = 0; s < ns; ++s) { const v8i_t a = *(const v8i_t*)(ap + 128 * s);
#pragma unroll
                for (int j = 0; j < 4; ++j) { const v8i_t b = *(const v8i_t*)(bp[j] + 128 * s); acc[0][j] = __builtin_amdgcn_mfma_scale_f32_16x16x128_f8f6f4(b, a, acc[0][j], 0, 0, 0, Dsc::SCALE_W * 0x01010101, 0, 0x7f7f7f7f); } }
        } else {
            static_assert(NB == 1, "batched passes: int8 descriptors only");
            const bf16_t* ap = S.a_ptr(t0, w, fr) + 8 * fq;
            const bf16_t* bp[4];
#pragma unroll
            for (int j = 0; j < 4; ++j) bp[j] = S.b_ptr(t0, w, 16 * j + fr) + 8 * fq;
#pragma unroll 2
            for (int s = 0; s < ns; ++s) { const bf16x8 a = *(const bf16x8*)(ap + 32 * s);
#pragma unroll
                for (int j = 0; j < 4; ++j) { const bf16x8 b = *(const bf16x8*)(bp[j] + 32 * s); acc[0][j] = __builtin_amdgcn_mfma_f32_16x16x32_bf16(b, a, acc[0][j], 0, 0, 0); } }
        }
#pragma unroll
        for (int b = 0; b < NB; ++b)
#pragma unroll
            for (int j = 0; j < 4; ++j) red[((b * 8 + w) * 4 + j) * 64 + lane] = acc[b][j];
        __syncthreads();
#pragma unroll
        for (int b = 0; b < NB; ++b) { const int t = t0 + b * F.G; if (t >= S.ntasks) break; LAS f32x4* rb = red + b * 8 * 4 * 64;
            if constexpr (Dsc::PAIRED) {
                if (tid < 128) { const int j = tid >> 6; f32x4 ga = rb[(0 * 4 + j) * 64 + lane], up = rb[(0 * 4 + j + 2) * 64 + lane];
#pragma unroll
                    for (int ww = 1; ww < 8; ++ww) { ga += rb[(ww * 4 + j) * 64 + lane]; up += rb[(ww * 4 + j + 2) * 64 + lane]; }
                    S.fin(t, fr, 16 * j + 4 * fq, ga, up); }
            } else
            if (tid < 256) { const int j = tid >> 6; f32x4 lo = rb[(0 * 4 + j) * 64 + lane], hi = rb[(4 * 4 + j) * 64 + lane];
#pragma unroll
                for (int ww = 1; ww < 4; ++ww) { lo += rb[(ww * 4 + j) * 64 + lane]; hi += rb[((4 + ww) * 4 + j) * 64 + lane]; }
                S.fin(t, fr, 16 * j + 4 * fq, lo, hi); } }
        __syncthreads();
    }
}

struct SkSeq { static constexpr int NB = 1; static constexpr int MODE = 2; static constexpr bool PAIRED = false;
    static constexpr int ntasks = 64;
    __device__ __forceinline__ int ksteps(int w) const { return 4 + (w < 2 ? 1 : 0); }
    __device__ __forceinline__ int kbeg(int w) const { return (4 * w + (w < 2 ? w : 2)) * 128; }
    const unsigned char* DFTM; const unsigned char* PQT; unsigned char* FOUR;
    __device__ __forceinline__ const unsigned char* a_ptr(int, int w, int r) const { return DFTM + (size_t)(4096 + r) * DK + kbeg(w); }
    __device__ __forceinline__ const unsigned char* b_ptr(int t, int w, int c) const { return PQT + (size_t)(64 * t + c) * DK + kbeg(w); }
    __device__ __forceinline__ void fin(int t, int r, int c, const f32x4 lo, const f32x4 hi) const { const int k = 4096 + r, n = 64 * t + c, b = n >> 9;
        const f32x4 z = (lo + hi) * (1.0f / (127.0f * sqrtf(128.0f * (float)LSEQ) * SPQ)); *(unsigned*)(FOUR + (size_t)(b * LSEQ + k) * FW + (n & 511)) = pack4_fp8(z[0], z[1], z[2], z[3]); }
};
struct SkMerge { static constexpr int NB = 1; static constexpr int MODE = 1; static constexpr bool PAIRED = false; static constexpr int SCALE_W = 127 - WAF_SHIFT;
    static constexpr int ntasks = 128, nsteps = 1; __device__ __forceinline__ int ksteps(int) const { return nsteps; }
    const unsigned char *ATT, *FOUR, *WA, *WF; const unsigned char* G; unsigned char* MG;
    __device__ __forceinline__ const unsigned char* a_ptr(int t, int w, int r) const { return ((w >> 2) ? FOUR : ATT) + (size_t)(32768 + 16 * (t >> 4) + r) * AW + (w & 3) * 128; }
    __device__ __forceinline__ const unsigned char* b_ptr(int t, int w, int c) const { return ((w >> 2) ? WF : WA) + (size_t)(64 * (t & 15) + c) * AW + (w & 3) * 128; }
    __device__ __forceinline__ void fin(int t, int r, int c, const f32x4 lo, const f32x4 hi) const { const int row = 32768 + 16 * (t >> 4) + r, col = 64 * (t & 15) + c;
        const f32x4 g0 = unpack4_u8(*(const unsigned*)(G + (size_t)row * (2 * D) + col)) * (1.0f / 255.0f), g1 = unpack4_u8(*(const unsigned*)(G + (size_t)row * (2 * D) + D + col)) * (1.0f / 255.0f);
        const f32x4 o = g0 * lo + g1 * hi; *(unsigned*)(MG + (size_t)row * D + col) = pack4_fp8(o[0], o[1], o[2], o[3]); }
};
struct SkWout { static constexpr int NB = 1; static constexpr int MODE = 1; static constexpr bool PAIRED = false; static constexpr int SCALE_W = 127 - WOUT_SHIFT;
    static constexpr int ntasks = 128, nsteps = 1; __device__ __forceinline__ int ksteps(int) const { return nsteps; }
    const unsigned char *MG, *WOUT; unsigned char* MIXB;
    __device__ __forceinline__ const unsigned char* a_ptr(int t, int w, int r) const { return MG + (size_t)(32768 + 16 * (t >> 4) + r) * D + w * 128; }
    __device__ __forceinline__ const unsigned char* b_ptr(int t, int w, int c) const { return WOUT + (size_t)(64 * (t & 15) + c) * D + w * 128; }
    __device__ __forceinline__ void fin(int t, int r, int c, const f32x4 lo, const f32x4 hi) const { const f32x4 o = lo + hi; *(unsigned*)(MIXB + (size_t)(32768 + 16 * (t >> 4) + r) * D + 64 * (t & 15) + c) = pack4_fp8(o[0], o[1], o[2], o[3]); }
};
struct SkDown { static constexpr int NB = 1; static constexpr int MODE = 1; static constexpr bool PAIRED = false; static constexpr int SCALE_W = 127 - WD_SHIFT;
    static constexpr int ntasks = NE * 8, nsteps = FF / 4 / 128; __device__ __forceinline__ int ksteps(int) const { return nsteps; }
    const unsigned char *HID, *WD; const float* GATE; unsigned char* Y;
    __device__ __forceinline__ const unsigned char* a_ptr(int t, int w, int r) const { return HID + (size_t)((t >> 3) * ESLOTS + 4096 + r) * FF + (w & 3) * (FF / 4); }
    __device__ __forceinline__ const unsigned char* b_ptr(int t, int w, int c) const { return WD + ((size_t)(t >> 3) * D + 128 * (t & 7) + 64 * (w >> 2) + c) * FF + (w & 3) * (FF / 4); }
    __device__ __forceinline__ void fin(int t, int r, int c, const f32x4 lo, const f32x4 hi) const { const int slot = (t >> 3) * ESLOTS + 4096 + r; const float g = GATE[slot];
        unsigned char* y = Y + (size_t)slot * D + 128 * (t & 7) + c; const f32x4 a = lo * g, b = hi * g; *(unsigned*)y = pack4_fp8(a[0], a[1], a[2], a[3]); *(unsigned*)(y + 64) = pack4_fp8(b[0], b[1], b[2], b[3]); }
};
struct SkGU { static constexpr int NB = 3; static constexpr int MODE = 2; static constexpr bool PAIRED = true;
    static constexpr int ntasks = NE * (FF / 32), nsteps = 1; __device__ __forceinline__ int ksteps(int) const { return nsteps; }
    const unsigned char *HB8, *WGU; const int* ROWIDX; unsigned char* HID;
    __device__ __forceinline__ const unsigned char* a_ptr(int t, int w, int r) const { const int e = t / (FF / 32); return HB8 + (size_t)ROWIDX[e * ESLOTS + 4096 + r] * D + w * 128; }
    __device__ __forceinline__ const unsigned char* b_ptr(int t, int w, int c) const { const int e = t / (FF / 32), hc = (t % (FF / 32)) * 32 + (c & 31), up = c >> 5;
        return WGU + ((size_t)e * (2 * FF) + (hc >> 7) * 256 + up * 128 + (hc & 127)) * D + w * 128; }
    __device__ __forceinline__ void fin(int t, int r, int c, const f32x4 ga, const f32x4 up) const { const int e = t / (FF / 32), slot = e * ESLOTS + 4096 + r, hc = (t % (FF / 32)) * 32 + c; f32x4 o;
#pragma unroll
        for (int j = 0; j < 4; ++j) { const float g = ga[j] * (1.0f / (SX * SW)); o[j] = g * fast_sigmoid(g) * (up[j] * (1.0f / (SX * SW))); }
        *(unsigned*)(HID + (size_t)slot * FF + hc) = pack4_fp8(o[0], o[1], o[2], o[3]); }
};

#ifndef PHASE_MASK
#define PHASE_MASK 0xFFFF
#endif
#define EN(k) ((PHASE_MASK >> (k)) & 1)
#ifndef REP_PHASE
#define REP_PHASE -1
#endif
#ifndef REP_NOEPI
#define REP_NOEPI 0
#endif
#define NREP(k) ((REP_PHASE) == (k) ? 2 : 1)
#define EPI_ON(k) (!(REP_NOEPI && NREP(k) == 2 && rep == 1))
constexpr int PH_PER_LAYER = 10, N_PHASES = 1 + DEPTH * PH_PER_LAYER;
struct Args { const float* in[18]; float* out; unsigned char* ws; int ph_lo, ph_hi; };
template <bool ALL>
__global__ void __launch_bounds__(512, 2) mk_fwd(Args args) {
    extern __shared__ __attribute__((aligned(16))) unsigned char lds_raw[];
    Frame F;
    F.lds = (LAS unsigned char*)lds_raw;
    F.tid = threadIdx.x; F.lane = F.tid & 63; F.wave = __builtin_amdgcn_readfirstlane(F.tid >> 6); F.G = gridDim.x; F.bid = blockIdx.x;
    F.x = args.in[0]; F.meta = args.in[1]; F.ln0_g = args.in[2]; F.ln0_b = args.in[3]; F.w_in = args.in[4]; F.b_gate = args.in[5]; F.sink = args.in[6];
    F.w_attn_o = args.in[7]; F.w_four_o = args.in[8]; F.w_out = args.in[9]; F.ln1_g = args.in[10]; F.ln1_b = args.in[11]; F.w_router = args.in[12];
    F.w_e_gate = args.in[13]; F.w_e_up = args.in[14]; F.w_e_down = args.in[15]; F.ln2_g = args.in[16]; F.ln2_b = args.in[17];
    F.out = args.out; F.ws = args.ws;
    volatile LAS unsigned* MISC = (volatile LAS unsigned*)(F.lds + MISC_OFF);
    if (F.tid < 64) MISC[F.tid] = 0u;
    __syncthreads();
    const int lo = ALL ? 0 : args.ph_lo, hi = ALL ? (MK_DEBUG ? 3 : N_PHASES) : args.ph_hi;
    unsigned* ctl = (unsigned*)(F.ws + WS_CTL);
    XcdBarrier bar; bar.bar = ctl + CW_BAR; bar.x = 0; bar.st = nullptr;
    if (hi - lo > 1) bar = xcd_barrier_post(ctl + CW_BAR, MISC + 8);
#define IN(k) (ALL ? (!MK_DEBUG || (k) < 3) : (lo <= (k) && (k) < hi))
#if defined(MK_PROBE_A)
    unsigned long long* ts = (unsigned long long*)(ctl + 2048);
#define STAMP(i) do { if (F.bid == 0 && F.tid == 0) ts[i] = __builtin_amdgcn_s_memrealtime(); } while (0)
#define SEAM(k) do { xcd_barrier(bar); STAMP((k) + 1); } while (0)
    STAMP(0);
#else
#define SEAM(k) do { if (IN(k) && IN((k) + 1)) xcd_barrier(bar); } while (0)
#endif
    LAS unsigned char* ring = F.lds;

    if (EN(0) && IN(0)) { for (int rep = 0; rep < NREP(0); ++rep) { p0_prologue(F); if (rep + 1 < NREP(0)) xcd_barrier(bar); } }
    SEAM(0);
    for (int layer = 0; layer < DEPTH; ++layer) {
        const int pb = 1 + layer * PH_PER_LAYER;
        if (EN(1) && IN(pb + 0)) for (int rep = 0; rep < NREP(1); ++rep) { if (rep) xcd_barrier(bar);
            SchedInProj S; S.o.init(TP / 256, INW / 256, F.G, F.bid); S.o1.init(128, 8, F.G, F.bid); S.o2.init(129, 5, F.G, F.bid); S.bal = (F.G == 256);
            S.A = (const char*)WSP(unsigned char, WS_HB8); S.B = (const char*)(WSP(unsigned char, WS_WIN) + (size_t)layer * INW * D); S.lda = D; S.ldb = D;
            EpiInProj E{WSP(bf16_t, WS_Q), WSP(bf16_t, WS_KB), WSP(bf16_t, WS_VT), WSP(bf16_t, WS_UF), WSP(unsigned char, WS_G), F.b_gate + (size_t)layer * 2 * D, EPI_ON(1)};
            pg8::gemm_phase<EpiInProj, SchedInProj, true, 2>(ring, S, E, D, D);
            if (F.G == 256 && F.bid >= 141 && layer + 1 < DEPTH && layer + 1 >= CONV_P0_LAYERS && rep == 0) conv_range_regs(F, layer + 1, (F.bid - 141) * 8 + F.wave, (256 - 141) * 8, CV_NA);
        }
        SEAM(pb + 0);
        if (EN(2) && IN(pb + 1)) for (int rep = 0; rep < NREP(2); ++rep) { if (rep) xcd_barrier(bar);
#ifndef NO_ATTN
#ifdef REP_CHAN_ONLY
            if (rep == 0)
#endif
            attn_phase(F, layer);
#endif
#ifndef NO_CHAN
            const bool skip16 = (F.G > 64);
            SchedChan S; S.o.init(BATCH * 4 * 17, 1, skip16 ? F.G - 16 : F.G, skip16 ? (F.bid < 16 ? BATCH * 4 * 17 : F.bid - 16) : F.bid); S.UF = (const char*)WSP(bf16_t, WS_UF); S.CSM = (const char*)WSP(bf16_t, WS_CSM);
            EpiChan E{WSP(unsigned char, WS_PQT)};
            pg8::gemm_phase<EpiChan, SchedChan, true>(ring, S, E, 256, 512);
#endif
        }
        SEAM(pb + 1);
        if (EN(3) && IN(pb + 2)) for (int rep = 0; rep < NREP(3); ++rep) { if (rep) xcd_barrier(bar);
            { SchedReg S; S.o.init(4096 / 256, 4096 / 256, F.G, F.bid); S.A = (const char*)WSP(unsigned char, WS_DFTM); S.B = (const char*)WSP(unsigned char, WS_PQT); S.lda = DK; S.ldb = DK;
              EpiSeq E{WSP(unsigned char, WS_FOUR)};
              pg8::gemm_phase<EpiSeq, SchedReg, true, 2>(ring, S, E, DK, DK); }
            { SkSeq K{WSP(unsigned char, WS_DFTM), WSP(unsigned char, WS_PQT), WSP(unsigned char, WS_FOUR)}; skinny_phase(F, K); }
        }
        SEAM(pb + 2);
        if (EN(4) && IN(pb + 3)) for (int rep = 0; rep < NREP(4); ++rep) { if (rep) xcd_barrier(bar);
            SchedMerge S; S.o.init(32768 / 256, D / 256, F.G, F.bid); S.ATT = (const char*)WSP(unsigned char, WS_ATT); S.FOUR = (const char*)WSP(unsigned char, WS_FOUR);
            S.WA = (const char*)(WSP(unsigned char, WS_WA) + (size_t)layer * D * AW); S.WF = (const char*)(WSP(unsigned char, WS_WF) + (size_t)layer * D * FW);
            EpiMerge E{WSP(unsigned char, WS_MG), WSP(unsigned char, WS_G)};
            pg8::gemm_phase<EpiMerge, SchedMerge, true, 1, 127 - WAF_SHIFT>(ring, S, E, AW, AW);
            { SkMerge K{WSP(unsigned char, WS_ATT), WSP(unsigned char, WS_FOUR), WSP(unsigned char, WS_WA) + (size_t)layer * D * AW, WSP(unsigned char, WS_WF) + (size_t)layer * D * FW, WSP(unsigned char, WS_G), WSP(unsigned char, WS_MG)}; skinny_phase(F, K); }
        }
        SEAM(pb + 3);
        if (EN(5) && IN(pb + 4)) for (int rep = 0; rep < NREP(5); ++rep) { if (rep) xcd_barrier(bar);
            SchedReg S; S.o.init(32768 / 256, D / 256, F.G, F.bid); S.A = (const char*)WSP(unsigned char, WS_MG); S.B = (const char*)(WSP(unsigned char, WS_WOUT) + (size_t)layer * D * D); S.lda = D; S.ldb = D;
            EpiWout E{(NREP(5) == 2 && rep == 0) ? WSP(unsigned char, WS_Q) : WSP(unsigned char, WS_MIXB)};
            pg8::gemm_phase<EpiWout, SchedReg, true, 1, 127 - WOUT_SHIFT>(ring, S, E, D, D);
            { SkWout K{WSP(unsigned char, WS_MG), WSP(unsigned char, WS_WOUT) + (size_t)layer * D * D, (NREP(5) == 2 && rep == 0) ? WSP(unsigned char, WS_Q) : WSP(unsigned char, WS_MIXB)}; skinny_phase(F, K); }
        }
        SEAM(pb + 4);
        if (EN(6) && IN(pb + 5)) for (int rep = 0; rep < NREP(6); ++rep) { if (rep) xcd_barrier(bar); ln1_router_phase(F, layer, (NREP(6) == 2 && rep == 0) ? WSP(unsigned char, WS_G) : WSP(unsigned char, WS_HB8)); }
        SEAM(pb + 5);
        if (EN(7) && IN(pb + 6)) for (int rep = 0; rep < NREP(7); ++rep) { if (rep) xcd_barrier(bar); topk_phase(F);
            if (F.G == 256 && F.bid >= 128 && layer + 1 < DEPTH && layer + 1 >= CONV_P0_LAYERS && rep == 0) conv_range_regs(F, layer + 1, CV_SLOT_A + (F.bid - 128) * 8 + F.wave, 128 * 8, CV_NB); }
        SEAM(pb + 6);
        if (EN(8) && IN(pb + 7)) for (int rep = 0; rep < NREP(8); ++rep) { if (rep) xcd_barrier(bar);
            SchedGU S; S.o.init(NE * 16, (2 * FF) / 256, F.G, F.bid); S.HB = (const char*)WSP(unsigned char, WS_HB8); S.WGU = (const char*)(WSP(unsigned char, WS_WGU) + (size_t)layer * NE * (2 * FF) * D);
            LAS int* idxtab = (LAS int*)(F.lds + IDXTAB_OFF); S.idxtab = idxtab;
            S.Fp = &F; S.conv_layer = (layer + 1 < DEPTH && layer + 1 >= CONV_P0_LAYERS && rep == 0) ? layer + 1 : -1; S.conv_slot = F.bid % 8;
            const int* ROWIDX = WSP(int, WS_ROWIDX);
            { int t_ = F.tid; asm volatile("" : "+v"(t_));
              for (int i = 0; i < IDXTAB_UNITS; ++i) { int pm, pn; if (!S.o.tile(i, pm, pn)) break; if (t_ < 256) idxtab[i * 256 + t_] = ROWIDX[(pm >> 4) * ESLOTS + (pm & 15) * 256 + t_]; } }
            __syncthreads();
            EpiGU E{WSP(bf16_t, WS_HID), EPI_ON(8)};
            pg8::gemm_phase<EpiGU, SchedGU, true, 2>(ring, S, E, D, D);
            { SkGU K{WSP(unsigned char, WS_HB8), WSP(unsigned char, WS_WGU) + (size_t)layer * NE * (2 * FF) * D, WSP(int, WS_ROWIDX), WSP(unsigned char, WS_HID)}; skinny_phase(F, K); }
        }
        SEAM(pb + 7);
        if (EN(9) && IN(pb + 8)) for (int rep = 0; rep < NREP(9); ++rep) { if (rep) xcd_barrier(bar);
            SchedDown S; S.o.init(NE * 16, D / 256, F.G, F.bid); S.HID = (const char*)WSP(bf16_t, WS_HID); S.WD = (const char*)(WSP(unsigned char, WS_WD) + (size_t)layer * NE * D * FF);
            EpiDown E{WSP(unsigned char, WS_Y), WSP(float, WS_GATE), EPI_ON(9)};
            pg8::gemm_phase<EpiDown, SchedDown, true, 1, 127 - WD_SHIFT>(ring, S, E, FF, FF);
            { SkDown K{WSP(unsigned char, WS_HID), WSP(unsigned char, WS_WD) + (size_t)layer * NE * D * FF, WSP(float, WS_GATE), WSP(unsigned char, WS_Y)}; skinny_phase(F, K); }
        }
        SEAM(pb + 8);
        if (EN(10) && IN(pb + 9)) for (int rep = 0; rep < NREP(10); ++rep) { if (rep) xcd_barrier(bar); combine_ln2_phase(F, layer, (NREP(10) == 2 && rep == 0) ? WSP(_Float16, WS_HID) : WSP(_Float16, WS_H), (NREP(10) == 2 && rep == 0) ? WSP(unsigned char, WS_HID + (size_t)TP * D * 4) : WSP(unsigned char, WS_HB8)); }
        SEAM(pb + 9);
#ifdef EXTRA_BAR
        for (int xb = 0; xb < EXTRA_BAR; ++xb) xcd_barrier(bar);
#endif
    }
#if defined(MK_PROBE_A)
    if (F.bid == 0) {
        float A = 0.f, B = 0.f;
        if (MK_PROBE_A == 0) A = (float)(ts[1] - ts[0]); else for (int l = 0; l < DEPTH; ++l) A += (float)(ts[1 + l * 10 + MK_PROBE_A + 0] - ts[1 + l * 10 + MK_PROBE_A - 1]);
        if (MK_PROBE_B == 0) B = (float)(ts[1] - ts[0]); else for (int l = 0; l < DEPTH; ++l) B += (float)(ts[1 + l * 10 + MK_PROBE_B + 0] - ts[1 + l * 10 + MK_PROBE_B - 1]);
        A *= 0.01f; B *= 0.01f;
        for (int j = F.tid; j < 33554; j += 512) { if (j == 0) F.out[0] = A; else F.out[(size_t)j * 1000] += B; }
    }
#endif
#undef IN
#undef SEAM
}

#if MK_DEBUG
__global__ void chk_attn(const unsigned char* ws, const float* sink, unsigned* errw) {
    const int s = blockIdx.x, d = threadIdx.x;
    const bf16_t* Q = (const bf16_t*)(ws + WS_Q); const bf16_t* KB = (const bf16_t*)(ws + WS_KB); const bf16_t* VT = (const bf16_t*)(ws + WS_VT); const unsigned char* ATT = ws + WS_ATT;
    int row;
    if (s < 64) { const int k = s & 15; const int p = k < 3 ? (k == 2 ? 15 : k) : k < 5 ? 13 + k : k < 7 ? 58 + k : k < 11 ? 120 + k : k == 11 ? 2056 : k < 14 ? 3971 + k : 4096 + k; row = ((s >> 4) * 2 + ((s >> 4) == 3 ? 1 : 0)) * LSEQ + p; }
    else row = (int)(((unsigned)s * 2654435761u) % (unsigned)T);
    const int hq = s & 7, kvh = hq >> 2, b = row / LSEQ, i = row - b * LSEQ;
    const float q = bf2f(Q[(size_t)row * AW + hq * 64 + d]);
    const float slope2 = exp2f(-(float)(hq + 1)) * LOG2E, sink2 = sink[hq] * LOG2E;
    const int j0 = i - 128 < 0 ? 0 : i - 128, j1 = i + 128 > LSEQ - 1 ? LSEQ - 1 : i + 128;
    float m = sink2;
    for (int j = j0; j <= j1; ++j) { float sc = wave_sum(q * bf2f(KB[(size_t)(b * LSEQ + j) * 128 + kvh * 64 + d])); sc -= slope2 * fabsf((float)(j - i)); m = fmaxf(m, sc); }
    float o = 0.f, den = exp2f(sink2 - m);
    for (int j = j0; j <= j1; ++j) { float sc = wave_sum(q * bf2f(KB[(size_t)(b * LSEQ + j) * 128 + kvh * 64 + d])); sc -= slope2 * fabsf((float)(j - i)); const float p = exp2f(sc - m); den += p;
        o += p * bf2f(VT[(size_t)((b * NKV + kvh) * HD + d) * VT_LD + VT_OFF + j]); }
    const float r = o / den, a = __builtin_amdgcn_cvt_f32_fp8((int)ATT[(size_t)row * AW + hq * 64 + d], 0);
    float err = fabsf(r - a), scale = fabsf(r);
    for (int x = 1; x < 64; x <<= 1) { err = fmaxf(err, __shfl_xor(err, x)); scale = fmaxf(scale, __shfl_xor(scale, x)); }
    if (d == 0) atomicMax(errw, __float_as_uint(err / fmaxf(scale, 1e-2f)));
}
__global__ void chk_report(const unsigned* errw, float* out, int n) {
    const int i = blockIdx.x * blockDim.x + threadIdx.x; if (i >= n) return;
    out[i] = (i == 0) ? 1000.0f + 10000.0f * __uint_as_float(errw[0]) : 0.0f;
}
static void debug_driver(Args a, int grid, hipStream_t stream, int out_size) {
    a.ph_lo = 0; a.ph_hi = 3;
    hipLaunchKernelGGL(mk_fwd<true>, dim3(grid), dim3(512), LDS_BYTES, stream, a);
    unsigned* errw = (unsigned*)(a.ws + WS_CTL) + CW_ERR;
    hipLaunchKernelGGL(chk_attn, dim3(8192), dim3(64), 0, stream, (const unsigned char*)a.ws, a.in[6], errw);
    hipLaunchKernelGGL(chk_report, dim3((out_size + 255) / 256), dim3(256), 0, stream, (const unsigned*)errw, a.out, out_size);
}
#endif

extern "C" void kernel_launch(void* const* d_in, const int* in_sizes, int n_in, void* d_out, int out_size, void* d_ws, size_t ws_size, hipStream_t stream) {
#if defined(MK_PER_PHASE)
    auto MKF = mk_fwd<false>;
#else
    auto MKF = mk_fwd<true>;
#endif
    static int grid = 0;
    if (grid == 0) {
        int dev = 0, cus = 0, per_cu = 0;
        if (hipGetDevice(&dev) != hipSuccess || hipDeviceGetAttribute(&cus, hipDeviceAttributeMultiprocessorCount, dev) != hipSuccess) { fprintf(stderr, "kernel_launch: device query failed\n"); grid = -1; return; }
        if (hipFuncSetAttribute((const void*)MKF, hipFuncAttributeMaxDynamicSharedMemorySize, LDS_BYTES) != hipSuccess) { fprintf(stderr, "kernel_launch: hipFuncSetAttribute failed\n"); grid = -1; return; }
        if (hipOccupancyMaxActiveBlocksPerMultiprocessor(&per_cu, (const void*)MKF, 512, LDS_BYTES) != hipSuccess || per_cu < 1) fprintf(stderr, "kernel_launch: occupancy query reports %d\n", per_cu);
        (void)hipGetLastError();
        if (ws_size < WS_END) fprintf(stderr, "kernel_launch: workspace %zu < %zu\n", ws_size, (size_t)WS_END);
        grid = cus;
    }
    if (grid < 0) return;
    (void)hipMemsetAsync((char*)d_ws + WS_CTL, 0, CTL_BYTES, stream);
    Args a{};
    for (int i = 0; i < 18; ++i) a.in[i] = (const float*)d_in[i];
    a.out = (float*)d_out; a.ws = (unsigned char*)d_ws;
#if MK_DEBUG
    debug_driver(a, grid, stream, out_size);
#elif defined(MK_PER_PHASE)
    for (int p = 0; p < N_PHASES; ++p) { a.ph_lo = p; a.ph_hi = p + 1; hipLaunchKernelGGL(MKF, dim3(grid), dim3(512), LDS_BYTES, stream, a); }
#else
    a.ph_lo = 0; a.ph_hi = N_PHASES;
    hipLaunchKernelGGL(MKF, dim3(grid), dim3(512), LDS_BYTES, stream, a);
#endif
}
```

```cpp
#include <hip/hip_runtime.h>
#include <cstdio>
#include <cstdint>

#ifndef MK_DEBUG
#define MK_DEBUG 0
#endif

#define LAS __attribute__((address_space(3)))
#define GAS __attribute__((address_space(1)))
typedef unsigned short bf16_t;
typedef short bf16x8 __attribute__((ext_vector_type(8)));
typedef int v8i_t __attribute__((ext_vector_type(8)));
typedef int v4i_t __attribute__((ext_vector_type(4)));
typedef short s16x4 __attribute__((ext_vector_type(4)));
typedef float f32x4 __attribute__((ext_vector_type(4)));
typedef float f32x16 __attribute__((ext_vector_type(16)));
typedef unsigned u32x4 __attribute__((ext_vector_type(4)));
typedef unsigned u32x2 __attribute__((ext_vector_type(2)));
typedef float f32x2_t __attribute__((ext_vector_type(2)));
typedef __bf16 bf16x2_t __attribute__((ext_vector_type(2)));

constexpr int D = 1024, BATCH = 8, SEQ = 4096, DEPTH = 4, NMETA = 16;
constexpr int LSEQ = SEQ + NMETA;
constexpr int T = BATCH * LSEQ;
constexpr int TP = 33024;
constexpr int NH = 8, NKV = 2, HD = 64, AW = 512, FW = 512, INW = 3328;
constexpr int NE = 16, CAP = 514, FF = 1536;
constexpr int ESLOTS = 4352;
constexpr int NSLOT = NE * ESLOTS;
constexpr int DK = 4352, QOFF = 2176;
constexpr int HALFL = LSEQ / 2;
constexpr int VT_LD = 4480, VT_OFF = 128;
constexpr int AFF_LD = 4128;
constexpr float LN_EPS = 1e-5f;
constexpr float ALPHA = 1.681792830507429f;
constexpr float LOG2E = 1.4426950408889634f;
#ifndef CONV_P0_LAYERS
#define CONV_P0_LAYERS 1
#endif
constexpr float SX = 20.0f;
constexpr float SW = 739.0f;
constexpr float SPQ = 1.75f;
constexpr int DFT_SHIFT = 9;
constexpr int WIN_SHIFT = 5;
constexpr int WGU_SHIFT = 5;
constexpr int WAF_SHIFT = 6;
constexpr int WOUT_SHIFT = 6;
constexpr int WD_SHIFT = 6;
constexpr float QSCALE = 0.125f * LOG2E;

constexpr size_t al(size_t x) { return (x + 4095) & ~(size_t)4095; }
constexpr size_t WS_CTL = 0, CTL_BYTES = 1u << 20;
constexpr size_t WS_WIN = WS_CTL + CTL_BYTES;
constexpr size_t WS_WA = WS_WIN + al((size_t)DEPTH * INW * D * 2);
constexpr size_t WS_WF = WS_WA + al((size_t)DEPTH * D * AW * 2);
constexpr size_t WS_WOUT = WS_WF + al((size_t)DEPTH * D * FW * 2);
constexpr size_t WS_WGU = WS_WOUT + al((size_t)DEPTH * D * D * 2);
constexpr size_t WS_WD = WS_WGU + al((size_t)DEPTH * NE * 2 * FF * D * 2);
constexpr size_t WS_DFTM = WS_WD + al((size_t)DEPTH * NE * D * FF * 2);
constexpr size_t WS_CSM = WS_DFTM + al((size_t)DK * DK * 2);
constexpr size_t WS_H = WS_CSM + al(256 * 256 * 2);
constexpr size_t WS_HB = WS_H + al((size_t)TP * D * 4);
constexpr size_t WS_VT = WS_HB + al((size_t)TP * D * 2);
constexpr size_t WS_ROWIDX = WS_VT + al((size_t)BATCH * NKV * HD * VT_LD * 2);
constexpr size_t WS_GATE = WS_ROWIDX + al((size_t)NSLOT * 4);
constexpr size_t WS_HB8 = WS_GATE + al((size_t)NSLOT * 4);
constexpr size_t WS_MIXB = WS_HB8 + al((size_t)TP * D);
constexpr size_t WS_STATS = WS_MIXB + al((size_t)TP * D * 2);
constexpr size_t WS_TMP = WS_STATS + al((size_t)TP * 8);
constexpr size_t WS_Q = WS_TMP;
constexpr size_t WS_KB = WS_Q + al((size_t)TP * AW * 2);
constexpr size_t WS_UF = WS_KB + al((size_t)TP * 128 * 2);
constexpr size_t WS_G = WS_UF + al((size_t)TP * FW * 2 + 4096);
constexpr size_t WS_ATT = WS_G + al((size_t)TP * 2 * D * 2);
constexpr size_t WS_PQT = WS_ATT + al((size_t)TP * AW * 2);
constexpr size_t WS_FOUR = WS_PQT + al((size_t)4096 * DK * 2);
constexpr size_t WS_P1 = WS_FOUR + al((size_t)TP * FW * 2);
constexpr size_t WS_MG = WS_P1 + al((size_t)TP * D * 2);
constexpr size_t WS_MIX_END = WS_MG + al((size_t)TP * D * 2);
constexpr size_t WS_AFFT = WS_TMP;
constexpr size_t WS_SLOTMAP = WS_AFFT + al((size_t)BATCH * NE * AFF_LD * 4);
constexpr size_t WS_HID = WS_SLOTMAP + al((size_t)T * NE * 4);
constexpr size_t WS_Y = WS_HID + al((size_t)NSLOT * FF * 2);
constexpr size_t WS_MOE_END = WS_Y + al((size_t)NSLOT * D * 2);
constexpr size_t WS_END = (WS_MIX_END > WS_MOE_END ? WS_MIX_END : WS_MOE_END);
static_assert(WS_END <= (size_t)1536 * 1024 * 1024, "d_ws map exceeds the guaranteed workspace");

constexpr int CW_BAR = 4096;
constexpr int CW_ERR = 1024;

constexpr int RING_BYTES = 131072;
constexpr int IDXTAB_OFF = RING_BYTES;
constexpr int IDXTAB_UNITS = 14;
constexpr int MISC_OFF = IDXTAB_OFF + IDXTAB_UNITS * 1024;
constexpr int LDS_BYTES = 147456;
static_assert(MISC_OFF + 256 <= LDS_BYTES, "LDS map");

#define LDS_WAIT() asm volatile("s_waitcnt lgkmcnt(0)" ::: "memory")
#define VM_WAIT() asm volatile("s_waitcnt vmcnt(0)" ::: "memory")
__device__ __forceinline__ unsigned cvtpk(float lo, float hi) { f32x2_t v = {lo, hi}; bf16x2_t b = __builtin_convertvector(v, bf16x2_t); return __builtin_bit_cast(unsigned, b); }
__device__ __forceinline__ bf16_t f2bf(float f) { return (bf16_t)(cvtpk(f, 0.f) & 0xffffu); }
__device__ __forceinline__ float bf2f(unsigned b) { return __uint_as_float(b << 16); }
__device__ __forceinline__ float bflo(unsigned w) { return __uint_as_float(w << 16); }
__device__ __forceinline__ float bfhi(unsigned w) { return __uint_as_float(w & 0xffff0000u); }
__device__ __forceinline__ u32x2 pack4(const f32x4 a) { u32x2 w; w.x = cvtpk(a[0], a[1]); w.y = cvtpk(a[2], a[3]); return w; }
__device__ __forceinline__ f32x4 unpack4(const u32x2 w) { return (f32x4){bflo(w.x), bfhi(w.x), bflo(w.y), bfhi(w.y)}; }
__device__ __forceinline__ unsigned pack4_fp8(float a, float b, float c, float d) { unsigned w = 0; w = __builtin_amdgcn_cvt_pk_fp8_f32(a, b, w, false); w = __builtin_amdgcn_cvt_pk_fp8_f32(c, d, w, true); return w; }
__device__ __forceinline__ unsigned pack4_i8(float a, float b, float c, float d) {
    const float M = 12582912.0f;
    const unsigned ua = __float_as_uint(__builtin_amdgcn_fmed3f(a, -127.f, 127.f) + M), ub = __float_as_uint(__builtin_amdgcn_fmed3f(b, -127.f, 127.f) + M);
    const unsigned uc = __float_as_uint(__builtin_amdgcn_fmed3f(c, -127.f, 127.f) + M), ud = __float_as_uint(__builtin_amdgcn_fmed3f(d, -127.f, 127.f) + M);
    const unsigned ab = __builtin_amdgcn_perm(ub, ua, 0x0c0c0400u), cd = __builtin_amdgcn_perm(ud, uc, 0x0c0c0400u);
    return __builtin_amdgcn_perm(cd, ab, 0x05040100u); }
__device__ __forceinline__ unsigned pack4_u8(float a, float b, float c, float d) {
    const float M = 12582912.0f;
    const unsigned ua = __float_as_uint(a + M), ub = __float_as_uint(b + M), uc = __float_as_uint(c + M), ud = __float_as_uint(d + M);
    const unsigned ab = __builtin_amdgcn_perm(ub, ua, 0x0c0c0400u), cd = __builtin_amdgcn_perm(ud, uc, 0x0c0c0400u);
    return __builtin_amdgcn_perm(cd, ab, 0x05040100u); }
__device__ __forceinline__ f32x4 unpack4_u8(unsigned w) { return (f32x4){(float)(w & 0xffu), (float)((w >> 8) & 0xffu), (float)((w >> 16) & 0xffu), (float)(w >> 24)}; }
__device__ __forceinline__ f32x4 unpack4_fp8(unsigned w) { const f32x2_t lo = __builtin_amdgcn_cvt_pk_f32_fp8(w, false), hi = __builtin_amdgcn_cvt_pk_f32_fp8(w, true); return (f32x4){lo[0], lo[1], hi[0], hi[1]}; }
__device__ __forceinline__ float fast_sigmoid(float x) { return __builtin_amdgcn_rcpf(1.0f + __builtin_amdgcn_exp2f(-LOG2E * x)); }
__device__ __forceinline__ float dpp_xor8(float x) { return __builtin_bit_cast(float, __builtin_amdgcn_update_dpp(0, __builtin_bit_cast(int, x), 0x128, 0xF, 0xF, true)); }
__device__ __forceinline__ float dpp_xor2(float x) { return __builtin_bit_cast(float, __builtin_amdgcn_update_dpp(0, __builtin_bit_cast(int, x), 0x4E, 0xF, 0xF, true)); }
__device__ __forceinline__ float dpp_xor1(float x) { return __builtin_bit_cast(float, __builtin_amdgcn_update_dpp(0, __builtin_bit_cast(int, x), 0xB1, 0xF, 0xF, true)); }
__device__ __forceinline__ float dpp_xor4(float x) { const int xi = __builtin_bit_cast(int, x); int t = __builtin_amdgcn_update_dpp(0, xi, 0x104, 0xF, 0x5, false); t = __builtin_amdgcn_update_dpp(t, xi, 0x114, 0xF, 0xA, false); return __builtin_bit_cast(float, t); }
__device__ __forceinline__ float swap_sum16(float x) { unsigned a = __builtin_bit_cast(unsigned, x), b = a; asm volatile("" : "+v"(b)); const auto r = __builtin_amdgcn_permlane16_swap(a, b, false, false);
    unsigned r0 = r[0], r1 = r[1]; asm volatile("" : "+v"(r0), "+v"(r1)); return __builtin_bit_cast(float, r0) + __builtin_bit_cast(float, r1); }
__device__ __forceinline__ float swap_sum32(float x) { unsigned a = __builtin_bit_cast(unsigned, x), b = a; asm volatile("" : "+v"(b)); const auto r = __builtin_amdgcn_permlane32_swap(a, b, false, false);
    unsigned r0 = r[0], r1 = r[1]; asm volatile("" : "+v"(r0), "+v"(r1)); return __builtin_bit_cast(float, r0) + __builtin_bit_cast(float, r1); }
__device__ __forceinline__ float wave_sum(float v) {
    v += dpp_xor1(v); v += dpp_xor2(v); v += dpp_xor4(v); v += dpp_xor8(v);
    return swap_sum32(swap_sum16(v));
}

#define XB_TMO      128
#define XB_XCNT(j)  (256  + 64 * (j))
#define XB_XSUB(j)  (1280 + 64 * (j))
#define XB_XGEN(j)  (2304 + 64 * (j))
#define XB_TOP      3328
#define XB_TOPGEN   3392
#define XCD_BAR_WORDS 3456
#define XB_SPIN_CAP (1u << 18)
__device__ __forceinline__ unsigned xb_ld(unsigned* p)              { return __hip_atomic_load(p, __ATOMIC_RELAXED, __HIP_MEMORY_SCOPE_AGENT); }
__device__ __forceinline__ unsigned xb_add(unsigned* p, unsigned v) { return __hip_atomic_fetch_add(p, v, __ATOMIC_RELAXED, __HIP_MEMORY_SCOPE_AGENT); }
__device__ __forceinline__ unsigned xb_xcc_id() { return (unsigned)__builtin_amdgcn_s_getreg((3 << 11) | 20) & 0xFu; }
#define XB_SPIN(cond, bar) do { unsigned _sp = 0; while (cond) { __builtin_amdgcn_s_sleep(1); \
    if ((++_sp & 255u) == 0u) { if (xb_ld(&(bar)[XB_TMO])) break; if (_sp > XB_SPIN_CAP) { atomicAdd(&(bar)[XB_TMO], 1u); break; } } } } while (0)
struct XcdBarrier { unsigned* bar; unsigned x; volatile LAS unsigned* st; };
__device__ __forceinline__ XcdBarrier xcd_barrier_post(unsigned* bar, volatile LAS unsigned* st) {
    XcdBarrier b; b.bar = bar; b.x = (unsigned)__builtin_amdgcn_readfirstlane((int)xb_xcc_id()); b.st = st;
    if (threadIdx.x == 0) (void)xb_add(&bar[XB_XCNT(b.x)], 1u);
    return b;
}
__device__ __forceinline__ void xcd_barrier_complete(unsigned* bar, unsigned x, unsigned& nloc, unsigned& nx) {
    const unsigned G = gridDim.x * gridDim.y * gridDim.z;
    unsigned sum, cnt, mine, sp = 0u;
    for (;;) {
        sum = 0u; cnt = 0u; mine = 0u;
#pragma unroll
        for (unsigned j = 0; j < 16; ++j) { const unsigned c = xb_ld(&bar[XB_XCNT(j)]); sum += c; cnt += (c > 0u) ? 1u : 0u; mine = (j == x) ? c : mine; }
        if (sum == G) break;
        __builtin_amdgcn_s_sleep(1);
        if ((++sp & 255u) == 0u) { if (xb_ld(&bar[XB_TMO])) break; if (sp > XB_SPIN_CAP) { atomicAdd(&bar[XB_TMO], 1u); break; } }
    }
    nloc = mine > 0u ? mine : 1u; nx = cnt > 0u ? cnt : 1u;
}
__device__ __forceinline__ void xcd_barrier(const XcdBarrier& b) {
    asm volatile("s_waitcnt vmcnt(0)" ::: "memory");
    __syncthreads();
    if (threadIdx.x == 0) {
        unsigned* bar = b.bar; unsigned bx = b.x; asm volatile("" : "+s"(bx));
        __builtin_amdgcn_s_waitcnt(0);
        unsigned nloc = b.st[0], nx = b.st[1];
        if (nloc == 0u) { xcd_barrier_complete(bar, bx, nloc, nx); b.st[0] = nloc; b.st[1] = nx; }
        const unsigned old = xb_add(&bar[XB_XSUB(bx)], 1u);
        const unsigned gen = old / nloc;
        if (old + 1u == (gen + 1u) * nloc) {
            __builtin_amdgcn_fence(__ATOMIC_RELEASE, "agent");
            asm volatile("s_waitcnt vmcnt(0)" ::: "memory");
            const unsigned og = xb_add(&bar[XB_TOP], 1u);
            const unsigned tg = og / nx;
            if (og + 1u == (tg + 1u) * nx) xb_add(&bar[XB_TOPGEN], 1u);
            else XB_SPIN(xb_ld(&bar[XB_TOPGEN]) == tg, bar);
            __builtin_amdgcn_fence(__ATOMIC_ACQUIRE, "agent");
            xb_add(&bar[XB_XGEN(bx)], 1u);
            asm volatile("s_waitcnt vmcnt(0)" ::: "memory");
        } else {
            XB_SPIN(xb_ld(&bar[XB_XGEN(bx)]) == gen, bar);
            __builtin_amdgcn_fence(__ATOMIC_ACQUIRE, "agent");
            asm volatile("s_waitcnt vmcnt(0)" ::: "memory");
        }
    }
    __syncthreads();
}

namespace pg8 {
constexpr int BM = 256, BK = 64, HALF = 128, HTB = HALF * BK * 2, STAGE_BYTES = 8 * HTB, NXCD = 8, WGM = 8;
__host__ __device__ __forceinline__ int lds_byte(int r, int c) { const int st = (r >> 4) * 2 + (c >> 5), rr = r & 15, cc = c & 31, ob = rr * 64 + cc * 2; return st * 1024 + (ob ^ (((ob >> 9) & 1) << 5)); }
__host__ __device__ __forceinline__ void stage_rc(int b, int& R, int& C) { const int st = b / 1024, sb = b % 1024, swz = sb ^ (((sb >> 9) & 1) << 5); R = (st >> 1) * 16 + swz / 64; C = (st & 1) * 32 + (swz % 64) / 2; }
__host__ __device__ __forceinline__ int perm32(int rho) { const int n = rho >> 4, i = rho & 15; return 8 * (i >> 2) + 4 * n + (i & 3); }

struct Unit { int pm, pn; const char* A; const char* B; int part; };

struct TileOrder {
    int nM, nN, nwg, G, c;
    __device__ __forceinline__ void init(int nM_, int nN_, int G_, int c_) { nM = nM_; nN = nN_; nwg = nM * nN; G = G_; c = c_; }
    __device__ __forceinline__ bool tile(int i, int& pm, int& pn) const {
        const long L = (long)i * G + c; if (L >= nwg) return false;
        int wgid = (int)L; { const int q = nwg / NXCD, r = nwg % NXCD, xcd = wgid % NXCD, off = wgid / NXCD; wgid = (xcd < r ? xcd * (q + 1) : r * (q + 1) + (xcd - r) * q) + off; }
        const int nig = WGM * nN, gid = wgid / nig, fm = gid * WGM, gsz = (nM - fm) < WGM ? (nM - fm) : WGM;
        pm = fm + ((wgid % nig) % gsz); pn = (wgid % nig) / gsz; return true;
    }
};

template <class Epi, class Sched, bool ALIGN_EPI, int MODE = 0, int SCALE_W = 127>
__device__ __forceinline__ void gemm_phase(LAS unsigned char* lds, const Sched& S, const Epi& E, const int K, const int ldb) {
    int tid_ = threadIdx.x; asm volatile("" : "+v"(tid_));
    const int tid = tid_, wid = __builtin_amdgcn_readfirstlane(tid >> 6), lane = tid & 63, wr = wid >> 2, wc = wid & 3, fr = lane & 15, fq = lane >> 4;
    constexpr bool FP8 = (MODE == 1), I8 = (MODE == 2);
    int nt = K / (BK * 2); asm volatile("" : "+s"(nt));
    int sR[2], sC[2]; unsigned voffB[2];
#pragma unroll
    for (int i = 0; i < 2; ++i) { stage_rc(tid * 16 + i * 8192, sR[i], sC[i]); const int Rb = Epi::PERM ? ((sR[i] & ~31) + perm32(sR[i] & 31)) : sR[i];
        voffB[i] = (unsigned)(Rb * ldb + sC[i] * 2); }
    const size_t kstep = (size_t)(BK * 2);
    const size_t hstepB = (size_t)HALF * ldb;
    unsigned voffA[2]; size_t hstepA = 0;
    if constexpr (!Sched::GATHER) { hstepA = (size_t)HALF * S.lda;
#pragma unroll
        for (int i = 0; i < 2; ++i) voffA[i] = (unsigned)(sR[i] * S.lda + sC[i] * 2); }
    const unsigned ldsw = (unsigned)wid * 1024u;
    const int aoff = lds_byte(wr * 64 + fr, fq * 8), boff = lds_byte(wc * 32 + fr, fq * 8);
#define PG8_SA(b, h) (((b) * 2 + (h)) * HTB)
#define PG8_SB(b, h) ((4 + (b) * 2 + (h)) * HTB)
#define PG8_STAGE(bufoff, gbase, voff) do { _Pragma("unroll") for (int _i = 0; _i < 2; ++_i) \
        __builtin_amdgcn_global_load_lds((const unsigned*)((const char*)(gbase) + (voff)[_i]), (LAS unsigned*)(lds + (bufoff) + ldsw + _i * 8192), 16, 0, 0); } while (0)
#define PG8_STAGE_A(bufoff, gbase, h, OFFS) do { if constexpr (Sched::GATHER) PG8_STAGE(bufoff, gbase, OFFS[h]); else PG8_STAGE(bufoff, (gbase) + (h) * hstepA, voffA); } while (0)
#define PG8_LD32(p) __builtin_shufflevector(*(const LAS u32x4*)(p), *(const LAS u32x4*)((p) + 1024), 0, 1, 2, 3, 4, 5, 6, 7)
#define PG8_STAGE_B(bufoff, gbase, h, OFFS) do { if constexpr (Sched::GATHER_B) PG8_STAGE(bufoff, gbase, OFFS[h]); else PG8_STAGE(bufoff, (gbase) + (h) * hstepB, voffB); } while (0)
#define PG8_LDA(dst, b, h) do { if constexpr (FP8) { _Pragma("unroll") for (int m = 0; m < 4; ++m) dst##8[m] = __builtin_bit_cast(v8i_t, PG8_LD32(lds + PG8_SA(b, h) + aoff + m * 2048)); } \
        else { _Pragma("unroll") for (int m = 0; m < 4; ++m) _Pragma("unroll") for (int k = 0; k < 2; ++k) dst[m][k] = *(const LAS bf16x8*)(lds + PG8_SA(b, h) + aoff + m * 2048 + k * 1024); } } while (0)
#define PG8_LDB(dst, b, h) do { if constexpr (FP8) { _Pragma("unroll") for (int n = 0; n < 2; ++n) dst##8[n] = __builtin_bit_cast(v8i_t, PG8_LD32(lds + PG8_SB(b, h) + boff + n * 2048)); } \
        else { _Pragma("unroll") for (int n = 0; n < 2; ++n) _Pragma("unroll") for (int k = 0; k < 2; ++k) dst[n][k] = *(const LAS bf16x8*)(lds + PG8_SB(b, h) + boff + n * 2048 + k * 1024); } } while (0)
#define PG8_MMA(ai, bj, At, Bt) do { __builtin_amdgcn_s_setprio(1); \
        if constexpr (FP8) { _Pragma("unroll") for (int m = 0; m < 4; ++m) _Pragma("unroll") for (int n = 0; n < 2; ++n) \
            asm volatile("v_mfma_scale_f32_16x16x128_f8f6f4 %0, %1, %2, %0, %3, %4 op_sel_hi:[0,0,0]" : "+v"(acc[ai][bj][m][n]) : "v"(Bt##8[n]), "v"(At##8[m]), "v"(sc_w), "v"(sc_a)); } \
        else if constexpr (I8) { _Pragma("unroll") for (int m = 0; m < 4; ++m) _Pragma("unroll") for (int n = 0; n < 2; ++n) _Pragma("unroll") for (int k = 0; k < 2; ++k) \
            acc[ai][bj][m][n] = __builtin_bit_cast(f32x4, __builtin_amdgcn_mfma_i32_16x16x64_i8(__builtin_bit_cast(v4i_t, Bt[n][k]), __builtin_bit_cast(v4i_t, At[m][k]), __builtin_bit_cast(v4i_t, acc[ai][bj][m][n]), 0, 0, 0)); } \
        else { _Pragma("unroll") for (int m = 0; m < 4; ++m) _Pragma("unroll") for (int n = 0; n < 2; ++n) _Pragma("unroll") for (int k = 0; k < 2; ++k) \
            acc[ai][bj][m][n] = __builtin_amdgcn_mfma_f32_16x16x32_bf16(Bt[n][k], At[m][k], acc[ai][bj][m][n], 0, 0, 0); } \
        __builtin_amdgcn_s_setprio(0); } while (0)
#define PG8_WAIT_V(n) asm volatile("s_waitcnt vmcnt(" #n ")" ::: "memory")
#define PG8_WAIT_L(n) asm volatile("s_waitcnt lgkmcnt(" #n ")" ::: "memory")
#define PG8_BAR __builtin_amdgcn_s_barrier()
#define PG8_SCHED __builtin_amdgcn_sched_barrier(0)
    Unit cur, nxt; int ui = 0;
    if (!S.next(0, cur)) return;
    unsigned oA[2][2], noA[2][2], oB[2][2], noB[2][2];
    int sRb[2];
#pragma unroll
    for (int i = 0; i < 2; ++i) sRb[i] = Epi::PERM ? ((sR[i] & ~31) + perm32(sR[i] & 31)) : sR[i];
#pragma unroll
    for (int h = 0; h < 2; ++h)
#pragma unroll
        for (int i = 0; i < 2; ++i) { oA[h][i] = Sched::GATHER ? S.aoff(cur, 0, h, sR[i], sC[i]) : 0u; oB[h][i] = Sched::GATHER_B ? S.boff(cur, 0, h, sRb[i], sC[i]) : 0u; }
    f32x4 acc[2][2][4][2];
#pragma unroll
    for (int a = 0; a < 2; ++a)
#pragma unroll
        for (int b = 0; b < 2; ++b)
#pragma unroll
            for (int m = 0; m < 4; ++m)
#pragma unroll
                for (int n = 0; n < 2; ++n) acc[a][b][m][n] = (f32x4){0.f, 0.f, 0.f, 0.f};
    const int sc_w = SCALE_W * 0x01010101, sc_a = 0x7f7f7f7f;
    bf16x8 At[4][2], B0[2][2], B1[2][2]; v8i_t At8[4], B08[2], B18[2];
    const char* cA = cur.A; const char* cB = cur.B;
    PG8_STAGE_B(PG8_SB(0, 0), cB, 0, oB); PG8_STAGE_B(PG8_SB(0, 1), cB, 1, oB); PG8_STAGE_A(PG8_SA(0, 0), cA, 0, oA); PG8_STAGE_A(PG8_SA(0, 1), cA, 1, oA);
    if (wr == 1) PG8_BAR;
    PG8_WAIT_V(2); PG8_BAR;
    PG8_STAGE_B(PG8_SB(1, 0), cB + kstep, 0, oB); PG8_STAGE_A(PG8_SA(1, 0), cA + kstep, 0, oA); PG8_STAGE_B(PG8_SB(1, 1), cB + kstep, 1, oB);
    PG8_WAIT_V(6); PG8_BAR;
    for (;;) {
        const bool has_next = S.next(ui + 1, nxt);
        const char* nA = has_next ? nxt.A : cA; const char* nB = has_next ? nxt.B : cB;
#pragma unroll
        for (int h = 0; h < 2; ++h)
#pragma unroll
            for (int i = 0; i < 2; ++i) { noA[h][i] = Sched::GATHER ? (has_next ? S.aoff(nxt, ui + 1, h, sR[i], sC[i]) : oA[h][i]) : 0u; noB[h][i] = Sched::GATHER_B ? (has_next ? S.boff(nxt, ui + 1, h, sRb[i], sC[i]) : oB[h][i]) : 0u; }
#pragma unroll 1
        for (int t = 0; t < nt; t += 2) {
            const bool last = (t == nt - 2);
            const char* a1 = cA + (size_t)(t + 1) * kstep;
            const char* a2 = last ? nA : cA + (size_t)(t + 2) * kstep; const char* b2 = last ? nB : cB + (size_t)(t + 2) * kstep;
            const char* a3 = a2 + kstep; const char* b3 = b2 + kstep;
            unsigned o2[2][2], o2B[2][2];
#pragma unroll
            for (int h = 0; h < 2; ++h)
#pragma unroll
                for (int i = 0; i < 2; ++i) { o2[h][i] = Sched::GATHER ? (last ? noA[h][i] : oA[h][i]) : 0u; o2B[h][i] = Sched::GATHER_B ? (last ? noB[h][i] : oB[h][i]) : 0u; }
            PG8_LDB(B0, 0, 0); PG8_LDB(B1, 0, 1); PG8_SCHED; PG8_LDA(At, 0, 0); PG8_STAGE_A(PG8_SA(1, 1), a1, 1, oA);
            PG8_WAIT_V(8); PG8_WAIT_L(0); PG8_BAR; PG8_MMA(0, 0, At, B0); PG8_MMA(0, 1, At, B1); PG8_BAR; PG8_SCHED;
            PG8_LDA(At, 0, 1); PG8_STAGE_B(PG8_SB(0, 0), b2, 0, o2B); PG8_STAGE_B(PG8_SB(0, 1), b2, 1, o2B); PG8_STAGE_A(PG8_SA(0, 0), a2, 0, o2);
            PG8_WAIT_V(8); PG8_WAIT_L(0); PG8_BAR; PG8_MMA(1, 0, At, B0); PG8_MMA(1, 1, At, B1); PG8_BAR; PG8_SCHED;
            PG8_LDB(B0, 1, 0); PG8_LDB(B1, 1, 1); PG8_SCHED; PG8_LDA(At, 1, 0); PG8_STAGE_A(PG8_SA(0, 1), a2, 1, o2);
            PG8_WAIT_V(8); PG8_WAIT_L(0); PG8_BAR; PG8_MMA(0, 0, At, B0); PG8_MMA(0, 1, At, B1); PG8_BAR; PG8_SCHED;
            PG8_LDA(At, 1, 1); PG8_STAGE_B(PG8_SB(1, 0), b3, 0, o2B); PG8_STAGE_B(PG8_SB(1, 1), b3, 1, o2B); PG8_STAGE_A(PG8_SA(1, 0), a3, 0, o2);
            PG8_WAIT_V(8); PG8_WAIT_L(0); PG8_BAR; PG8_MMA(1, 0, At, B0); PG8_MMA(1, 1, At, B1); PG8_BAR; PG8_SCHED;
        }
        if constexpr (ALIGN_EPI) { if (wr == 0) PG8_BAR; }
        if constexpr (FP8) asm volatile("s_nop 15\n\ts_nop 15\n\ts_nop 15\n\ts_nop 15" ::: "memory");
        bool keep_acc = false;
        int fr_e = fr, fq_e = fq; asm volatile("" : "+v"(fr_e), "+v"(fq_e));
        if constexpr (Epi::TWO_PART) { if (cur.part == 0) { E.mid(acc, cur, wr, wc, fr_e, fq_e); keep_acc = true; } else E(acc, cur, wr, wc, fr_e, fq_e); }
        else E(acc, cur, wr, wc, fr_e, fq_e);
        if constexpr (Sched::HAS_HOOK) S.hook(ui);
        if (!has_next) break;
        if (!keep_acc) {
#pragma unroll
        for (int a = 0; a < 2; ++a)
#pragma unroll
            for (int b = 0; b < 2; ++b)
#pragma unroll
                for (int m = 0; m < 4; ++m)
#pragma unroll
                    for (int n = 0; n < 2; ++n) acc[a][b][m][n] = (f32x4){0.f, 0.f, 0.f, 0.f};
        }
        cur = nxt; cA = nA; cB = nB; ++ui;
#pragma unroll
        for (int h = 0; h < 2; ++h)
#pragma unroll
            for (int i = 0; i < 2; ++i) { oA[h][i] = noA[h][i]; oB[h][i] = noB[h][i]; }
        if constexpr (ALIGN_EPI) { if (wr == 1) PG8_BAR; }
    }
    PG8_WAIT_V(0);
    if constexpr (!ALIGN_EPI) { if (wr == 0) PG8_BAR; }
    PG8_BAR;
#undef PG8_SA
#undef PG8_SB
#undef PG8_STAGE
#undef PG8_STAGE_A
#undef PG8_STAGE_B
#undef PG8_LDA
#undef PG8_LDB
#undef PG8_MMA
#undef PG8_LD32
#undef PG8_WAIT_V
#undef PG8_WAIT_L
#undef PG8_BAR
#undef PG8_SCHED
}
}
using pg8::Unit;
using pg8::TileOrder;

struct Frame {
    LAS unsigned char* lds;
    int tid, lane, wave, G, bid;
    const float *x, *meta, *ln0_g, *ln0_b, *w_in, *b_gate, *sink, *w_attn_o, *w_four_o, *w_out, *ln1_g, *ln1_b, *w_router, *w_e_gate, *w_e_up, *w_e_down, *ln2_g, *ln2_b;
    float* out; unsigned char* ws;
};
#define WSP(T_, off) ((T_*)(F.ws + (off)))

__device__ __forceinline__ void conv_share_regs(const Frame& F, int cl);
struct SchedReg {
    static constexpr bool GATHER = false, GATHER_B = false, HAS_HOOK = false;
    TileOrder o; const char* A; const char* B; int lda, ldb;
    __device__ __forceinline__ bool next(int i, Unit& u) const { int pm, pn; if (!o.tile(i, pm, pn)) return false; u.pm = pm; u.pn = pn; u.part = 1;
        u.A = A + (size_t)pm * 256 * lda; u.B = B + (size_t)pn * 256 * ldb; return true; }
    __device__ __forceinline__ unsigned aoff(const Unit&, int, int h, int R, int C) const { return (unsigned)((h * 128 + R) * lda + C * 2); }
    __device__ __forceinline__ unsigned boff(const Unit&, int, int, int, int) const { return 0u; }
};
struct SchedInProj {
    static constexpr bool GATHER = false, GATHER_B = false, HAS_HOOK = false;
    TileOrder o, o1, o2; bool bal; const char* A; const char* B; int lda, ldb;
    __device__ __forceinline__ bool next(int i, Unit& u) const { int pm, pn;
        if (!bal) { if (!o.tile(i, pm, pn)) return false; }
        else if (i < 4) { o1.tile(i, pm, pn); pn += 5; }
        else { const int L = (i - 4) * 256 + o2.c; if (L < 645) o2.tile(i - 4, pm, pn); else if (L < 653) { pm = 128; pn = 5 + (L - 645); } else return false; }
        u.pm = pm; u.pn = pn; u.part = 1; u.A = A + (size_t)pm * 256 * lda; u.B = B + (size_t)pn * 256 * ldb; return true; }
    __device__ __forceinline__ unsigned aoff(const Unit&, int, int h, int R, int C) const { return (unsigned)((h * 128 + R) * lda + C * 2); }
    __device__ __forceinline__ unsigned boff(const Unit&, int, int, int, int) const { return 0u; }
};
struct SchedMerge {
    static constexpr bool GATHER = false, GATHER_B = false, HAS_HOOK = false; static constexpr int lda = AW;
    TileOrder o; const char* ATT; const char* FOUR; const char* WA; const char* WF;
    __device__ __forceinline__ bool next(int i, Unit& u) const { int pm, pn; if (!o.tile(i >> 1, pm, pn)) return false; u.pm = pm; u.pn = pn; u.part = i & 1;
        u.A = ((i & 1) ? FOUR : ATT) + (size_t)pm * 256 * AW; u.B = ((i & 1) ? WF : WA) + (size_t)pn * 256 * AW; return true; }
    __device__ __forceinline__ unsigned aoff(const Unit&, int, int h, int R, int C) const { return (unsigned)((h * 128 + R) * AW + C) * 2u; }
    __device__ __forceinline__ unsigned boff(const Unit&, int, int, int, int) const { return 0u; }
};
struct SchedDown {
    static constexpr bool GATHER = false, GATHER_B = false, HAS_HOOK = false; static constexpr int lda = FF;
    TileOrder o; const char* HID; const char* WD;
    __device__ __forceinline__ bool next(int i, Unit& u) const { int pm, pn; if (!o.tile(i, pm, pn)) return false; u.pm = pm; u.pn = pn; u.part = 1; const int e = pm >> 4;
        u.A = HID + (size_t)(e * ESLOTS + (pm & 15) * 256) * FF; u.B = WD + ((size_t)e * D + (size_t)pn * 256) * FF; return true; }
    __device__ __forceinline__ unsigned aoff(const Unit&, int, int h, int R, int C) const { return (unsigned)((h * 128 + R) * FF + C * 2); }
    __device__ __forceinline__ unsigned boff(const Unit&, int, int, int, int) const { return 0u; }
};
struct SchedGU {
    static constexpr bool GATHER = true, GATHER_B = false, HAS_HOOK = true; static constexpr int lda = D;
    TileOrder o; const char* HB; const char* WGU; const LAS int* idxtab; const Frame* Fp; int conv_layer, conv_slot;
    __device__ __forceinline__ void hook(int ui) const { if (conv_layer >= 0 && ui == conv_slot) conv_share_regs(*Fp, conv_layer); }
    __device__ __forceinline__ bool next(int i, Unit& u) const { int pm, pn; if (!o.tile(i, pm, pn)) return false; u.pm = pm; u.pn = pn; u.part = 1; const int e = pm >> 4;
        u.A = HB; u.B = WGU + ((size_t)e * (2 * FF) + (size_t)pn * 256) * D; return true; }
    __device__ __forceinline__ unsigned aoff(const Unit&, int i, int h, int R, int C) const { return (unsigned)idxtab[i * 256 + h * 128 + R] * (unsigned)D + (unsigned)C * 2u; }
    __device__ __forceinline__ unsigned boff(const Unit&, int, int, int, int) const { return 0u; }
};
struct SchedChan {
    static constexpr bool GATHER = false, GATHER_B = true, HAS_HOOK = false; static constexpr int lda = 512;
    TileOrder o; const char* UF; const char* CSM;
    __device__ __forceinline__ bool next(int i, Unit& u) const { int pm, pn; if (!o.tile(i, pm, pn)) return false; u.pm = pm; u.pn = 0; u.part = 1; const int bg = pm / 17, g = bg & 3, b = bg >> 2;
        u.A = CSM; u.B = UF + ((size_t)b * LSEQ * FW + (size_t)g * 128) * 2; return true; }
    __device__ __forceinline__ unsigned aoff(const Unit&, int, int, int, int) const { return 0u; }
    __device__ __forceinline__ unsigned boff(const Unit& u, int, int h, int R, int C) const { const int lt = u.pm % 17, l = lt * 128 + R; int tok = h ? LSEQ - l : l; if (tok >= LSEQ) tok = 0;
        return (unsigned)(tok * FW + C) * 2u; }
};

typedef const f32x4 (&AccRef)[2][2][4][2];
__device__ __forceinline__ f32x4 i2f(const f32x4 a, float sc) { const v4i_t i = __builtin_bit_cast(v4i_t, a); return (f32x4){(float)i[0], (float)i[1], (float)i[2], (float)i[3]} * sc; }
__device__ __forceinline__ u32x4 pack8(const f32x4 a, const f32x4 b) { u32x4 w; w.x = cvtpk(a[0], a[1]); w.y = cvtpk(a[2], a[3]); w.z = cvtpk(b[0], b[1]); w.w = cvtpk(b[2], b[3]); return w; }

#ifndef EPI_WT
#define EPI_WT 0
#endif
__device__ __forceinline__ void st16(void* p, const u32x4 v) {
#if EPI_WT
    asm volatile("global_store_dwordx4 %0, %1, off sc1\n\ts_nop 1" :: "v"(p), "v"(v) : "memory");
#elif defined(EPI_NT)
    __builtin_nontemporal_store(v, (u32x4*)p);
#else
    *(u32x4*)p = v;
#endif
}
__device__ __forceinline__ u32x4 pair16(const u32x2 a, const u32x2 b) {
    const auto r0 = __builtin_amdgcn_permlane16_swap(a.x, b.x, false, false), r1 = __builtin_amdgcn_permlane16_swap(a.y, b.y, false, false);
    return (u32x4){r0[0], r1[0], r0[1], r1[1]};
}
__device__ __forceinline__ void store_rows8(unsigned char* base, size_t pitch, const u32x2 (&pk)[4], int fq) {
#pragma unroll
    for (int mp = 0; mp < 2; ++mp) st16(base + (size_t)(32 * mp + 16 * (fq & 1)) * pitch + 16 * (fq >> 1), pair16(pk[2 * mp], pk[2 * mp + 1]));
}
struct EpiInProj { static constexpr bool TWO_PART = false;
    static constexpr bool PERM = true;
    bf16_t *Q, *KB, *VT, *UF; unsigned char* G; const float* bgate; bool active;
    __device__ __forceinline__ void operator()(AccRef acc, const Unit& u, int wr, int wc, int fr, int fq) const {
        if (!active) return;
        const int pn = u.pn, rbase = u.pm * 256 + wr * 64 + fr, c8 = wc * 32 + 8 * fq;
        constexpr float dq = 1.0f / (SX * SW);
#pragma unroll
        for (int ai = 0; ai < 2; ++ai) { if (u.pm * 256 + ai * 128 >= T) continue;
#pragma unroll
            for (int bj = 0; bj < 2; ++bj) { const int colt = bj * 128 + c8;
                if (pn >= 5) {
                    const int gc = (pn - 5) * 256 + colt; const f32x4 b0 = *(const f32x4*)(bgate + gc) * -LOG2E, b1 = *(const f32x4*)(bgate + gc + 4) * -LOG2E; u32x2 pk[4];
#pragma unroll
                    for (int m = 0; m < 4; ++m) { f32x4 v0 = i2f(acc[ai][bj][m][0], -LOG2E * dq), v1 = i2f(acc[ai][bj][m][1], -LOG2E * dq);
#pragma unroll
                        for (int j = 0; j < 4; ++j) { v0[j] = __builtin_amdgcn_rcpf(__builtin_fmaf(__builtin_amdgcn_exp2f(v0[j] + b0[j]), 1.0f / 255.0f, 1.0f / 255.0f));
                                                      v1[j] = __builtin_amdgcn_rcpf(__builtin_fmaf(__builtin_amdgcn_exp2f(v1[j] + b1[j]), 1.0f / 255.0f, 1.0f / 255.0f)); }
                        pk[m] = (u32x2){pack4_u8(v0[0], v0[1], v0[2], v0[3]), pack4_u8(v1[0], v1[1], v1[2], v1[3])}; }
                    store_rows8(G + (size_t)(rbase + ai * 128) * (2 * D) + (pn - 5) * 256 + bj * 128 + wc * 32, 2 * D, pk, fq);
                } else {
#pragma unroll
                    for (int m = 0; m < 4; ++m) { const int row = rbase + ai * 128 + m * 16; f32x4 v0 = i2f(acc[ai][bj][m][0], dq), v1 = i2f(acc[ai][bj][m][1], dq);
                        if (pn < 2) { v0 = v0 * QSCALE; v1 = v1 * QSCALE; st16(Q + (size_t)row * AW + pn * 256 + colt, pack8(v0, v1)); }
                        else if (pn == 2) {
                            if (bj == 0) { st16(KB + (size_t)row * 128 + c8, pack8(v0, v1)); }
                            else { const int b = row / LSEQ, p = row - b * LSEQ; const int kvh = c8 >> 6, d0 = c8 & 63;
                                bf16_t* vp = VT + ((size_t)((b * NKV + kvh) * HD + d0)) * VT_LD + VT_OFF + p;
#pragma unroll
                                for (int j = 0; j < 4; ++j) { vp[(size_t)j * VT_LD] = f2bf(v0[j]); vp[(size_t)(4 + j) * VT_LD] = f2bf(v1[j]); } } }
                        else { st16(UF + (size_t)row * FW + (pn - 3) * 256 + colt, pack8(v0, v1)); } } } } }
    }
};
struct EpiChan { static constexpr bool TWO_PART = false;
    static constexpr bool PERM = true;
    unsigned char* PQT;
    __device__ __forceinline__ void operator()(AccRef acc, const Unit& u, int wr, int wc, int fr, int fq) const {
        const int lt = u.pm % 17, bg = u.pm / 17, l8 = lt * 128 + wc * 32 + 8 * fq;
        u32x2 pp[4], pq[4];
#pragma unroll
        for (int m = 0; m < 4; ++m) { float pe[8], qo[8];
#pragma unroll
            for (int n = 0; n < 2; ++n)
#pragma unroll
                for (int j = 0; j < 4; ++j) { const int l = l8 + 4 * n + j; const bool pair = (l >= 1 && l <= HALFL - 1), own = (l <= HALFL);
                    float p = own ? acc[0][0][m][n][j] : 0.f, q = 0.f;
                    if (pair) { p += acc[0][1][m][n][j]; q = acc[1][0][m][n][j] - acc[1][1][m][n][j]; }
                    pe[4 * n + j] = p; qo[4 * n + j] = q; }
            pp[m] = (u32x2){pack4_i8(pe[0] * SPQ, pe[1] * SPQ, pe[2] * SPQ, pe[3] * SPQ), pack4_i8(pe[4] * SPQ, pe[5] * SPQ, pe[6] * SPQ, pe[7] * SPQ)};
            pq[m] = (u32x2){pack4_i8(qo[0] * SPQ, qo[1] * SPQ, qo[2] * SPQ, qo[3] * SPQ), pack4_i8(qo[4] * SPQ, qo[5] * SPQ, qo[6] * SPQ, qo[7] * SPQ)}; }
        unsigned char* base = PQT + (size_t)(bg * 128 + wr * 64 + fr) * DK + lt * 128 + wc * 32;
        store_rows8(base, DK, pp, fq); store_rows8(base + QOFF, DK, pq, fq);
    }
};
struct EpiSeq { static constexpr bool TWO_PART = false;
    static constexpr bool PERM = true;
    unsigned char* FOUR;
    __device__ __forceinline__ void operator()(AccRef acc, const Unit& u, int wr, int wc, int fr, int fq) const {
        const float us = 1.0f / (127.0f * sqrtf(128.0f * (float)LSEQ) * SPQ);
#pragma unroll
        for (int ai = 0; ai < 2; ++ai)
#pragma unroll
            for (int bj = 0; bj < 2; ++bj) { const int n = u.pn * 256 + bj * 128 + wc * 32, b = n >> 9, cc = n & 511, k0 = u.pm * 256 + ai * 128 + wr * 64 + fr; u32x2 pk[4];
#pragma unroll
                for (int m = 0; m < 4; ++m) { const f32x4 z0 = i2f(acc[ai][bj][m][0], us), z1 = i2f(acc[ai][bj][m][1], us);
                    pk[m] = (u32x2){pack4_fp8(z0[0], z0[1], z0[2], z0[3]), pack4_fp8(z1[0], z1[1], z1[2], z1[3])}; }
                store_rows8(FOUR + (size_t)(b * LSEQ + k0) * FW + cc, FW, pk, fq); }
    }
};
__device__ __forceinline__ void unpack8(const u32x4 w, f32x4& a, f32x4& b) { a = (f32x4){bflo(w.x), bfhi(w.x), bflo(w.y), bfhi(w.y)}; b = (f32x4){bflo(w.z), bfhi(w.z), bflo(w.w), bfhi(w.w)}; }
__device__ __forceinline__ f32x4 fmaxv(const f32x4 a) { return (f32x4){fmaxf(a[0], 0.5f), fmaxf(a[1], 0.5f), fmaxf(a[2], 0.5f), fmaxf(a[3], 0.5f)}; }
struct EpiMerge {
    static constexpr bool PERM = true, TWO_PART = true;
    unsigned char* MG; const unsigned char* G;
    typedef f32x4 (&AccMut)[2][2][4][2];
    __device__ __forceinline__ void mid(AccMut acc, const Unit& u, int wr, int wc, int fr, int fq) const {
#pragma unroll
        for (int ai = 0; ai < 2; ++ai)
#pragma unroll
            for (int m = 0; m < 4; ++m) { int row = u.pm * 256 + ai * 128 + wr * 64 + 16 * m + fr; if (row >= T) row = T - 1;
#pragma unroll
                for (int bj = 0; bj < 2; ++bj) { const int col = u.pn * 256 + bj * 128 + wc * 32 + 8 * fq;
                    const u32x2 wa = *(const u32x2*)(G + (size_t)row * (2 * D) + col), wb = *(const u32x2*)(G + (size_t)row * (2 * D) + D + col);
                    const f32x4 a0 = unpack4_u8(wa.x), a1 = unpack4_u8(wa.y), b0 = unpack4_u8(wb.x), b1 = unpack4_u8(wb.y);
#pragma unroll
                    for (int j = 0; j < 4; ++j) { acc[ai][bj][m][0][j] *= a0[j] * __builtin_amdgcn_rcpf(fmaxf(b0[j], 0.5f)); acc[ai][bj][m][1][j] *= a1[j] * __builtin_amdgcn_rcpf(fmaxf(b1[j], 0.5f)); } } }
    }
    __device__ __forceinline__ void operator()(AccRef acc, const Unit& u, int wr, int wc, int fr, int fq) const {
#pragma unroll
        for (int ai = 0; ai < 2; ++ai)
#pragma unroll
            for (int bj = 0; bj < 2; ++bj) { const int row0 = u.pm * 256 + ai * 128 + wr * 64 + fr, colg = u.pn * 256 + bj * 128 + wc * 32; u32x2 pk[4];
#pragma unroll
                for (int m = 0; m < 4; ++m) { const u32x2 wb = *(const u32x2*)(G + (size_t)(row0 + 16 * m) * (2 * D) + D + colg + 8 * fq);
                    const f32x4 g0 = fmaxv(unpack4_u8(wb.x)) * (1.0f / 255.0f), g1 = fmaxv(unpack4_u8(wb.y)) * (1.0f / 255.0f);
                    const f32x4 o0 = acc[ai][bj][m][0] * g0, o1 = acc[ai][bj][m][1] * g1;
                    pk[m] = (u32x2){pack4_fp8(o0[0], o0[1], o0[2], o0[3]), pack4_fp8(o1[0], o1[1], o1[2], o1[3])}; }
                store_rows8(MG + (size_t)row0 * D + colg, D, pk, fq); }
    }
};
struct EpiWout { static constexpr bool TWO_PART = false;
    static constexpr bool PERM = true;
    unsigned char* MIXB;
    __device__ __forceinline__ void operator()(AccRef acc, const Unit& u, int wr, int wc, int fr, int fq) const {
#pragma unroll
        for (int ai = 0; ai < 2; ++ai)
#pragma unroll
            for (int bj = 0; bj < 2; ++bj) { u32x2 pk[4];
#pragma unroll
                for (int m = 0; m < 4; ++m) { const f32x4 a0 = acc[ai][bj][m][0], a1 = acc[ai][bj][m][1]; pk[m] = (u32x2){pack4_fp8(a0[0], a0[1], a0[2], a0[3]), pack4_fp8(a1[0], a1[1], a1[2], a1[3])}; }
                store_rows8(MIXB + (size_t)(u.pm * 256 + ai * 128 + wr * 64 + fr) * D + u.pn * 256 + bj * 128 + wc * 32, D, pk, fq); }
    }
};
struct EpiGU { static constexpr bool TWO_PART = false;
    static constexpr bool PERM = true;
    bf16_t* HID; bool active;
    __device__ __forceinline__ void operator()(AccRef acc, const Unit& u, int wr, int wc, int fr, int fq) const {
        if (!active) return;
        constexpr float dq = 1.0f / (SX * SW);
#pragma unroll
        for (int ai = 0; ai < 2; ++ai) { u32x2 pk[4];
#pragma unroll
            for (int m = 0; m < 4; ++m) { f32x4 o[2];
#pragma unroll
                for (int n = 0; n < 2; ++n)
                    { const f32x4 ga = i2f(acc[ai][0][m][n], 1.0f), up = i2f(acc[ai][1][m][n], 1.0f);
#pragma unroll
                    for (int j = 0; j < 4; ++j) o[n][j] = (ga[j] * up[j]) * __builtin_amdgcn_rcpf(__builtin_fmaf(__builtin_amdgcn_exp2f(ga[j] * (-LOG2E * dq)), 1.0f / (dq * dq), 1.0f / (dq * dq))); }
                pk[m] = (u32x2){pack4_fp8(o[0][0], o[0][1], o[0][2], o[0][3]), pack4_fp8(o[1][0], o[1][1], o[1][2], o[1][3])}; }
            store_rows8((unsigned char*)HID + (size_t)((u.pm >> 4) * ESLOTS + (u.pm & 15) * 256 + ai * 128 + wr * 64 + fr) * FF + u.pn * 128 + wc * 32, FF, pk, fq); }
    }
};
struct EpiDown { static constexpr bool TWO_PART = false;
    static constexpr bool PERM = true;
    unsigned char* Y; const float* GATE; bool active;
    __device__ __forceinline__ void operator()(AccRef acc, const Unit& u, int wr, int wc, int fr, int fq) const {
        if (!active) return;
#pragma unroll
        for (int ai = 0; ai < 2; ++ai) { const int row0 = (u.pm >> 4) * ESLOTS + (u.pm & 15) * 256 + ai * 128 + wr * 64 + fr; float g[4];
#pragma unroll
            for (int m = 0; m < 4; ++m) g[m] = GATE[row0 + 16 * m];
#pragma unroll
            for (int bj = 0; bj < 2; ++bj) { u32x2 pk[4];
#pragma unroll
                for (int m = 0; m < 4; ++m) { const f32x4 y0 = acc[ai][bj][m][0] * g[m], y1 = acc[ai][bj][m][1] * g[m]; pk[m] = (u32x2){pack4_fp8(y0[0], y0[1], y0[2], y0[3]), pack4_fp8(y1[0], y1[1], y1[2], y1[3])}; }
                store_rows8(Y + (size_t)row0 * D + u.pn * 256 + bj * 128 + wc * 32, D, pk, fq); } }
    }
};

__device__ __forceinline__ void transpose_item(const float* W, int K, int N, int k0, int n0, bf16_t* WT, int drow0, LAS float* scr, int lane) {
    float r[64];
#pragma unroll
    for (int kk = 0; kk < 64; ++kk) r[kk] = __builtin_nontemporal_load(W + (size_t)(k0 + kk) * N + n0 + lane);
#pragma unroll
    for (int kk = 0; kk < 64; ++kk) scr[kk * 65 + lane] = r[kk];
    LDS_WAIT(); asm volatile("" ::: "memory");
    const int c = lane & 7;
#pragma unroll
    for (int j = 0; j < 8; ++j) { const int n = (lane >> 3) + 8 * j; const LAS float* s = scr + (8 * c) * 65 + n;
        u32x4 o; o.x = cvtpk(s[0 * 65], s[1 * 65]); o.y = cvtpk(s[2 * 65], s[3 * 65]); o.z = cvtpk(s[4 * 65], s[5 * 65]); o.w = cvtpk(s[6 * 65], s[7 * 65]);
        *(u32x4*)(WT + (size_t)(drow0 + n) * K + k0 + 8 * c) = o; }
    LDS_WAIT(); asm volatile("" ::: "memory");
}
template <bool I8>
__device__ __forceinline__ void transpose_item_q(const float* W, int K, int N, int k0, int n0, unsigned char* WT, int drow0, float sc, LAS float* scr, int lane) {
    float r[64];
#pragma unroll
    for (int kk = 0; kk < 64; ++kk) r[kk] = __builtin_nontemporal_load(W + (size_t)(k0 + kk) * N + n0 + lane);
#pragma unroll
    for (int kk = 0; kk < 64; ++kk) scr[kk * 65 + lane] = r[kk] * sc;
    LDS_WAIT(); asm volatile("" ::: "memory");
    const int c = lane & 7;
#pragma unroll
    for (int j = 0; j < 8; ++j) { const int n = (lane >> 3) + 8 * j; const LAS float* s = scr + (8 * c) * 65 + n;
        u32x2 o; if constexpr (I8) { o.x = pack4_i8(s[0 * 65], s[1 * 65], s[2 * 65], s[3 * 65]); o.y = pack4_i8(s[4 * 65], s[5 * 65], s[6 * 65], s[7 * 65]); }
        else { o.x = pack4_fp8(s[0 * 65], s[1 * 65], s[2 * 65], s[3 * 65]); o.y = pack4_fp8(s[4 * 65], s[5 * 65], s[6 * 65], s[7 * 65]); }
        *(u32x2*)(WT + (size_t)(drow0 + n) * K + k0 + 8 * c) = o; }
    LDS_WAIT(); asm volatile("" ::: "memory");
}
__device__ __forceinline__ void ln_row(f32x4 (&v)[4], const f32x4 (&gm)[4], const f32x4 (&bt)[4], float& mean_o, float& rstd_o) {
    float s = 0.f;
#pragma unroll
    for (int j = 0; j < 4; ++j) s += (v[j][0] + v[j][1]) + (v[j][2] + v[j][3]);
    const float mean = wave_sum(s) * (1.f / D); float s2 = 0.f;
#pragma unroll
    for (int j = 0; j < 4; ++j) { v[j] = v[j] - mean; s2 += (v[j][0] * v[j][0] + v[j][1] * v[j][1]) + (v[j][2] * v[j][2] + v[j][3] * v[j][3]); }
    const float rstd = 1.0f / sqrtf(wave_sum(s2) * (1.f / D) + LN_EPS);
#pragma unroll
    for (int j = 0; j < 4; ++j) v[j] = v[j] * rstd * gm[j] + bt[j];
    mean_o = mean; rstd_o = rstd;
}
__device__ __forceinline__ void ln_row(f32x4 (&v)[4], const f32x4 (&gm)[4], const f32x4 (&bt)[4]) { float a, b; ln_row(v, gm, bt, a, b); }
__device__ __forceinline__ void ln_apply(f32x4 (&v)[4], const f32x4 (&gm)[4], const f32x4 (&bt)[4], float mean, float rstd) {
#pragma unroll
    for (int j = 0; j < 4; ++j) { v[j] = v[j] - mean; v[j] = v[j] * rstd * gm[j] + bt[j]; }
}
typedef _Float16 f16x4 __attribute__((ext_vector_type(4)));
__device__ __forceinline__ f32x4 h2f(const f16x4 h) { return __builtin_convertvector(h, f32x4); }
__device__ __forceinline__ void store_row(const f32x4 (&v)[4], _Float16* hrow, unsigned char* h8row, int lane) {
#pragma unroll
    for (int j = 0; j < 4; ++j) { *(f16x4*)(hrow + 4 * lane + 256 * j) = __builtin_convertvector(v[j], f16x4); *(unsigned*)(h8row + 4 * lane + 256 * j) = pack4_i8(v[j][0] * SX, v[j][1] * SX, v[j][2] * SX, v[j][3] * SX); }
}

constexpr int CV_IN = 16 * 52, CV_A = 8 * 16, CV_O = 16 * 16, CV_E = 16 * 24  , CV_D = 24 * 16  ;
constexpr int CV_PER_LAYER = CV_IN + 2 * CV_A + CV_O + NE * (2 * CV_E + CV_D);
struct ConvDesc { const float* src; unsigned char* dst; int N, K; float sc; bool i8; };
__device__ __forceinline__ ConvDesc conv_desc(const Frame& F, int it) { ConvDesc d; const int l = it / CV_PER_LAYER; int r = it % CV_PER_LAYER;
    if (r < CV_IN) { const int kb = r / 52, nb = r % 52; d.N = INW; d.K = D; d.src = F.w_in + (size_t)l * D * INW + (size_t)(kb * 64) * INW + nb * 64; d.dst = WSP(unsigned char, WS_WIN) + (size_t)l * INW * D + (size_t)(nb * 64) * D + kb * 64; d.sc = SW; d.i8 = true; return d; } r -= CV_IN;
    if (r < CV_A) { const int kb = r / 16, nb = r % 16; d.N = D; d.K = AW; d.src = F.w_attn_o + (size_t)l * AW * D + (size_t)(kb * 64) * D + nb * 64; d.dst = WSP(unsigned char, WS_WA) + (size_t)l * D * AW + (size_t)(nb * 64) * AW + kb * 64; d.sc = (float)(1 << WAF_SHIFT); d.i8 = false; return d; } r -= CV_A;
    if (r < CV_A) { const int kb = r / 16, nb = r % 16; d.N = D; d.K = FW; d.src = F.w_four_o + (size_t)l * FW * D + (size_t)(kb * 64) * D + nb * 64; d.dst = WSP(unsigned char, WS_WF) + (size_t)l * D * FW + (size_t)(nb * 64) * FW + kb * 64; d.sc = (float)(1 << WAF_SHIFT); d.i8 = false; return d; } r -= CV_A;
    if (r < CV_O) { const int kb = r / 16, nb = r % 16; d.N = D; d.K = D; d.src = F.w_out + (size_t)l * D * D + (size_t)(kb * 64) * D + nb * 64; d.dst = WSP(unsigned char, WS_WOUT) + (size_t)l * D * D + (size_t)(nb * 64) * D + kb * 64; d.sc = (float)(1 << WOUT_SHIFT); d.i8 = false; return d; } r -= CV_O;
    const int e = r / (2 * CV_E + CV_D); r %= (2 * CV_E + CV_D);
    if (r < 2 * CV_E) { const int up = r / CV_E; r %= CV_E; const int kb = r / 24, nb = r % 24, n0 = nb * 64; d.N = FF; d.K = D;
        d.src = (up ? F.w_e_up : F.w_e_gate) + ((size_t)l * NE + e) * D * FF + (size_t)(kb * 64) * FF + n0;
        d.dst = WSP(unsigned char, WS_WGU) + ((size_t)l * NE + e) * (2 * FF) * D + (size_t)((n0 >> 7) * 256 + up * 128 + (n0 & 127)) * D + kb * 64; d.sc = SW; d.i8 = true; return d; }
    r -= 2 * CV_E;
    { const int kb = r / 16, nb = r % 16; d.N = D; d.K = FF; d.src = F.w_e_down + ((size_t)l * NE + e) * FF * D + (size_t)(kb * 64) * D + nb * 64;
      d.dst = WSP(unsigned char, WS_WD) + ((size_t)l * NE + e) * D * FF + (size_t)(nb * 64) * FF + kb * 64; d.sc = (float)(1 << WD_SHIFT); d.i8 = false; return d; } }
__device__ __forceinline__ void conv_item_regs(const ConvDesc& d, int lane) {
    float r[64];
#pragma unroll
    for (int kk = 0; kk < 64; ++kk) r[kk] = __builtin_nontemporal_load(d.src + (size_t)kk * d.N + lane);
    unsigned char* o = d.dst + (size_t)lane * d.K;
#pragma unroll
    for (int j = 0; j < 4; ++j) { u32x4 w;
        if (d.i8) { w.x = pack4_i8(r[16 * j] * d.sc, r[16 * j + 1] * d.sc, r[16 * j + 2] * d.sc, r[16 * j + 3] * d.sc); w.y = pack4_i8(r[16 * j + 4] * d.sc, r[16 * j + 5] * d.sc, r[16 * j + 6] * d.sc, r[16 * j + 7] * d.sc);
                    w.z = pack4_i8(r[16 * j + 8] * d.sc, r[16 * j + 9] * d.sc, r[16 * j + 10] * d.sc, r[16 * j + 11] * d.sc); w.w = pack4_i8(r[16 * j + 12] * d.sc, r[16 * j + 13] * d.sc, r[16 * j + 14] * d.sc, r[16 * j + 15] * d.sc); }
        else { w.x = pack4_fp8(r[16 * j] * d.sc, r[16 * j + 1] * d.sc, r[16 * j + 2] * d.sc, r[16 * j + 3] * d.sc); w.y = pack4_fp8(r[16 * j + 4] * d.sc, r[16 * j + 5] * d.sc, r[16 * j + 6] * d.sc, r[16 * j + 7] * d.sc);
               w.z = pack4_fp8(r[16 * j + 8] * d.sc, r[16 * j + 9] * d.sc, r[16 * j + 10] * d.sc, r[16 * j + 11] * d.sc); w.w = pack4_fp8(r[16 * j + 12] * d.sc, r[16 * j + 13] * d.sc, r[16 * j + 14] * d.sc, r[16 * j + 15] * d.sc); }
        *(u32x4*)(o + 16 * j) = w; }
}
__device__ __forceinline__ void conv_range_regs(const Frame& F, int cl, int first, int stride, int count) {
    int lane_ = F.lane; asm volatile("" : "+v"(lane_));
#pragma unroll 1
    for (int i = 0; i < count; ++i) { const int it = first + i * stride; if (it >= CV_PER_LAYER) break; const ConvDesc d = conv_desc(F, cl * CV_PER_LAYER + it); conv_item_regs(d, lane_); }
    asm volatile("s_waitcnt vmcnt(0)" ::: "memory");
}
#ifndef CV_NA
#define CV_NA 2
#endif
#ifndef CV_NB
#define CV_NB 2
#endif
constexpr int CV_SLOT_A = CV_NA * (256 - 141) * 8, CV_SLOT_B = CV_NB * 128 * 8;
__device__ __forceinline__ void conv_share_regs(const Frame& F, int cl) {
    const int pre = (F.G == 256) ? CV_SLOT_A + CV_SLOT_B : 0;
    conv_range_regs(F, cl, pre + F.bid * 8 + F.wave, F.G * 8, CV_PER_LAYER);
}
__device__ __forceinline__ void p0_prologue(Frame& F) {
    const int gw = F.bid * 8 + F.wave, NGW = F.G * 8, gt = F.bid * 512 + F.tid, NGT = F.G * 512;
    {
        LAS float* scr = (LAS float*)(F.lds + F.wave * 16640);
        constexpr int TOTAL = CV_PER_LAYER * CONV_P0_LAYERS;
        typedef ConvDesc Desc;
        auto make = [&](int it) -> Desc { return conv_desc(F, it); };
#define P0_LOAD(d, r) do { _Pragma("unroll") for (int kk = 0; kk < 64; ++kk) r[kk] = __builtin_nontemporal_load((d).src + (size_t)kk * (d).N + F.lane); } while (0)
#define P0_FINISH(d, r) do { _Pragma("unroll") for (int kk = 0; kk < 64; ++kk) scr[kk * 65 + F.lane] = r[kk] * (d).sc; \
            LDS_WAIT(); asm volatile("" ::: "memory"); const int c_ = F.lane & 7; \
            _Pragma("unroll") for (int j = 0; j < 8; ++j) { const int n_ = (F.lane >> 3) + 8 * j; const LAS float* s_ = scr + (8 * c_) * 65 + n_; u32x2 o_; \
                if ((d).i8) { o_.x = pack4_i8(s_[0 * 65], s_[1 * 65], s_[2 * 65], s_[3 * 65]); o_.y = pack4_i8(s_[4 * 65], s_[5 * 65], s_[6 * 65], s_[7 * 65]); } \
                else { o_.x = pack4_fp8(s_[0 * 65], s_[1 * 65], s_[2 * 65], s_[3 * 65]); o_.y = pack4_fp8(s_[4 * 65], s_[5 * 65], s_[6 * 65], s_[7 * 65]); } \
                *(u32x2*)((d).dst + (size_t)n_ * (d).K + 8 * c_) = o_; } \
            LDS_WAIT(); asm volatile("" ::: "memory"); } while (0)
        float r0[64], r1[64]; Desc d0, d1;
        if (gw < TOTAL) { d0 = make(gw); P0_LOAD(d0, r0); }
#pragma unroll 1
        for (int it = gw; it < TOTAL; it += 2 * NGW) {
            const bool v1 = it + NGW < TOTAL; if (v1) { d1 = make(it + NGW); P0_LOAD(d1, r1); }
            P0_FINISH(d0, r0);
            if (it + 2 * NGW < TOTAL) { d0 = make(it + 2 * NGW); P0_LOAD(d0, r0); }
            if (v1) P0_FINISH(d1, r1);
        }
#undef P0_LOAD
#undef P0_FINISH
    }
    {
        const float sc = 127.0f, invL = 1.0f / (float)LSEQ;
        unsigned char* M = WSP(unsigned char, WS_DFTM);
        for (int ch = gt; ch < DK * (DK / 16); ch += NGT) { const int k = ch / (DK / 16), j0 = (ch % (DK / 16)) * 16; float v[16];
#pragma unroll
            for (int jj = 0; jj < 16; ++jj) { const int j = j0 + jj; float val = 0.f;
                if (k < LSEQ) { if (j <= HALFL) val = __builtin_amdgcn_cosf((float)((k * j) % LSEQ) * invL) * sc;
                                else if (j >= QOFF && j - QOFF <= HALFL) val = -__builtin_amdgcn_sinf((float)((k * (j - QOFF)) % LSEQ) * invL) * sc; }
                v[jj] = val; }
            u32x4 o; o.x = pack4_i8(v[0], v[1], v[2], v[3]); o.y = pack4_i8(v[4], v[5], v[6], v[7]); o.z = pack4_i8(v[8], v[9], v[10], v[11]); o.w = pack4_i8(v[12], v[13], v[14], v[15]);
            *(u32x4*)(M + (size_t)k * DK + j0) = o; }
        bf16_t* C = WSP(bf16_t, WS_CSM);
        for (int idx = gt; idx < 256 * 256; idx += NGT) { const int n = idx >> 8, c = idx & 255; float val = 0.f;
            if (c < 128) { const float ph = (float)(((n & 127) * c) & 127) * (1.0f / 128.0f); val = (n < 128) ? __builtin_amdgcn_cosf(ph) : __builtin_amdgcn_sinf(ph); }
            C[idx] = f2bf(val); }
    }
    {
        u32x4 z = {0u, 0u, 0u, 0u};
        u32x4* vt = WSP(u32x4, WS_VT); for (int i = gt; i < (int)((size_t)BATCH * NKV * HD * VT_LD * 2 / 16); i += NGT) vt[i] = z;
        u32x4* ri = WSP(u32x4, WS_ROWIDX); for (int i = gt; i < NSLOT * 4 / 16; i += NGT) ri[i] = z;
        u32x4* ga = WSP(u32x4, WS_GATE); for (int i = gt; i < NSLOT * 4 / 16; i += NGT) ga[i] = z;
        u32x4* hp = (u32x4*)(WSP(unsigned char, WS_HB8) + (size_t)T * D); for (int i = gt; i < (TP - T) * D / 16; i += NGT) hp[i] = z;
    }
    {
        f32x4 gm[4], bt[4];
#pragma unroll
        for (int j = 0; j < 4; ++j) { gm[j] = *(const f32x4*)(F.ln0_g + 4 * F.lane + 256 * j); bt[j] = *(const f32x4*)(F.ln0_b + 4 * F.lane + 256 * j); }
        _Float16* H = WSP(_Float16, WS_H); unsigned char* HB = WSP(unsigned char, WS_HB8);
        for (int row = gw; row < T; row += NGW) { const int b = row / LSEQ, p = row - b * LSEQ;
            const float* src = (p < NMETA) ? F.meta + (size_t)p * D : F.x + ((size_t)b * SEQ + (p - NMETA)) * D;
            f32x4 v[4];
#pragma unroll
            for (int j = 0; j < 4; ++j) v[j] = *(const f32x4*)(src + 4 * F.lane + 256 * j);
            ln_row(v, gm, bt); store_row(v, H + (size_t)row * D, HB + (size_t)row * D, F.lane); }
    }
}

__device__ __forceinline__ void attn_phase(Frame& F, int layer) {
    const bf16_t* Q = WSP(bf16_t, WS_Q); const bf16_t* KB = WSP(bf16_t, WS_KB); const bf16_t* VT = WSP(bf16_t, WS_VT); unsigned char* ATT = WSP(unsigned char, WS_ATT);
    LAS unsigned char* Ks = F.lds; LAS unsigned char* Vs = F.lds + 40960;
    int tid_ = F.tid; asm volatile("" : "+v"(tid_)); const int tid = tid_, lane = tid & 63, r32 = lane & 31, hi = lane >> 5, w = F.wave;
    u32x4 kreg[5], vreg[5];
#define ATT_LOAD(uu) do { const int qt_ = (uu) < 1024 ? ((uu) & 63) : 64, bk_ = (uu) < 1024 ? ((uu) >> 6) : (uu) - 1024, kvh_ = bk_ & 1, b_ = bk_ >> 1, kb_ = qt_ * 64 - 128; \
        _Pragma("unroll") for (int i = 0; i < 5; ++i) { const int c = tid + 512 * i, row = c >> 3, ch = c & 7; int pos = kb_ + row; pos = pos < 0 ? 0 : (pos > LSEQ - 1 ? LSEQ - 1 : pos); \
            kreg[i] = *(const u32x4*)(KB + (size_t)(b_ * LSEQ + pos) * 128 + kvh_ * 64 + ch * 8); } \
        _Pragma("unroll") for (int i = 0; i < 5; ++i) { const int c = tid + 512 * i, d = c / 40, ch = c - d * 40; \
            vreg[i] = *(const u32x4*)(VT + (size_t)((b_ * NKV + kvh_) * HD + d) * VT_LD + VT_OFF + kb_ + ch * 8); } } while (0)
    bf16x8 qf[4];
#define ATT_LOADQ(uu) do { const int qt_ = (uu) < 1024 ? ((uu) & 63) : 64, bk_ = (uu) < 1024 ? ((uu) >> 6) : (uu) - 1024, kvh_ = bk_ & 1, b_ = bk_ >> 1; \
        const int qp_ = qt_ * 64 + 32 * (w & 1) + r32, qr_ = qp_ < LSEQ ? qp_ : LSEQ - 1; \
        _Pragma("unroll") for (int d0 = 0; d0 < 4; ++d0) qf[d0] = *(const bf16x8*)(Q + (size_t)(b_ * LSEQ + qr_) * AW + (kvh_ * 4 + (w >> 1)) * 64 + 16 * d0 + 8 * hi); } while (0)
    const float snk0 = __builtin_bit_cast(float, __builtin_amdgcn_readfirstlane(__builtin_bit_cast(int, F.sink[layer * NH + (w >> 1)])));
    const float snk1 = __builtin_bit_cast(float, __builtin_amdgcn_readfirstlane(__builtin_bit_cast(int, F.sink[layer * NH + 4 + (w >> 1)])));
#define ATT_UNIT(L) ((F.G == 256 && (L) < 1024) ? (((L) & ~255) + (((L) & 7) << 5) + (((L) & 255) >> 3)) : (L))
    if (F.bid < BATCH * NKV * 65) { const int u0_ = ATT_UNIT(F.bid); ATT_LOAD(u0_); ATT_LOADQ(u0_); }
#pragma unroll 1
    for (int ul = F.bid; ul < BATCH * NKV * 65; ul += F.G) { const int u = ATT_UNIT(ul), un = ATT_UNIT(ul + F.G);
        const int qt = u < 1024 ? (u & 63) : 64, bk = u < 1024 ? (u >> 6) : u - 1024, kvh = bk & 1, b = bk >> 1, q0 = qt * 64, kb = q0 - 128;
        int tw = tid; asm volatile("" : "+v"(tw));
#pragma unroll
        for (int i = 0; i < 5; ++i) { const int c = tw + 512 * i, row = c >> 3, ch = c & 7;
            *(LAS u32x4*)(Ks + row * 128 + ((ch ^ ((row >> 1) & 7)) << 4)) = kreg[i]; }
#pragma unroll
        for (int i = 0; i < 5; ++i) { const int c = tw + 512 * i, d = c / 40, ch = c - d * 40; const u32x4 v = vreg[i];
            const int x = (d >> 1) & 15, g0 = 2 * ch;
            *(LAS u32x2*)(Vs + d * 640 + ((g0 ^ x) << 3)) = (u32x2){v.x, v.y};
            *(LAS u32x2*)(Vs + d * 640 + (((g0 + 1) ^ x) << 3)) = (u32x2){v.z, v.w}; }
        __syncthreads();
        asm volatile("" :: "v"(qf[0]), "v"(qf[1]), "v"(qf[2]), "v"(qf[3]));
        if (ul + F.G < BATCH * NKV * 65) ATT_LOAD(un);
        if (q0 + 32 * (w & 1) < LSEQ) {
            const int hq = kvh * 4 + (w >> 1), sub = w & 1, qpos = q0 + 32 * sub + r32;
            const float slope2 = __builtin_amdgcn_exp2f(-(float)(hq + 1)) * LOG2E;
            float mrun = (kvh ? snk1 : snk0) * LOG2E, lsum = hi == 0 ? 1.0f : 0.0f;
            f32x16 o0 = {}, o1 = {};
            const int kbase = kb + 4 * hi; const float frel = (float)(kbase - qpos);
            const float dlo = (float)(qpos < 128 ? -qpos : -128), dhi = (float)((LSEQ - 1 - qpos) < 128 ? (LSEQ - 1 - qpos) : 128), dmid = 0.5f * (dlo + dhi), dhalf = 0.5f * (dhi - dlo);
            const bool inner = (q0 >= 128) && (q0 + 63 + 128 <= LSEQ - 1);
            const int sw = (r32 >> 1) & 7;
            LAS unsigned char* kp = Ks + r32 * 128;
            const int x0 = (r32 >> 1) & 15;
            LAS unsigned char* vp0 = Vs + r32 * 640;
#pragma unroll
            for (int t = 0; t < 5; ++t) {
                f32x16 p0 = {}, p1 = {};
                LAS unsigned char* kt = kp + t * 8192;
#pragma unroll
                for (int d0 = 0; d0 < 4; ++d0) { const int c = 2 * d0 + hi;
                    const bf16x8 kf0 = *(const LAS bf16x8*)(kt + ((c ^ sw) << 4));
                    const bf16x8 kf1 = *(const LAS bf16x8*)(kt + 4096 + ((c ^ sw) << 4));
                    p0 = __builtin_amdgcn_mfma_f32_32x32x16_bf16(kf0, qf[d0], p0, 0, 0, 0);
                    p1 = __builtin_amdgcn_mfma_f32_32x32x16_bf16(kf1, qf[d0], p1, 0, 0, 0); }
                float tmax = -1e30f; float ft = frel + (float)(64 * t); asm volatile("" : "+v"(ft));
                if (inner && t >= 1 && t <= 3) {
                    float fa = ft; asm volatile("" : "+v"(fa));
#pragma unroll
                    for (int r = 0; r < 16; ++r) { const float cst = (float)((r & 3) + 8 * (r >> 2));
                        const float d0f = fa + cst, d1f = fa + (cst + 32.0f);
                        p0[r] = p0[r] - slope2 * fabsf(d0f); p1[r] = p1[r] - slope2 * fabsf(d1f);
                        tmax = fmaxf(tmax, fmaxf(p0[r], p1[r])); }
                } else {
                    float fb = ft; asm volatile("" : "+v"(fb)); const float fe = fb - dmid;
#pragma unroll
                    for (int r = 0; r < 16; ++r) { const float cst = (float)((r & 3) + 8 * (r >> 2));
                        const float d0f = fb + cst, d1f = fb + (cst + 32.0f), e0f = fe + cst, e1f = fe + (cst + 32.0f);
                        p0[r] = (fabsf(e0f) <= dhalf) ? p0[r] - slope2 * fabsf(d0f) : -1e30f; p1[r] = (fabsf(e1f) <= dhalf) ? p1[r] - slope2 * fabsf(d1f) : -1e30f;
                        tmax = fmaxf(tmax, fmaxf(p0[r], p1[r])); }
                }
                tmax = fmaxf(tmax, __shfl_xor(tmax, 32));
                const float mnew = fmaxf(mrun, tmax), alpha = __builtin_amdgcn_exp2f(mrun - mnew); mrun = mnew;
                if (__any(alpha != 1.0f)) { lsum *= alpha; o0 = o0 * alpha; o1 = o1 * alpha; }
                float ps = 0.f;
#pragma unroll
                for (int r = 0; r < 16; ++r) { p0[r] = __builtin_amdgcn_exp2f(p0[r] - mnew); p1[r] = __builtin_amdgcn_exp2f(p1[r] - mnew); ps += p0[r] + p1[r]; }
                lsum += ps;
                u32x4 pw[4];
                pw[0] = (u32x4){cvtpk(p0[0], p0[1]), cvtpk(p0[2], p0[3]), cvtpk(p0[4], p0[5]), cvtpk(p0[6], p0[7])};
                pw[1] = (u32x4){cvtpk(p0[8], p0[9]), cvtpk(p0[10], p0[11]), cvtpk(p0[12], p0[13]), cvtpk(p0[14], p0[15])};
                pw[2] = (u32x4){cvtpk(p1[0], p1[1]), cvtpk(p1[2], p1[3]), cvtpk(p1[4], p1[5]), cvtpk(p1[6], p1[7])};
                pw[3] = (u32x4){cvtpk(p1[8], p1[9]), cvtpk(p1[10], p1[11]), cvtpk(p1[12], p1[13]), cvtpk(p1[14], p1[15])};
                LAS unsigned char* vt0 = vp0 + t * 128;
#pragma unroll
                for (int ks = 0; ks < 4; ++ks) { const int gl = 4 * ks + hi; const int ol = (gl ^ x0) << 3, oh = ((gl + 2) ^ x0) << 3;
                    { const u32x2 lo = *(const LAS u32x2*)(vt0 + ol), h8 = *(const LAS u32x2*)(vt0 + oh);
                      const u32x4 vf = {lo.x, lo.y, h8.x, h8.y}; o0 = __builtin_amdgcn_mfma_f32_32x32x16_bf16(__builtin_bit_cast(bf16x8, vf), __builtin_bit_cast(bf16x8, pw[ks]), o0, 0, 0, 0); }
                    { const u32x2 lo = *(const LAS u32x2*)(vt0 + ol + 32 * 640), h8 = *(const LAS u32x2*)(vt0 + oh + 32 * 640);
                      const u32x4 vf = {lo.x, lo.y, h8.x, h8.y}; o1 = __builtin_amdgcn_mfma_f32_32x32x16_bf16(__builtin_bit_cast(bf16x8, vf), __builtin_bit_cast(bf16x8, pw[ks]), o1, 0, 0, 0); } }
            }
            if (ul + F.G < BATCH * NKV * 65) ATT_LOADQ(un);
            const float ltot = lsum + __shfl_xor(lsum, 32), inv = 1.0f / ltot;
            if (qpos < LSEQ) { unsigned char* orow = ATT + (size_t)(b * LSEQ + qpos) * AW + hq * 64 + 4 * hi;
#pragma unroll
                for (int rq = 0; rq < 4; ++rq) {
                    *(unsigned*)(orow + 8 * rq) = pack4_fp8(o0[4 * rq] * inv, o0[4 * rq + 1] * inv, o0[4 * rq + 2] * inv, o0[4 * rq + 3] * inv);
                    *(unsigned*)(orow + 32 + 8 * rq) = pack4_fp8(o1[4 * rq] * inv, o1[4 * rq + 1] * inv, o1[4 * rq + 2] * inv, o1[4 * rq + 3] * inv); } }
        }
        __syncthreads();
    }
#undef ATT_LOAD
#undef ATT_UNIT
#undef ATT_LOADQ
}

__device__ __forceinline__ void reduce_scatter32(float (&a)[32], int lane) {
#pragma unroll
    for (int i = 0; i < 16; ++i) { const auto r = __builtin_amdgcn_permlane32_swap(__builtin_bit_cast(unsigned, a[i]), __builtin_bit_cast(unsigned, a[i + 16]), false, false);
        unsigned r0 = r[0], r1 = r[1]; asm volatile("" : "+v"(r0), "+v"(r1));
        a[i] = __builtin_bit_cast(float, r0) + __builtin_bit_cast(float, r1); }
#pragma unroll
    for (int i = 0; i < 8; ++i) { const auto r = __builtin_amdgcn_permlane16_swap(__builtin_bit_cast(unsigned, a[i]), __builtin_bit_cast(unsigned, a[i + 8]), false, false);
        unsigned r0 = r[0], r1 = r[1]; asm volatile("" : "+v"(r0), "+v"(r1));
        a[i] = __builtin_bit_cast(float, r0) + __builtin_bit_cast(float, r1); }
    { const bool up = (lane & 8) != 0;
#pragma unroll
      for (int i = 0; i < 4; ++i) { const float keep = up ? a[i + 4] : a[i], send = up ? a[i] : a[i + 4]; a[i] = keep + dpp_xor8(send); } }
    { const bool up = (lane & 4) != 0;
#pragma unroll
      for (int i = 0; i < 2; ++i) { const float keep = up ? a[i + 2] : a[i], send = up ? a[i] : a[i + 2]; a[i] = keep + dpp_xor4(send); } }
    { const bool up = (lane & 2) != 0; const float keep = up ? a[1] : a[0], send = up ? a[0] : a[1]; a[0] = keep + dpp_xor2(send); }
    a[0] += dpp_xor1(a[0]);
}
__device__ __forceinline__ void ln1_router_phase(Frame& F, int layer, unsigned char* HBo) {
    LAS float* WrL = (LAS float*)F.lds;
    int tid_ = F.tid; asm volatile("" : "+v"(tid_)); const int lane = tid_ & 63;
    { const float* wr = F.w_router + (size_t)layer * D * NE;
      for (int idx = tid_; idx < D * NE; idx += 512) { const int d = idx >> 4, e = idx & 15, ln = (d & 255) >> 2, j = d >> 8, i = d & 3; WrL[ln * 260 + (j * 4 + i) * 16 + e] = wr[idx]; } }
    __syncthreads();
    f32x4 gm[4], bt[4];
#pragma unroll
    for (int j = 0; j < 4; ++j) { gm[j] = *(const f32x4*)(F.ln1_g + (size_t)layer * D + 4 * lane + 256 * j); bt[j] = *(const f32x4*)(F.ln1_b + (size_t)layer * D + 4 * lane + 256 * j); }
    const _Float16* H = WSP(_Float16, WS_H); _Float16* Hw = WSP(_Float16, WS_H); const unsigned char* MIXB = WSP(unsigned char, WS_MIXB); float* AFFT = WSP(float, WS_AFFT);
    const int gw = F.bid * 8 + F.wave, NGW = F.G * 8;
    f16x4 yn[2][4]; unsigned mn[2][4];
#define LN1_LOAD(g_) do { _Pragma("unroll") for (int tk = 0; tk < 2; ++tk) _Pragma("unroll") for (int j = 0; j < 4; ++j) { \
        yn[tk][j] = *(const f16x4*)(H + (size_t)((g_) * 2 + tk) * D + 4 * lane + 256 * j); mn[tk][j] = *(const unsigned*)(MIXB + (size_t)((g_) * 2 + tk) * D + 4 * lane + 256 * j); } } while (0)
    if (gw < T / 2) LN1_LOAD(gw);
#pragma unroll 1
    for (int grp = gw; grp < T / 2; grp += NGW) {
        const int row0 = grp * 2;
        f32x4 y[2][4];
#pragma unroll
        for (int tk = 0; tk < 2; ++tk)
#pragma unroll
            for (int j = 0; j < 4; ++j) y[tk][j] = h2f(yn[tk][j]) * ALPHA + unpack4_fp8(mn[tk][j]);
        if (grp + NGW < T / 2) LN1_LOAD(grp + NGW);
#pragma unroll
        for (int tk = 0; tk < 2; ++tk) { ln_row(y[tk], gm, bt);
#pragma unroll
            for (int j = 0; j < 4; ++j) *(f16x4*)(Hw + (size_t)(row0 + tk) * D + 4 * lane + 256 * j) = __builtin_convertvector(y[tk][j], f16x4);
#pragma unroll
            for (int j = 0; j < 4; ++j) *(unsigned*)(HBo + (size_t)(row0 + tk) * D + 4 * lane + 256 * j) = pack4_i8(y[tk][j][0] * SX, y[tk][j][1] * SX, y[tk][j][2] * SX, y[tk][j][3] * SX); }
        f32x2_t acc2[16];
#pragma unroll
        for (int i = 0; i < 16; ++i) acc2[i] = (f32x2_t){0.f, 0.f};
#pragma unroll
        for (int ji = 0; ji < 16; ++ji) { if ((ji & 1) == 0) asm volatile("" ::: "memory");
            const LAS f32x4* wp = (const LAS f32x4*)(WrL + lane * 260 + ji * 16); const f32x4 w0 = wp[0], w1 = wp[1], w2 = wp[2], w3 = wp[3];
#pragma unroll
            for (int tk = 0; tk < 2; ++tk) { const float yv = y[tk][ji >> 2][ji & 3];
                { const f32x2_t y2 = {yv, yv};
                  acc2[tk * 8 + 0] += y2 * (f32x2_t){w0[0], w0[1]}; acc2[tk * 8 + 1] += y2 * (f32x2_t){w0[2], w0[3]}; acc2[tk * 8 + 2] += y2 * (f32x2_t){w1[0], w1[1]}; acc2[tk * 8 + 3] += y2 * (f32x2_t){w1[2], w1[3]};
                  acc2[tk * 8 + 4] += y2 * (f32x2_t){w2[0], w2[1]}; acc2[tk * 8 + 5] += y2 * (f32x2_t){w2[2], w2[3]}; acc2[tk * 8 + 6] += y2 * (f32x2_t){w3[0], w3[1]}; acc2[tk * 8 + 7] += y2 * (f32x2_t){w3[2], w3[3]}; } } }
        float acc[32];
#pragma unroll
        for (int i = 0; i < 16; ++i) { acc[2 * i] = acc2[i][0]; acc[2 * i + 1] = acc2[i][1]; }
        reduce_scatter32(acc, lane);
        const float logit = acc[0]; float mx = logit;
        mx = fmaxf(mx, dpp_xor2(mx)); mx = fmaxf(mx, dpp_xor4(mx)); mx = fmaxf(mx, dpp_xor8(mx)); mx = fmaxf(mx, __shfl_xor(mx, 16));
        const float ex = __expf(logit - mx); float sm = ex;
        sm += dpp_xor2(sm); sm += dpp_xor4(sm); sm += dpp_xor8(sm); sm += __shfl_xor(sm, 16);
        if ((lane & 1) == 0) { const int row = row0 + (lane >> 5), e = (lane >> 1) & 15, b = row / LSEQ, p = row - b * LSEQ;
            AFFT[(size_t)(b * NE + e) * AFF_LD + p] = ex / sm; }
    }
#undef LN1_LOAD
}

__device__ __forceinline__ void topk_phase(Frame& F) {
    LAS unsigned* cnt = (LAS unsigned*)F.lds; LAS unsigned* pre = cnt + 64;
    const float* AFFT = WSP(float, WS_AFFT); int* ROWIDX = WSP(int, WS_ROWIDX); float* GATE = WSP(float, WS_GATE); int* SLOTMAP = WSP(int, WS_SLOTMAP);
    int tid_ = F.tid; asm volatile("" : "+v"(tid_)); const int tid = tid_, lane = tid & 63, wave = F.wave;
    for (int item = F.bid; item < BATCH * NE; item += F.G) {
        const int b = item >> 4, e = item & 15; const float* a = AFFT + (size_t)item * AFF_LD;
        unsigned key[9];
#pragma unroll
        for (int i = 0; i < 9; ++i) { const int p = tid * 9 + i; key[i] = p < LSEQ ? __float_as_uint(a[p]) : 0u; }
        unsigned thr = 0u;
#pragma unroll 1
        for (int it = 0; it < 15; ++it) { const unsigned hb = 1u << (30 - 2 * it), lb = hb >> 1, c10 = thr | hb, c01 = thr | lb, c11 = c10 | lb; unsigned n10 = 0, n01 = 0, n11 = 0;
#pragma unroll
            for (int i = 0; i < 9; ++i) { n10 += (unsigned)__popcll(__ballot(key[i] >= c10)); n01 += (unsigned)__popcll(__ballot(key[i] >= c01)); n11 += (unsigned)__popcll(__ballot(key[i] >= c11)); }
            if (lane == 0) { cnt[(it & 1) * 24 + wave * 3 + 0] = n10; cnt[(it & 1) * 24 + wave * 3 + 1] = n01; cnt[(it & 1) * 24 + wave * 3 + 2] = n11; }
            __syncthreads();
            unsigned t10 = 0, t01 = 0, t11 = 0;
#pragma unroll
            for (int w2 = 0; w2 < 8; ++w2) { t10 += cnt[(it & 1) * 24 + w2 * 3 + 0]; t01 += cnt[(it & 1) * 24 + w2 * 3 + 1]; t11 += cnt[(it & 1) * 24 + w2 * 3 + 2]; }
            if (t10 >= (unsigned)CAP) thr = (t11 >= (unsigned)CAP) ? c11 : c10; else if (t01 >= (unsigned)CAP) thr = c01; }
        { const unsigned cand = thr | 1u; unsigned c = 0;
#pragma unroll
            for (int i = 0; i < 9; ++i) c += (unsigned)__popcll(__ballot(key[i] >= cand));
            if (lane == 0) cnt[24 + wave * 3] = c;
            __syncthreads();
            unsigned tot = 0;
#pragma unroll
            for (int w2 = 0; w2 < 8; ++w2) tot += cnt[24 + w2 * 3];
            if (tot >= (unsigned)CAP) thr = cand; }
        unsigned pg = 0, pe = 0;
#pragma unroll
        for (int i = 0; i < 9; ++i) { pg += key[i] > thr ? 1u : 0u; pe += key[i] == thr ? 1u : 0u; }
        unsigned v = pg | (pe << 16);
#pragma unroll
        for (int o = 1; o < 64; o <<= 1) { const unsigned t2 = __shfl_up(v, o); if (lane >= o) v += t2; }
        if (lane == 63) pre[wave] = v;
        __syncthreads();
        unsigned woff = 0, tot = 0;
#pragma unroll
        for (int w2 = 0; w2 < 8; ++w2) { const unsigned x = pre[w2]; if (w2 < wave) woff += x; tot += x; }
        const unsigned need = (unsigned)CAP - (tot & 0xffffu);
        unsigned excl = v - (pg | (pe << 16)) + woff; unsigned gtb = excl & 0xffffu, eqb = excl >> 16;
#pragma unroll
        for (int i = 0; i < 9; ++i) { const int p = tid * 9 + i; const bool isgt = key[i] > thr, iseq = key[i] == thr, sel = isgt || (iseq && eqb < need);
            if (p < LSEQ) { const int row = b * LSEQ + p; int s = -1;
                if (sel) { s = e * ESLOTS + b * CAP + (int)(gtb + (eqb < need ? eqb : need)); ROWIDX[s] = row; GATE[s] = __uint_as_float(key[i]); }
                SLOTMAP[(size_t)row * NE + e] = s; }
            gtb += isgt ? 1u : 0u; eqb += iseq ? 1u : 0u; }
        __syncthreads();
    }
}

__device__ __forceinline__ void combine_ln2_phase(Frame& F, int layer, _Float16* Ho, unsigned char* HBo) {
    int lane_ = F.lane; asm volatile("" : "+v"(lane_)); const int lane = lane_;
    f32x4 gm[4], bt[4];
#pragma unroll
    for (int j = 0; j < 4; ++j) { gm[j] = *(const f32x4*)(F.ln2_g + (size_t)layer * D + 4 * lane + 256 * j); bt[j] = *(const f32x4*)(F.ln2_b + (size_t)layer * D + 4 * lane + 256 * j); }
    const _Float16* H = WSP(_Float16, WS_H); const unsigned char* Y = WSP(unsigned char, WS_Y); const int* SLOTMAP = WSP(int, WS_SLOTMAP);
    const int gw = F.bid * 8 + F.wave, NGW = F.G * 8;
    f16x4 hvN[2][4]; unsigned mskN[2]; int slN[2][4]; unsigned ywN[2][4][4]; int smN[2];
    int smA[2] = {0, 0};
#define P10_SEL(r0_, sm_) do { _Pragma("unroll") for (int q = 0; q < 2; ++q) { const int row_ = (q == 0 || (r0_) + NGW >= T) ? (r0_) : (r0_) + NGW; sm_[q] = SLOTMAP[(size_t)row_ * NE + (lane & 15)]; } } while (0)
#define P10_LOAD(r0_, sm_) do { _Pragma("unroll") for (int q = 0; q < 2; ++q) { const int row_ = (q == 0 || (r0_) + NGW >= T) ? (r0_) : (r0_) + NGW; \
        _Pragma("unroll") for (int j = 0; j < 4; ++j) hvN[q][j] = *(const f16x4*)(H + (size_t)row_ * D + 4 * lane + 256 * j); \
        smN[q] = sm_[q]; \
        unsigned mm_ = (unsigned)__ballot(sm_[q] >= 0) & 0xffffu; \
        _Pragma("unroll") for (int k = 0; k < 4; ++k) { int s_ = -1; if (mm_) { const int e_ = __builtin_ctz(mm_); mm_ &= mm_ - 1; s_ = __builtin_amdgcn_readlane(sm_[q], e_); } slN[q][k] = s_; \
            const unsigned char* yr_ = Y + (size_t)(s_ >= 0 ? s_ : 0) * D + 4 * lane; \
            _Pragma("unroll") for (int j = 0; j < 4; ++j) ywN[q][k][j] = *(const unsigned*)(yr_ + 256 * j); } \
        mskN[q] = mm_; } } while (0)
    int rc = gw, rn = gw + 2 * NGW;
    { int sm0[2]; P10_SEL(rc, sm0); P10_LOAD(rc, sm0); }
    if (rn < T) P10_SEL(rn, smA);
#pragma unroll 1
    for (;;) {
        int rows[2]; rows[0] = rc; rows[1] = (rc + NGW < T) ? rc + NGW : rc;
        f32x4 v[2][4]; unsigned msk[2]; int sl[2][4]; int sm[2]; unsigned yw[2][4][4];
#pragma unroll
        for (int q = 0; q < 2; ++q) { msk[q] = mskN[q]; sm[q] = smN[q];
#pragma unroll
            for (int j = 0; j < 4; ++j) v[q][j] = h2f(hvN[q][j]) * ALPHA;
#pragma unroll
            for (int k = 0; k < 4; ++k) { sl[q][k] = slN[q][k];
#pragma unroll
                for (int j = 0; j < 4; ++j) yw[q][k][j] = ywN[q][k][j]; } }
        const bool has_next = rn < T; const int rnn = rn + 2 * NGW;
        if (has_next) { P10_LOAD(rn, smA); if (rnn < T) P10_SEL(rnn, smA); }
#pragma unroll
        for (int q = 0; q < 2; ++q) {
#pragma unroll
            for (int k = 0; k < 4; ++k) { const float wgt = sl[q][k] >= 0 ? 1.0f : 0.0f;
#pragma unroll
                for (int j = 0; j < 4; ++j) v[q][j] += unpack4_fp8(yw[q][k][j]) * wgt; }
            unsigned mm = msk[q];
            while (mm) { const int e = __builtin_ctz(mm); mm &= mm - 1; const int s = __builtin_amdgcn_readlane(sm[q], e); const unsigned char* yr = Y + (size_t)s * D + 4 * lane;
#pragma unroll
                for (int j = 0; j < 4; ++j) v[q][j] += unpack4_fp8(*(const unsigned*)(yr + 256 * j)); }
            ln_row(v[q], gm, bt);
            if (q == 0 || rows[1] != rows[0]) {
                if (layer < DEPTH - 1) store_row(v[q], Ho + (size_t)rows[q] * D, HBo + (size_t)rows[q] * D, lane);
                else { const int b = rows[q] / LSEQ, p = rows[q] - b * LSEQ;
                    if (p >= NMETA) { float* o = F.out + ((size_t)b * SEQ + (p - NMETA)) * D;
#pragma unroll
                        for (int j = 0; j < 4; ++j) *(f32x4*)(o + 4 * lane + 256 * j) = v[q][j]; } } }
        }
        if (!has_next) break;
        rc = rn; rn = rnn;
    }
#undef P10_SEL
#undef P10_LOAD
}

template <class Dsc>
__device__ __forceinline__ void skinny_phase(Frame& F, const Dsc& S) {
    constexpr int NB = Dsc::NB;
    int tid_ = F.tid; asm volatile("" : "+v"(tid_)); const int tid = tid_, lane = tid & 63, fr = lane & 15, fq = lane >> 4, w = F.wave;
    LAS f32x4* red = (LAS f32x4*)F.lds;
#pragma unroll 1
    for (int t0 = F.bid; t0 < S.ntasks; t0 += F.G * NB) {
        f32x4 acc[NB][4];
#pragma unroll
        for (int b = 0; b < NB; ++b)
#pragma unroll
            for (int j = 0; j < 4; ++j) acc[b][j] = (f32x4){0.f, 0.f, 0.f, 0.f};
        const int ns = S.ksteps(w);
        if constexpr (Dsc::MODE == 2) {
            const unsigned char* ap[NB]; const unsigned char* bp[NB][4]; v4i_t ia[NB][4];
#pragma unroll
            for (int b = 0; b < NB; ++b) { int t = t0 + b * F.G; if (t >= S.ntasks) t = t0;
                ap[b] = S.a_ptr(t, w, fr) + 32 * fq;
#pragma unroll
                for (int j = 0; j < 4; ++j) { bp[b][j] = S.b_ptr(t, w, 16 * j + fr) + 32 * fq; ia[b][j] = (v4i_t){0, 0, 0, 0}; } }
#pragma unroll
            for (int s = 0; s < ns; ++s)
#pragma unroll
                for (int b = 0; b < NB; ++b) { const v4i_t a0 = *(const v4i_t*)(ap[b] + 128 * s), a1 = *(const v4i_t*)(ap[b] + 128 * s + 16);
#pragma unroll
                    for (int j = 0; j < 4; ++j) { const v4i_t b0 = *(const v4i_t*)(bp[b][j] + 128 * s), b1 = *(const v4i_t*)(bp[b][j] + 128 * s + 16);
                        ia[b][j] = __builtin_amdgcn_mfma_i32_16x16x64_i8(b0, a0, ia[b][j], 0, 0, 0); ia[b][j] = __builtin_amdgcn_mfma_i32_16x16x64_i8(b1, a1, ia[b][j], 0, 0, 0); } }
#pragma unroll
            for (int b = 0; b < NB; ++b)
#pragma unroll
                for (int j = 0; j < 4; ++j) acc[b][j] = (f32x4){(float)ia[b][j][0], (float)ia[b][j][1], (float)ia[b][j][2], (float)ia[b][j][3]};
        } else if constexpr (Dsc::MODE == 1) {
            static_assert(NB == 1, "batched passes: int8 descriptors only");
            const unsigned char* ap = S.a_ptr(t0, w, fr) + 32 * fq;
            const unsigned char* bp[4];
#pragma unroll
            for (int j = 0; j < 4; ++j) bp[j] = S.b_ptr(t0, w, 16 * j + fr) + 32 * fq;
#pragma unroll
            for (int s = 0; s < ns; ++s) { const v8i_t a = *(const v8i_t*)(ap + 128 * s);
#pragma unroll
                for (int j = 0; j < 4; ++j) { const v8i_t b = *(const v8i_t*)(bp[j] + 128 * s); acc[0][j] = __builtin_amdgcn_mfma_scale_f32_16x16x128_f8f6f4(b, a, acc[0][j], 0, 0, 0, Dsc::SCALE_W * 0x01010101, 0, 0x7f7f7f7f); } }
        } else {
            static_assert(NB == 1, "batched passes: int8 descriptors only");
            const bf16_t* ap = S.a_ptr(t0, w, fr) + 8 * fq;
            const bf16_t* bp[4];
#pragma unroll
            for (int j = 0; j < 4; ++j) bp[j] = S.b_ptr(t0, w, 16 * j + fr) + 8 * fq;
#pragma unroll 2
            for (int s = 0; s < ns; ++s) { const bf16x8 a = *(const bf16x8*)(ap + 32 * s);
#pragma unroll
                for (int j = 0; j < 4; ++j) { const bf16x8 b = *(const bf16x8*)(bp[j] + 32 * s); acc[0][j] = __builtin_amdgcn_mfma_f32_16x16x32_bf16(b, a, acc[0][j], 0, 0, 0); } }
        }
#pragma unroll
        for (int b = 0; b < NB; ++b)
#pragma unroll
            for (int j = 0; j < 4; ++j) red[((b * 8 + w) * 4 + j) * 64 + lane] = acc[b][j];
        __syncthreads();
#pragma unroll
        for (int b = 0; b < NB; ++b) { const int t = t0 + b * F.G; if (t >= S.ntasks) break; LAS f32x4* rb = red + b * 8 * 4 * 64;
            if constexpr (Dsc::PAIRED) {
                if (tid < 128) { const int j = tid >> 6; f32x4 ga = rb[(0 * 4 + j) * 64 + lane], up = rb[(0 * 4 + j + 2) * 64 + lane];
#pragma unroll
                    for (int ww = 1; ww < 8; ++ww) { ga += rb[(ww * 4 + j) * 64 + lane]; up += rb[(ww * 4 + j + 2) * 64 + lane]; }
                    S.fin(t, fr, 16 * j + 4 * fq, ga, up); }
            } else
            if (tid < 256) { const int j = tid >> 6; f32x4 lo = rb[(0 * 4 + j) * 64 + lane], hi = rb[(4 * 4 + j) * 64 + lane];
#pragma unroll
                for (int ww = 1; ww < 4; ++ww) { lo += rb[(ww * 4 + j) * 64 + lane]; hi += rb[((4 + ww) * 4 + j) * 64 + lane]; }
                S.fin(t, fr, 16 * j + 4 * fq, lo, hi); } }
        __syncthreads();
    }
}

struct SkSeq { static constexpr int NB = 1; static constexpr int MODE = 2; static constexpr bool PAIRED = false;
    static constexpr int ntasks = 64;
    __device__ __forceinline__ int ksteps(int w) const { return 4 + (w < 2 ? 1 : 0); }
    __device__ __forceinline__ int kbeg(int w) const { return (4 * w + (w < 2 ? w : 2)) * 128; }
    const unsigned char* DFTM; const unsigned char* PQT; unsigned char* FOUR;
    __device__ __forceinline__ const unsigned char* a_ptr(int, int w, int r) const { return DFTM + (size_t)(4096 + r) * DK + kbeg(w); }
    __device__ __forceinline__ const unsigned char* b_ptr(int t, int w, int c) const { return PQT + (size_t)(64 * t + c) * DK + kbeg(w); }
    __device__ __forceinline__ void fin(int t, int r, int c, const f32x4 lo, const f32x4 hi) const { const int k = 4096 + r, n = 64 * t + c, b = n >> 9;
        const f32x4 z = (lo + hi) * (1.0f / (127.0f * sqrtf(128.0f * (float)LSEQ) * SPQ)); *(unsigned*)(FOUR + (size_t)(b * LSEQ + k) * FW + (n & 511)) = pack4_fp8(z[0], z[1], z[2], z[3]); }
};
struct SkMerge { static constexpr int NB = 1; static constexpr int MODE = 1; static constexpr bool PAIRED = false; static constexpr int SCALE_W = 127 - WAF_SHIFT;
    static constexpr int ntasks = 128, nsteps = 1; __device__ __forceinline__ int ksteps(int) const { return nsteps; }
    const unsigned char *ATT, *FOUR, *WA, *WF; const unsigned char* G; unsigned char* MG;
    __device__ __forceinline__ const unsigned char* a_ptr(int t, int w, int r) const { return ((w >> 2) ? FOUR : ATT) + (size_t)(32768 + 16 * (t >> 4) + r) * AW + (w & 3) * 128; }
    __device__ __forceinline__ const unsigned char* b_ptr(int t, int w, int c) const { return ((w >> 2) ? WF : WA) + (size_t)(64 * (t & 15) + c) * AW + (w & 3) * 128; }
    __device__ __forceinline__ void fin(int t, int r, int c, const f32x4 lo, const f32x4 hi) const { const int row = 32768 + 16 * (t >> 4) + r, col = 64 * (t & 15) + c;
        const f32x4 g0 = unpack4_u8(*(const unsigned*)(G + (size_t)row * (2 * D) + col)) * (1.0f / 255.0f), g1 = unpack4_u8(*(const unsigned*)(G + (size_t)row * (2 * D) + D + col)) * (1.0f / 255.0f);
        const f32x4 o = g0 * lo + g1 * hi; *(unsigned*)(MG + (size_t)row * D + col) = pack4_fp8(o[0], o[1], o[2], o[3]); }
};
struct SkWout { static constexpr int NB = 1; static constexpr int MODE = 1; static constexpr bool PAIRED = false; static constexpr int SCALE_W = 127 - WOUT_SHIFT;
    static constexpr int ntasks = 128, nsteps = 1; __device__ __forceinline__ int ksteps(int) const { return nsteps; }
    const unsigned char *MG, *WOUT; unsigned char* MIXB;
    __device__ __forceinline__ const unsigned char* a_ptr(int t, int w, int r) const { return MG + (size_t)(32768 + 16 * (t >> 4) + r) * D + w * 128; }
    __device__ __forceinline__ const unsigned char* b_ptr(int t, int w, int c) const { return WOUT + (size_t)(64 * (t & 15) + c) * D + w * 128; }
    __device__ __forceinline__ void fin(int t, int r, int c, const f32x4 lo, const f32x4 hi) const { const f32x4 o = lo + hi; *(unsigned*)(MIXB + (size_t)(32768 + 16 * (t >> 4) + r) * D + 64 * (t & 15) + c) = pack4_fp8(o[0], o[1], o[2], o[3]); }
};
struct SkDown { static constexpr int NB = 1; static constexpr int MODE = 1; static constexpr bool PAIRED = false; static constexpr int SCALE_W = 127 - WD_SHIFT;
    static constexpr int ntasks = NE * 8, nsteps = FF / 4 / 128; __device__ __forceinline__ int ksteps(int) const { return nsteps; }
    const unsigned char *HID, *WD; const float* GATE; unsigned char* Y;
    __device__ __forceinline__ const unsigned char* a_ptr(int t, int w, int r) const { return HID + (size_t)((t >> 3) * ESLOTS + 4096 + r) * FF + (w & 3) * (FF / 4); }
    __device__ __forceinline__ const unsigned char* b_ptr(int t, int w, int c) const { return WD + ((size_t)(t >> 3) * D + 128 * (t & 7) + 64 * (w >> 2) + c) * FF + (w & 3) * (FF / 4); }
    __device__ __forceinline__ void fin(int t, int r, int c, const f32x4 lo, const f32x4 hi) const { const int slot = (t >> 3) * ESLOTS + 4096 + r; const float g = GATE[slot];
        unsigned char* y = Y + (size_t)slot * D + 128 * (t & 7) + c; const f32x4 a = lo * g, b = hi * g; *(unsigned*)y = pack4_fp8(a[0], a[1], a[2], a[3]); *(unsigned*)(y + 64) = pack4_fp8(b[0], b[1], b[2], b[3]); }
};
struct SkGU { static constexpr int NB = 3; static constexpr int MODE = 2; static constexpr bool PAIRED = true;
    static constexpr int ntasks = NE * (FF / 32), nsteps = 1; __device__ __forceinline__ int ksteps(int) const { return nsteps; }
    const unsigned char *HB8, *WGU; const int* ROWIDX; unsigned char* HID;
    __device__ __forceinline__ const unsigned char* a_ptr(int t, int w, int r) const { const int e = t / (FF / 32); return HB8 + (size_t)ROWIDX[e * ESLOTS + 4096 + r] * D + w * 128; }
    __device__ __forceinline__ const unsigned char* b_ptr(int t, int w, int c) const { const int e = t / (FF / 32), hc = (t % (FF / 32)) * 32 + (c & 31), up = c >> 5;
        return WGU + ((size_t)e * (2 * FF) + (hc >> 7) * 256 + up * 128 + (hc & 127)) * D + w * 128; }
    __device__ __forceinline__ void fin(int t, int r, int c, const f32x4 ga, const f32x4 up) const { const int e = t / (FF / 32), slot = e * ESLOTS + 4096 + r, hc = (t % (FF / 32)) * 32 + c; f32x4 o;
#pragma unroll
        for (int j = 0; j < 4; ++j) { const float g = ga[j] * (1.0f / (SX * SW)); o[j] = g * fast_sigmoid(g) * (up[j] * (1.0f / (SX * SW))); }
        *(unsigned*)(HID + (size_t)slot * FF + hc) = pack4_fp8(o[0], o[1], o[2], o[3]); }
};

#ifndef PHASE_MASK
#define PHASE_MASK 0xFFFF
#endif
#define EN(k) ((PHASE_MASK >> (k)) & 1)
#ifndef REP_PHASE
#define REP_PHASE -1
#endif
#ifndef REP_NOEPI
#define REP_NOEPI 0
#endif
#define NREP(k) ((REP_PHASE) == (k) ? 2 : 1)
#define EPI_ON(k) (!(REP_NOEPI && NREP(k) == 2 && rep == 1))
constexpr int PH_PER_LAYER = 10, N_PHASES = 1 + DEPTH * PH_PER_LAYER;
struct Args { const float* in[18]; float* out; unsigned char* ws; int ph_lo, ph_hi; };
template <bool ALL>
__global__ void __launch_bounds__(512, 2) mk_fwd(Args args) {
    extern __shared__ __attribute__((aligned(16))) unsigned char lds_raw[];
    Frame F;
    F.lds = (LAS unsigned char*)lds_raw;
    F.tid = threadIdx.x; F.lane = F.tid & 63; F.wave = __builtin_amdgcn_readfirstlane(F.tid >> 6); F.G = gridDim.x; F.bid = blockIdx.x;
    F.x = args.in[0]; F.meta = args.in[1]; F.ln0_g = args.in[2]; F.ln0_b = args.in[3]; F.w_in = args.in[4]; F.b_gate = args.in[5]; F.sink = args.in[6];
    F.w_attn_o = args.in[7]; F.w_four_o = args.in[8]; F.w_out = args.in[9]; F.ln1_g = args.in[10]; F.ln1_b = args.in[11]; F.w_router = args.in[12];
    F.w_e_gate = args.in[13]; F.w_e_up = args.in[14]; F.w_e_down = args.in[15]; F.ln2_g = args.in[16]; F.ln2_b = args.in[17];
    F.out = args.out; F.ws = args.ws;
    volatile LAS unsigned* MISC = (volatile LAS unsigned*)(F.lds + MISC_OFF);
    if (F.tid < 64) MISC[F.tid] = 0u;
    __syncthreads();
    const int lo = ALL ? 0 : args.ph_lo, hi = ALL ? (MK_DEBUG ? 3 : N_PHASES) : args.ph_hi;
    unsigned* ctl = (unsigned*)(F.ws + WS_CTL);
    XcdBarrier bar; bar.bar = ctl + CW_BAR; bar.x = 0; bar.st = nullptr;
    if (hi - lo > 1) bar = xcd_barrier_post(ctl + CW_BAR, MISC + 8);
#define IN(k) (ALL ? (!MK_DEBUG || (k) < 3) : (lo <= (k) && (k) < hi))
#if defined(MK_PROBE_A)
    unsigned long long* ts = (unsigned long long*)(ctl + 2048);
#define STAMP(i) do { if (F.bid == 0 && F.tid == 0) ts[i] = __builtin_amdgcn_s_memrealtime(); } while (0)
#define SEAM(k) do { xcd_barrier(bar); STAMP((k) + 1); } while (0)
    STAMP(0);
#else
#define SEAM(k) do { if (IN(k) && IN((k) + 1)) xcd_barrier(bar); } while (0)
#endif
    LAS unsigned char* ring = F.lds;

    if (EN(0) && IN(0)) { for (int rep = 0; rep < NREP(0); ++rep) { p0_prologue(F); if (rep + 1 < NREP(0)) xcd_barrier(bar); } }
    SEAM(0);
    for (int layer = 0; layer < DEPTH; ++layer) {
        const int pb = 1 + layer * PH_PER_LAYER;
        if (EN(1) && IN(pb + 0)) for (int rep = 0; rep < NREP(1); ++rep) { if (rep) xcd_barrier(bar);
            SchedInProj S; S.o.init(TP / 256, INW / 256, F.G, F.bid); S.o1.init(128, 8, F.G, F.bid); S.o2.init(129, 5, F.G, F.bid); S.bal = (F.G == 256);
            S.A = (const char*)WSP(unsigned char, WS_HB8); S.B = (const char*)(WSP(unsigned char, WS_WIN) + (size_t)layer * INW * D); S.lda = D; S.ldb = D;
            EpiInProj E{WSP(bf16_t, WS_Q), WSP(bf16_t, WS_KB), WSP(bf16_t, WS_VT), WSP(bf16_t, WS_UF), WSP(unsigned char, WS_G), F.b_gate + (size_t)layer * 2 * D, EPI_ON(1)};
            pg8::gemm_phase<EpiInProj, SchedInProj, true, 2>(ring, S, E, D, D);
            if (F.G == 256 && F.bid >= 141 && layer + 1 < DEPTH && layer + 1 >= CONV_P0_LAYERS && rep == 0) conv_range_regs(F, layer + 1, (F.bid - 141) * 8 + F.wave, (256 - 141) * 8, CV_NA);
        }
        SEAM(pb + 0);
        if (EN(2) && IN(pb + 1)) for (int rep = 0; rep < NREP(2); ++rep) { if (rep) xcd_barrier(bar);
#ifndef NO_ATTN
#ifdef REP_CHAN_ONLY
            if (rep == 0)
#endif
            attn_phase(F, layer);
#endif
#ifndef NO_CHAN
            const bool skip16 = (F.G > 64);
            SchedChan S; S.o.init(BATCH * 4 * 17, 1, skip16 ? F.G - 16 : F.G, skip16 ? (F.bid < 16 ? BATCH * 4 * 17 : F.bid - 16) : F.bid); S.UF = (const char*)WSP(bf16_t, WS_UF); S.CSM = (const char*)WSP(bf16_t, WS_CSM);
            EpiChan E{WSP(unsigned char, WS_PQT)};
            pg8::gemm_phase<EpiChan, SchedChan, true>(ring, S, E, 256, 512);
#endif
        }
        SEAM(pb + 1);
        if (EN(3) && IN(pb + 2)) for (int rep = 0; rep < NREP(3); ++rep) { if (rep) xcd_barrier(bar);
            { SchedReg S; S.o.init(4096 / 256, 4096 / 256, F.G, F.bid); S.A = (const char*)WSP(unsigned char, WS_DFTM); S.B = (const char*)WSP(unsigned char, WS_PQT); S.lda = DK; S.ldb = DK;
              EpiSeq E{WSP(unsigned char, WS_FOUR)};
              pg8::gemm_phase<EpiSeq, SchedReg, true, 2>(ring, S, E, DK, DK); }
            { SkSeq K{WSP(unsigned char, WS_DFTM), WSP(unsigned char, WS_PQT), WSP(unsigned char, WS_FOUR)}; skinny_phase(F, K); }
        }
        SEAM(pb + 2);
        if (EN(4) && IN(pb + 3)) for (int rep = 0; rep < NREP(4); ++rep) { if (rep) xcd_barrier(bar);
            SchedMerge S; S.o.init(32768 / 256, D / 256, F.G, F.bid); S.ATT = (const char*)WSP(unsigned char, WS_ATT); S.FOUR = (const char*)WSP(unsigned char, WS_FOUR);
            S.WA = (const char*)(WSP(unsigned char, WS_WA) + (size_t)layer * D * AW); S.WF = (const char*)(WSP(unsigned char, WS_WF) + (size_t)layer * D * FW);
            EpiMerge E{WSP(unsigned char, WS_MG), WSP(unsigned char, WS_G)};
            pg8::gemm_phase<EpiMerge, SchedMerge, true, 1, 127 - WAF_SHIFT>(ring, S, E, AW, AW);
            { SkMerge K{WSP(unsigned char, WS_ATT), WSP(unsigned char, WS_FOUR), WSP(unsigned char, WS_WA) + (size_t)layer * D * AW, WSP(unsigned char, WS_WF) + (size_t)layer * D * FW, WSP(unsigned char, WS_G), WSP(unsigned char, WS_MG)}; skinny_phase(F, K); }
        }
        SEAM(pb + 3);
        if (EN(5) && IN(pb + 4)) for (int rep = 0; rep < NREP(5); ++rep) { if (rep) xcd_barrier(bar);
            SchedReg S; S.o.init(32768 / 256, D / 256, F.G, F.bid); S.A = (const char*)WSP(unsigned char, WS_MG); S.B = (const char*)(WSP(unsigned char, WS_WOUT) + (size_t)layer * D * D); S.lda = D; S.ldb = D;
            EpiWout E{(NREP(5) == 2 && rep == 0) ? WSP(unsigned char, WS_Q) : WSP(unsigned char, WS_MIXB)};
            pg8::gemm_phase<EpiWout, SchedReg, true, 1, 127 - WOUT_SHIFT>(ring, S, E, D, D);
            { SkWout K{WSP(unsigned char, WS_MG), WSP(unsigned char, WS_WOUT) + (size_t)layer * D * D, (NREP(5) == 2 && rep == 0) ? WSP(unsigned char, WS_Q) : WSP(unsigned char, WS_MIXB)}; skinny_phase(F, K); }
        }
        SEAM(pb + 4);
        if (EN(6) && IN(pb + 5)) for (int rep = 0; rep < NREP(6); ++rep) { if (rep) xcd_barrier(bar); ln1_router_phase(F, layer, (NREP(6) == 2 && rep == 0) ? WSP(unsigned char, WS_G) : WSP(unsigned char, WS_HB8)); }
        SEAM(pb + 5);
        if (EN(7) && IN(pb + 6)) for (int rep = 0; rep < NREP(7); ++rep) { if (rep) xcd_barrier(bar); topk_phase(F);
            if (F.G == 256 && F.bid >= 128 && layer + 1 < DEPTH && layer + 1 >= CONV_P0_LAYERS && rep == 0) conv_range_regs(F, layer + 1, CV_SLOT_A + (F.bid - 128) * 8 + F.wave, 128 * 8, CV_NB); }
        SEAM(pb + 6);
        if (EN(8) && IN(pb + 7)) for (int rep = 0; rep < NREP(8); ++rep) { if (rep) xcd_barrier(bar);
            SchedGU S; S.o.init(NE * 16, (2 * FF) / 256, F.G, F.bid); S.HB = (const char*)WSP(unsigned char, WS_HB8); S.WGU = (const char*)(WSP(unsigned char, WS_WGU) + (size_t)layer * NE * (2 * FF) * D);
            LAS int* idxtab = (LAS int*)(F.lds + IDXTAB_OFF); S.idxtab = idxtab;
            S.Fp = &F; S.conv_layer = (layer + 1 < DEPTH && layer + 1 >= CONV_P0_LAYERS && rep == 0) ? layer + 1 : -1; S.conv_slot = F.bid % 8;
            const int* ROWIDX = WSP(int, WS_ROWIDX);
            { int t_ = F.tid; asm volatile("" : "+v"(t_));
              for (int i = 0; i < IDXTAB_UNITS; ++i) { int pm, pn; if (!S.o.tile(i, pm, pn)) break; if (t_ < 256) idxtab[i * 256 + t_] = ROWIDX[(pm >> 4) * ESLOTS + (pm & 15) * 256 + t_]; } }
            __syncthreads();
            EpiGU E{WSP(bf16_t, WS_HID), EPI_ON(8)};
            pg8::gemm_phase<EpiGU, SchedGU, true, 2>(ring, S, E, D, D);
            { SkGU K{WSP(unsigned char, WS_HB8), WSP(unsigned char, WS_WGU) + (size_t)layer * NE * (2 * FF) * D, WSP(int, WS_ROWIDX), WSP(unsigned char, WS_HID)}; skinny_phase(F, K); }
        }
        SEAM(pb + 7);
        if (EN(9) && IN(pb + 8)) for (int rep = 0; rep < NREP(9); ++rep) { if (rep) xcd_barrier(bar);
            SchedDown S; S.o.init(NE * 16, D / 256, F.G, F.bid); S.HID = (const char*)WSP(bf16_t, WS_HID); S.WD = (const char*)(WSP(unsigned char, WS_WD) + (size_t)layer * NE * D * FF);
            EpiDown E{WSP(unsigned char, WS_Y), WSP(float, WS_GATE), EPI_ON(9)};
            pg8::gemm_phase<EpiDown, SchedDown, true, 1, 127 - WD_SHIFT>(ring, S, E, FF, FF);
            { SkDown K{WSP(unsigned char, WS_HID), WSP(unsigned char, WS_WD) + (size_t)layer * NE * D * FF, WSP(float, WS_GATE), WSP(unsigned char, WS_Y)}; skinny_phase(F, K); }
        }
        SEAM(pb + 8);
        if (EN(10) && IN(pb + 9)) for (int rep = 0; rep < NREP(10); ++rep) { if (rep) xcd_barrier(bar); combine_ln2_phase(F, layer, (NREP(10) == 2 && rep == 0) ? WSP(_Float16, WS_HID) : WSP(_Float16, WS_H), (NREP(10) == 2 && rep == 0) ? WSP(unsigned char, WS_HID + (size_t)TP * D * 4) : WSP(unsigned char, WS_HB8)); }
        SEAM(pb + 9);
#ifdef EXTRA_BAR
        for (int xb = 0; xb < EXTRA_BAR; ++xb) xcd_barrier(bar);
#endif
    }
#if defined(MK_PROBE_A)
    if (F.bid == 0) {
        float A = 0.f, B = 0.f;
        if (MK_PROBE_A == 0) A = (float)(ts[1] - ts[0]); else for (int l = 0; l < DEPTH; ++l) A += (float)(ts[1 + l * 10 + MK_PROBE_A + 0] - ts[1 + l * 10 + MK_PROBE_A - 1]);
        if (MK_PROBE_B == 0) B = (float)(ts[1] - ts[0]); else for (int l = 0; l < DEPTH; ++l) B += (float)(ts[1 + l * 10 + MK_PROBE_B + 0] - ts[1 + l * 10 + MK_PROBE_B - 1]);
        A *= 0.01f; B *= 0.01f;
        for (int j = F.tid; j < 33554; j += 512) { if (j == 0) F.out[0] = A; else F.out[(size_t)j * 1000] += B; }
    }
#endif
#undef IN
#undef SEAM
}

#if MK_DEBUG
__global__ void chk_attn(const unsigned char* ws, const float* sink, unsigned* errw) {
    const int s = blockIdx.x, d = threadIdx.x;
    const bf16_t* Q = (const bf16_t*)(ws + WS_Q); const bf16_t* KB = (const bf16_t*)(ws + WS_KB); const bf16_t* VT = (const bf16_t*)(ws + WS_VT); const unsigned char* ATT = ws + WS_ATT;
    int row;
    if (s < 64) { const int k = s & 15; const int p = k < 3 ? (k == 2 ? 15 : k) : k < 5 ? 13 + k : k < 7 ? 58 + k : k < 11 ? 120 + k : k == 11 ? 2056 : k < 14 ? 3971 + k : 4096 + k; row = ((s >> 4) * 2 + ((s >> 4) == 3 ? 1 : 0)) * LSEQ + p; }
    else row = (int)(((unsigned)s * 2654435761u) % (unsigned)T);
    const int hq = s & 7, kvh = hq >> 2, b = row / LSEQ, i = row - b * LSEQ;
    const float q = bf2f(Q[(size_t)row * AW + hq * 64 + d]);
    const float slope2 = exp2f(-(float)(hq + 1)) * LOG2E, sink2 = sink[hq] * LOG2E;
    const int j0 = i - 128 < 0 ? 0 : i - 128, j1 = i + 128 > LSEQ - 1 ? LSEQ - 1 : i + 128;
    float m = sink2;
    for (int j = j0; j <= j1; ++j) { float sc = wave_sum(q * bf2f(KB[(size_t)(b * LSEQ + j) * 128 + kvh * 64 + d])); sc -= slope2 * fabsf((float)(j - i)); m = fmaxf(m, sc); }
    float o = 0.f, den = exp2f(sink2 - m);
    for (int j = j0; j <= j1; ++j) { float sc = wave_sum(q * bf2f(KB[(size_t)(b * LSEQ + j) * 128 + kvh * 64 + d])); sc -= slope2 * fabsf((float)(j - i)); const float p = exp2f(sc - m); den += p;
        o += p * bf2f(VT[(size_t)((b * NKV + kvh) * HD + d) * VT_LD + VT_OFF + j]); }
    const float r = o / den, a = __builtin_amdgcn_cvt_f32_fp8((int)ATT[(size_t)row * AW + hq * 64 + d], 0);
    float err = fabsf(r - a), scale = fabsf(r);
    for (int x = 1; x < 64; x <<= 1) { err = fmaxf(err, __shfl_xor(err, x)); scale = fmaxf(scale, __shfl_xor(scale, x)); }
    if (d == 0) atomicMax(errw, __float_as_uint(err / fmaxf(scale, 1e-2f)));
}
__global__ void chk_report(const unsigned* errw, float* out, int n) {
    const int i = blockIdx.x * blockDim.x + threadIdx.x; if (i >= n) return;
    out[i] = (i == 0) ? 1000.0f + 10000.0f * __uint_as_float(errw[0]) : 0.0f;
}
static void debug_driver(Args a, int grid, hipStream_t stream, int out_size) {
    a.ph_lo = 0; a.ph_hi = 3;
    hipLaunchKernelGGL(mk_fwd<true>, dim3(grid), dim3(512), LDS_BYTES, stream, a);
    unsigned* errw = (unsigned*)(a.ws + WS_CTL) + CW_ERR;
    hipLaunchKernelGGL(chk_attn, dim3(8192), dim3(64), 0, stream, (const unsigned char*)a.ws, a.in[6], errw);
    hipLaunchKernelGGL(chk_report, dim3((out_size + 255) / 256), dim3(256), 0, stream, (const unsigned*)errw, a.out, out_size);
}
#endif

extern "C" void kernel_launch(void* const* d_in, const int* in_sizes, int n_in, void* d_out, int out_size, void* d_ws, size_t ws_size, hipStream_t stream) {
#if defined(MK_PER_PHASE)
    auto MKF = mk_fwd<false>;
#else
    auto MKF = mk_fwd<true>;
#endif
    static int grid = 0;
    if (grid == 0) {
        int dev = 0, cus = 0, per_cu = 0;
        if (hipGetDevice(&dev) != hipSuccess || hipDeviceGetAttribute(&cus, hipDeviceAttributeMultiprocessorCount, dev) != hipSuccess) { fprintf(stderr, "kernel_launch: device query failed\n"); grid = -1; return; }
        if (hipFuncSetAttribute((const void*)MKF, hipFuncAttributeMaxDynamicSharedMemorySize, LDS_BYTES) != hipSuccess) { fprintf(stderr, "kernel_launch: hipFuncSetAttribute failed\n"); grid = -1; return; }
        if (hipOccupancyMaxActiveBlocksPerMultiprocessor(&per_cu, (const void*)MKF, 512, LDS_BYTES) != hipSuccess || per_cu < 1) fprintf(stderr, "kernel_launch: occupancy query reports %d\n", per_cu);
        (void)hipGetLastError();
        if (ws_size < WS_END) fprintf(stderr, "kernel_launch: workspace %zu < %zu\n", ws_size, (size_t)WS_END);
        grid = cus;
    }
    if (grid < 0) return;
    (void)hipMemsetAsync((char*)d_ws + WS_CTL, 0, CTL_BYTES, stream);
    Args a{};
    for (int i = 0; i < 18; ++i) a.in[i] = (const float*)d_in[i];
    a.out = (float*)d_out; a.ws = (unsigned char*)d_ws;
#if MK_DEBUG
    debug_driver(a, grid, stream, out_size);
#elif defined(MK_PER_PHASE)
    for (int p = 0; p < N_PHASES; ++p) { a.ph_lo = p; a.ph_hi = p + 1; hipLaunchKernelGGL(MKF, dim3(grid), dim3(512), LDS_BYTES, stream, a); }
#else
    a.ph_lo = 0; a.ph_hi = N_PHASES;
    hipLaunchKernelGGL(MKF, dim3(grid), dim3(512), LDS_BYTES, stream, a);
#endif
}
```

```cpp
#include <hip/hip_runtime.h>
#include <cstdio>
#include <cstdint>

#ifndef MK_DEBUG
#define MK_DEBUG 0
#endif

#define LAS __attribute__((address_space(3)))
#define GAS __attribute__((address_space(1)))
typedef unsigned short bf16_t;
typedef short bf16x8 __attribute__((ext_vector_type(8)));
typedef int v8i_t __attribute__((ext_vector_type(8)));
typedef int v4i_t __attribute__((ext_vector_type(4)));
typedef short s16x4 __attribute__((ext_vector_type(4)));
typedef float f32x4 __attribute__((ext_vector_type(4)));
typedef float f32x16 __attribute__((ext_vector_type(16)));
typedef unsigned u32x4 __attribute__((ext_vector_type(4)));
typedef unsigned u32x2 __attribute__((ext_vector_type(2)));
typedef float f32x2_t __attribute__((ext_vector_type(2)));
typedef __bf16 bf16x2_t __attribute__((ext_vector_type(2)));

constexpr int D = 1024, BATCH = 8, SEQ = 4096, DEPTH = 4, NMETA = 16;
constexpr int LSEQ = SEQ + NMETA;
constexpr int T = BATCH * LSEQ;
constexpr int TP = 33024;
constexpr int NH = 8, NKV = 2, HD = 64, AW = 512, FW = 512, INW = 3328;
constexpr int NE = 16, CAP = 514, FF = 1536;
constexpr int ESLOTS = 4352;
constexpr int NSLOT = NE * ESLOTS;
constexpr int DK = 4352, QOFF = 2176;
constexpr int HALFL = LSEQ / 2;
constexpr int VT_LD = 4480, VT_OFF = 128;
constexpr int AFF_LD = 4128;
constexpr float LN_EPS = 1e-5f;
constexpr float ALPHA = 1.681792830507429f;
constexpr float LOG2E = 1.4426950408889634f;
#ifndef CONV_P0_LAYERS
#define CONV_P0_LAYERS 1
#endif
constexpr float SX = 20.0f;
constexpr float SW = 739.0f;
constexpr float SPQ = 1.75f;
constexpr int DFT_SHIFT = 9;
constexpr int WIN_SHIFT = 5;
constexpr int WGU_SHIFT = 5;
constexpr int WAF_SHIFT = 6;
constexpr int WOUT_SHIFT = 6;
constexpr int WD_SHIFT = 6;
constexpr float QSCALE = 0.125f * LOG2E;

constexpr size_t al(size_t x) { return (x + 4095) & ~(size_t)4095; }
constexpr size_t WS_CTL = 0, CTL_BYTES = 1u << 20;
constexpr size_t WS_WIN = WS_CTL + CTL_BYTES;
constexpr size_t WS_WA = WS_WIN + al((size_t)DEPTH * INW * D * 2);
constexpr size_t WS_WF = WS_WA + al((size_t)DEPTH * D * AW * 2);
constexpr size_t WS_WOUT = WS_WF + al((size_t)DEPTH * D * FW * 2);
constexpr size_t WS_WGU = WS_WOUT + al((size_t)DEPTH * D * D * 2);
constexpr size_t WS_WD = WS_WGU + al((size_t)DEPTH * NE * 2 * FF * D * 2);
constexpr size_t WS_DFTM = WS_WD + al((size_t)DEPTH * NE * D * FF * 2);
constexpr size_t WS_CSM = WS_DFTM + al((size_t)DK * DK * 2);
constexpr size_t WS_H = WS_CSM + al(256 * 256 * 2);
constexpr size_t WS_HB = WS_H + al((size_t)TP * D * 4);
constexpr size_t WS_VT = WS_HB + al((size_t)TP * D * 2);
constexpr size_t WS_ROWIDX = WS_VT + al((size_t)BATCH * NKV * HD * VT_LD * 2);
constexpr size_t WS_GATE = WS_ROWIDX + al((size_t)NSLOT * 4);
constexpr size_t WS_HB8 = WS_GATE + al((size_t)NSLOT * 4);
constexpr size_t WS_MIXB = WS_HB8 + al((size_t)TP * D);
constexpr size_t WS_STATS = WS_MIXB + al((size_t)TP * D * 2);
constexpr size_t WS_TMP = WS_STATS + al((size_t)TP * 8);
constexpr size_t WS_Q = WS_TMP;
constexpr size_t WS_KB = WS_Q + al((size_t)TP * AW * 2);
constexpr size_t WS_UF = WS_KB + al((size_t)TP * 128 * 2);
constexpr size_t WS_G = WS_UF + al((size_t)TP * FW * 2 + 4096);
constexpr size_t WS_ATT = WS_G + al((size_t)TP * 2 * D * 2);
constexpr size_t WS_PQT = WS_ATT + al((size_t)TP * AW * 2);
constexpr size_t WS_FOUR = WS_PQT + al((size_t)4096 * DK * 2);
constexpr size_t WS_P1 = WS_FOUR + al((size_t)TP * FW * 2);
constexpr size_t WS_MG = WS_P1 + al((size_t)TP * D * 2);
constexpr size_t WS_MIX_END = WS_MG + al((size_t)TP * D * 2);
constexpr size_t WS_AFFT = WS_TMP;
constexpr size_t WS_SLOTMAP = WS_AFFT + al((size_t)BATCH * NE * AFF_LD * 4);
constexpr size_t WS_HID = WS_SLOTMAP + al((size_t)T * NE * 4);
constexpr size_t WS_Y = WS_HID + al((size_t)NSLOT * FF * 2);
constexpr size_t WS_MOE_END = WS_Y + al((size_t)NSLOT * D * 2);
constexpr size_t WS_END = (WS_MIX_END > WS_MOE_END ? WS_MIX_END : WS_MOE_END);
static_assert(WS_END <= (size_t)1536 * 1024 * 1024, "d_ws map exceeds the guaranteed workspace");

constexpr int CW_BAR = 4096;
constexpr int CW_ERR = 1024;

constexpr int RING_BYTES = 131072;
constexpr int IDXTAB_OFF = RING_BYTES;
constexpr int IDXTAB_UNITS = 14;
constexpr int MISC_OFF = IDXTAB_OFF + IDXTAB_UNITS * 1024;
constexpr int LDS_BYTES = 147456;
static_assert(MISC_OFF + 256 <= LDS_BYTES, "LDS map");

#define LDS_WAIT() asm volatile("s_waitcnt lgkmcnt(0)" ::: "memory")
#define VM_WAIT() asm volatile("s_waitcnt vmcnt(0)" ::: "memory")
__device__ __forceinline__ unsigned cvtpk(float lo, float hi) { f32x2_t v = {lo, hi}; bf16x2_t b = __builtin_convertvector(v, bf16x2_t); return __builtin_bit_cast(unsigned, b); }
__device__ __forceinline__ bf16_t f2bf(float f) { return (bf16_t)(cvtpk(f, 0.f) & 0xffffu); }
__device__ __forceinline__ float bf2f(unsigned b) { return __uint_as_float(b << 16); }
__device__ __forceinline__ float bflo(unsigned w) { return __uint_as_float(w << 16); }
__device__ __forceinline__ float bfhi(unsigned w) { return __uint_as_float(w & 0xffff0000u); }
__device__ __forceinline__ u32x2 pack4(const f32x4 a) { u32x2 w; w.x = cvtpk(a[0], a[1]); w.y = cvtpk(a[2], a[3]); return w; }
__device__ __forceinline__ f32x4 unpack4(const u32x2 w) { return (f32x4){bflo(w.x), bfhi(w.x), bflo(w.y), bfhi(w.y)}; }
__device__ __forceinline__ unsigned pack4_fp8(float a, float b, float c, float d) { unsigned w = 0; w = __builtin_amdgcn_cvt_pk_fp8_f32(a, b, w, false); w = __builtin_amdgcn_cvt_pk_fp8_f32(c, d, w, true); return w; }
__device__ __forceinline__ unsigned pack4_i8(float a, float b, float c, float d) {
    const float M = 12582912.0f;
    const unsigned ua = __float_as_uint(__builtin_amdgcn_fmed3f(a, -127.f, 127.f) + M), ub = __float_as_uint(__builtin_amdgcn_fmed3f(b, -127.f, 127.f) + M);
    const unsigned uc = __float_as_uint(__builtin_amdgcn_fmed3f(c, -127.f, 127.f) + M), ud = __float_as_uint(__builtin_amdgcn_fmed3f(d, -127.f, 127.f) + M);
    const unsigned ab = __builtin_amdgcn_perm(ub, ua, 0x0c0c0400u), cd = __builtin_amdgcn_perm(ud, uc, 0x0c0c0400u);
    return __builtin_amdgcn_perm(cd, ab, 0x05040100u); }
__device__ __forceinline__ unsigned pack4_u8(float a, float b, float c, float d) {
    const float M = 12582912.0f;
    const unsigned ua = __float_as_uint(a + M), ub = __float_as_uint(b + M), uc = __float_as_uint(c + M), ud = __float_as_uint(d + M);
    const unsigned ab = __builtin_amdgcn_perm(ub, ua, 0x0c0c0400u), cd = __builtin_amdgcn_perm(ud, uc, 0x0c0c0400u);
    return __builtin_amdgcn_perm(cd, ab, 0x05040100u); }
__device__ __forceinline__ f32x4 unpack4_u8(unsigned w) { return (f32x4){(float)(w & 0xffu), (float)((w >> 8) & 0xffu), (float)((w >> 16) & 0xffu), (float)(w >> 24)}; }
__device__ __forceinline__ f32x4 unpack4_fp8(unsigned w) { const f32x2_t lo = __builtin_amdgcn_cvt_pk_f32_fp8(w, false), hi = __builtin_amdgcn_cvt_pk_f32_fp8(w, true); return (f32x4){lo[0], lo[1], hi[0], hi[1]}; }
__device__ __forceinline__ float fast_sigmoid(float x) { return __builtin_amdgcn_rcpf(1.0f + __builtin_amdgcn_exp2f(-LOG2E * x)); }
__device__ __forceinline__ float dpp_xor8(float x) { return __builtin_bit_cast(float, __builtin_amdgcn_update_dpp(0, __builtin_bit_cast(int, x), 0x128, 0xF, 0xF, true)); }
__device__ __forceinline__ float dpp_xor2(float x) { return __builtin_bit_cast(float, __builtin_amdgcn_update_dpp(0, __builtin_bit_cast(int, x), 0x4E, 0xF, 0xF, true)); }
__device__ __forceinline__ float dpp_xor1(float x) { return __builtin_bit_cast(float, __builtin_amdgcn_update_dpp(0, __builtin_bit_cast(int, x), 0xB1, 0xF, 0xF, true)); }
__device__ __forceinline__ float dpp_xor4(float x) { const int xi = __builtin_bit_cast(int, x); int t = __builtin_amdgcn_update_dpp(0, xi, 0x104, 0xF, 0x5, false); t = __builtin_amdgcn_update_dpp(t, xi, 0x114, 0xF, 0xA, false); return __builtin_bit_cast(float, t); }
__device__ __forceinline__ float swap_sum16(float x) { unsigned a = __builtin_bit_cast(unsigned, x), b = a; asm volatile("" : "+v"(b)); const auto r = __builtin_amdgcn_permlane16_swap(a, b, false, false);
    unsigned r0 = r[0], r1 = r[1]; asm volatile("" : "+v"(r0), "+v"(r1)); return __builtin_bit_cast(float, r0) + __builtin_bit_cast(float, r1); }
__device__ __forceinline__ float swap_sum32(float x) { unsigned a = __builtin_bit_cast(unsigned, x), b = a; asm volatile("" : "+v"(b)); const auto r = __builtin_amdgcn_permlane32_swap(a, b, false, false);
    unsigned r0 = r[0], r1 = r[1]; asm volatile("" : "+v"(r0), "+v"(r1)); return __builtin_bit_cast(float, r0) + __builtin_bit_cast(float, r1); }
__device__ __forceinline__ float wave_sum(float v) {
    v += dpp_xor1(v); v += dpp_xor2(v); v += dpp_xor4(v); v += dpp_xor8(v);
    return swap_sum32(swap_sum16(v));
}

#define XB_TMO      128
#define XB_XCNT(j)  (256  + 64 * (j))
#define XB_XSUB(j)  (1280 + 64 * (j))
#define XB_XGEN(j)  (2304 + 64 * (j))
#define XB_TOP      3328
#define XB_TOPGEN   3392
#define XCD_BAR_WORDS 3456
#define XB_SPIN_CAP (1u << 18)
__device__ __forceinline__ unsigned xb_ld(unsigned* p)              { return __hip_atomic_load(p, __ATOMIC_RELAXED, __HIP_MEMORY_SCOPE_AGENT); }
__device__ __forceinline__ unsigned xb_add(unsigned* p, unsigned v) { return __hip_atomic_fetch_add(p, v, __ATOMIC_RELAXED, __HIP_MEMORY_SCOPE_AGENT); }
__device__ __forceinline__ unsigned xb_xcc_id() { return (unsigned)__builtin_amdgcn_s_getreg((3 << 11) | 20) & 0xFu; }
#define XB_SPIN(cond, bar) do { unsigned _sp = 0; while (cond) { __builtin_amdgcn_s_sleep(1); \
    if ((++_sp & 255u) == 0u) { if (xb_ld(&(bar)[XB_TMO])) break; if (_sp > XB_SPIN_CAP) { atomicAdd(&(bar)[XB_TMO], 1u); break; } } } } while (0)
struct XcdBarrier { unsigned* bar; unsigned x; volatile LAS unsigned* st; };
__device__ __forceinline__ XcdBarrier xcd_barrier_post(unsigned* bar, volatile LAS unsigned* st) {
    XcdBarrier b; b.bar = bar; b.x = (unsigned)__builtin_amdgcn_readfirstlane((int)xb_xcc_id()); b.st = st;
    if (threadIdx.x == 0) (void)xb_add(&bar[XB_XCNT(b.x)], 1u);
    return b;
}
__device__ __forceinline__ void xcd_barrier_complete(unsigned* bar, unsigned x, unsigned& nloc, unsigned& nx) {
    const unsigned G = gridDim.x * gridDim.y * gridDim.z;
    unsigned sum, cnt, mine, sp = 0u;
    for (;;) {
        sum = 0u; cnt = 0u; mine = 0u;
#pragma unroll
        for (unsigned j = 0; j < 16; ++j) { const unsigned c = xb_ld(&bar[XB_XCNT(j)]); sum += c; cnt += (c > 0u) ? 1u : 0u; mine = (j == x) ? c : mine; }
        if (sum == G) break;
        __builtin_amdgcn_s_sleep(1);
        if ((++sp & 255u) == 0u) { if (xb_ld(&bar[XB_TMO])) break; if (sp > XB_SPIN_CAP) { atomicAdd(&bar[XB_TMO], 1u); break; } }
    }
    nloc = mine > 0u ? mine : 1u; nx = cnt > 0u ? cnt : 1u;
}
__device__ __forceinline__ void xcd_barrier(const XcdBarrier& b) {
    asm volatile("s_waitcnt vmcnt(0)" ::: "memory");
    __syncthreads();
    if (threadIdx.x == 0) {
        unsigned* bar = b.bar; unsigned bx = b.x; asm volatile("" : "+s"(bx));
        __builtin_amdgcn_s_waitcnt(0);
        unsigned nloc = b.st[0], nx = b.st[1];
        if (nloc == 0u) { xcd_barrier_complete(bar, bx, nloc, nx); b.st[0] = nloc; b.st[1] = nx; }
        const unsigned old = xb_add(&bar[XB_XSUB(bx)], 1u);
        const unsigned gen = old / nloc;
        if (old + 1u == (gen + 1u) * nloc) {
            __builtin_amdgcn_fence(__ATOMIC_RELEASE, "agent");
            asm volatile("s_waitcnt vmcnt(0)" ::: "memory");
            const unsigned og = xb_add(&bar[XB_TOP], 1u);
            const unsigned tg = og / nx;
            if (og + 1u == (tg + 1u) * nx) xb_add(&bar[XB_TOPGEN], 1u);
            else XB_SPIN(xb_ld(&bar[XB_TOPGEN]) == tg, bar);
            __builtin_amdgcn_fence(__ATOMIC_ACQUIRE, "agent");
            xb_add(&bar[XB_XGEN(bx)], 1u);
            asm volatile("s_waitcnt vmcnt(0)" ::: "memory");
        } else {
            XB_SPIN(xb_ld(&bar[XB_XGEN(bx)]) == gen, bar);
            __builtin_amdgcn_fence(__ATOMIC_ACQUIRE, "agent");
            asm volatile("s_waitcnt vmcnt(0)" ::: "memory");
        }
    }
    __syncthreads();
}

namespace pg8 {
constexpr int BM = 256, BK = 64, HALF = 128, HTB = HALF * BK * 2, STAGE_BYTES = 8 * HTB, NXCD = 8, WGM = 8;
__host__ __device__ __forceinline__ int lds_byte(int r, int c) { const int st = (r >> 4) * 2 + (c >> 5), rr = r & 15, cc = c & 31, ob = rr * 64 + cc * 2; return st * 1024 + (ob ^ (((ob >> 9) & 1) << 5)); }
__host__ __device__ __forceinline__ void stage_rc(int b, int& R, int& C) { const int st = b / 1024, sb = b % 1024, swz = sb ^ (((sb >> 9) & 1) << 5); R = (st >> 1) * 16 + swz / 64; C = (st & 1) * 32 + (swz % 64) / 2; }
__host__ __device__ __forceinline__ int perm32(int rho) { const int n = rho >> 4, i = rho & 15; return 8 * (i >> 2) + 4 * n + (i & 3); }

struct Unit { int pm, pn; const char* A; const char* B; int part; };

struct TileOrder {
    int nM, nN, nwg, G, c;
    __device__ __forceinline__ void init(int nM_, int nN_, int G_, int c_) { nM = nM_; nN = nN_; nwg = nM * nN; G = G_; c = c_; }
    __device__ __forceinline__ bool tile(int i, int& pm, int& pn) const {
        const long L = (long)i * G + c; if (L >= nwg) return false;
        int wgid = (int)L; { const int q = nwg / NXCD, r = nwg % NXCD, xcd = wgid % NXCD, off = wgid / NXCD; wgid = (xcd < r ? xcd * (q + 1) : r * (q + 1) + (xcd - r) * q) + off; }
        const int nig = WGM * nN, gid = wgid / nig, fm = gid * WGM, gsz = (nM - fm) < WGM ? (nM - fm) : WGM;
        pm = fm + ((wgid % nig) % gsz); pn = (wgid % nig) / gsz; return true;
    }
};

template <class Epi, class Sched, bool ALIGN_EPI, int MODE = 0, int SCALE_W = 127>
__device__ __forceinline__ void gemm_phase(LAS unsigned char* lds, const Sched& S, const Epi& E, const int K, const int ldb) {
    int tid_ = threadIdx.x; asm volatile("" : "+v"(tid_));
    const int tid = tid_, wid = __builtin_amdgcn_readfirstlane(tid >> 6), lane = tid & 63, wr = wid >> 2, wc = wid & 3, fr = lane & 15, fq = lane >> 4;
    constexpr bool FP8 = (MODE == 1), I8 = (MODE == 2);
    int nt = K / (BK * 2); asm volatile("" : "+s"(nt));
    int sR[2], sC[2]; unsigned voffB[2];
#pragma unroll
    for (int i = 0; i < 2; ++i) { stage_rc(tid * 16 + i * 8192, sR[i], sC[i]); const int Rb = Epi::PERM ? ((sR[i] & ~31) + perm32(sR[i] & 31)) : sR[i];
        voffB[i] = (unsigned)(Rb * ldb + sC[i] * 2); }
    const size_t kstep = (size_t)(BK * 2);
    const size_t hstepB = (size_t)HALF * ldb;
    unsigned voffA[2]; size_t hstepA = 0;
    if constexpr (!Sched::GATHER) { hstepA = (size_t)HALF * S.lda;
#pragma unroll
        for (int i = 0; i < 2; ++i) voffA[i] = (unsigned)(sR[i] * S.lda + sC[i] * 2); }
    const unsigned ldsw = (unsigned)wid * 1024u;
    const int aoff = lds_byte(wr * 64 + fr, fq * 8), boff = lds_byte(wc * 32 + fr, fq * 8);
#define PG8_SA(b, h) (((b) * 2 + (h)) * HTB)
#define PG8_SB(b, h) ((4 + (b) * 2 + (h)) * HTB)
#define PG8_STAGE(bufoff, gbase, voff) do { _Pragma("unroll") for (int _i = 0; _i < 2; ++_i) \
        __builtin_amdgcn_global_load_lds((const unsigned*)((const char*)(gbase) + (voff)[_i]), (LAS unsigned*)(lds + (bufoff) + ldsw + _i * 8192), 16, 0, 0); } while (0)
#define PG8_STAGE_A(bufoff, gbase, h, OFFS) do { if constexpr (Sched::GATHER) PG8_STAGE(bufoff, gbase, OFFS[h]); else PG8_STAGE(bufoff, (gbase) + (h) * hstepA, voffA); } while (0)
#define PG8_LD32(p) __builtin_shufflevector(*(const LAS u32x4*)(p), *(const LAS u32x4*)((p) + 1024), 0, 1, 2, 3, 4, 5, 6, 7)
#define PG8_STAGE_B(bufoff, gbase, h, OFFS) do { if constexpr (Sched::GATHER_B) PG8_STAGE(bufoff, gbase, OFFS[h]); else PG8_STAGE(bufoff, (gbase) + (h) * hstepB, voffB); } while (0)
#define PG8_LDA(dst, b, h) do { if constexpr (FP8) { _Pragma("unroll") for (int m = 0; m < 4; ++m) dst##8[m] = __builtin_bit_cast(v8i_t, PG8_LD32(lds + PG8_SA(b, h) + aoff + m * 2048)); } \
        else { _Pragma("unroll") for (int m = 0; m < 4; ++m) _Pragma("unroll") for (int k = 0; k < 2; ++k) dst[m][k] = *(const LAS bf16x8*)(lds + PG8_SA(b, h) + aoff + m * 2048 + k * 1024); } } while (0)
#define PG8_LDB(dst, b, h) do { if constexpr (FP8) { _Pragma("unroll") for (int n = 0; n < 2; ++n) dst##8[n] = __builtin_bit_cast(v8i_t, PG8_LD32(lds + PG8_SB(b, h) + boff + n * 2048)); } \
        else { _Pragma("unroll") for (int n = 0; n < 2; ++n) _Pragma("unroll") for (int k = 0; k < 2; ++k) dst[n][k] = *(const LAS bf16x8*)(lds + PG8_SB(b, h) + boff + n * 2048 + k * 1024); } } while (0)
#define PG8_MMA(ai, bj, At, Bt) do { __builtin_amdgcn_s_setprio(1); \
        if constexpr (FP8) { _Pragma("unroll") for (int m = 0; m < 4; ++m) _Pragma("unroll") for (int n = 0; n < 2; ++n) \
            asm volatile("v_mfma_scale_f32_16x16x128_f8f6f4 %0, %1, %2, %0, %3, %4 op_sel_hi:[0,0,0]" : "+v"(acc[ai][bj][m][n]) : "v"(Bt##8[n]), "v"(At##8[m]), "v"(sc_w), "v"(sc_a)); } \
        else if constexpr (I8) { _Pragma("unroll") for (int m = 0; m < 4; ++m) _Pragma("unroll") for (int n = 0; n < 2; ++n) _Pragma("unroll") for (int k = 0; k < 2; ++k) \
            acc[ai][bj][m][n] = __builtin_bit_cast(f32x4, __builtin_amdgcn_mfma_i32_16x16x64_i8(__builtin_bit_cast(v4i_t, Bt[n][k]), __builtin_bit_cast(v4i_t, At[m][k]), __builtin_bit_cast(v4i_t, acc[ai][bj][m][n]), 0, 0, 0)); } \
        else { _Pragma("unroll") for (int m = 0; m < 4; ++m) _Pragma("unroll") for (int n = 0; n < 2; ++n) _Pragma("unroll") for (int k = 0; k < 2; ++k) \
            acc[ai][bj][m][n] = __builtin_amdgcn_mfma_f32_16x16x32_bf16(Bt[n][k], At[m][k], acc[ai][bj][m][n], 0, 0, 0); } \
        __builtin_amdgcn_s_setprio(0); } while (0)
#define PG8_WAIT_V(n) asm volatile("s_waitcnt vmcnt(" #n ")" ::: "memory")
#define PG8_WAIT_L(n) asm volatile("s_waitcnt lgkmcnt(" #n ")" ::: "memory")
#define PG8_BAR __builtin_amdgcn_s_barrier()
#define PG8_SCHED __builtin_amdgcn_sched_barrier(0)
    Unit cur, nxt; int ui = 0;
    if (!S.next(0, cur)) return;
    unsigned oA[2][2], noA[2][2], oB[2][2], noB[2][2];
    int sRb[2];
#pragma unroll
    for (int i = 0; i < 2; ++i) sRb[i] = Epi::PERM ? ((sR[i] & ~31) + perm32(sR[i] & 31)) : sR[i];
#pragma unroll
    for (int h = 0; h < 2; ++h)
#pragma unroll
        for (int i = 0; i < 2; ++i) { oA[h][i] = Sched::GATHER ? S.aoff(cur, 0, h, sR[i], sC[i]) : 0u; oB[h][i] = Sched::GATHER_B ? S.boff(cur, 0, h, sRb[i], sC[i]) : 0u; }
    f32x4 acc[2][2][4][2];
#pragma unroll
    for (int a = 0; a < 2; ++a)
#pragma unroll
        for (int b = 0; b < 2; ++b)
#pragma unroll
            for (int m = 0; m < 4; ++m)
#pragma unroll
                for (int n = 0; n < 2; ++n) acc[a][b][m][n] = (f32x4){0.f, 0.f, 0.f, 0.f};
    const int sc_w = SCALE_W * 0x01010101, sc_a = 0x7f7f7f7f;
    bf16x8 At[4][2], B0[2][2], B1[2][2]; v8i_t At8[4], B08[2], B18[2];
    const char* cA = cur.A; const char* cB = cur.B;
    PG8_STAGE_B(PG8_SB(0, 0), cB, 0, oB); PG8_STAGE_B(PG8_SB(0, 1), cB, 1, oB); PG8_STAGE_A(PG8_SA(0, 0), cA, 0, oA); PG8_STAGE_A(PG8_SA(0, 1), cA, 1, oA);
    if (wr == 1) PG8_BAR;
    PG8_WAIT_V(2); PG8_BAR;
    PG8_STAGE_B(PG8_SB(1, 0), cB + kstep, 0, oB); PG8_STAGE_A(PG8_SA(1, 0), cA + kstep, 0, oA); PG8_STAGE_B(PG8_SB(1, 1), cB + kstep, 1, oB);
    PG8_WAIT_V(6); PG8_BAR;
    for (;;) {
        const bool has_next = S.next(ui + 1, nxt);
        const char* nA = has_next ? nxt.A : cA; const char* nB = has_next ? nxt.B : cB;
#pragma unroll
        for (int h = 0; h < 2; ++h)
#pragma unroll
            for (int i = 0; i < 2; ++i) { noA[h][i] = Sched::GATHER ? (has_next ? S.aoff(nxt, ui + 1, h, sR[i], sC[i]) : oA[h][i]) : 0u; noB[h][i] = Sched::GATHER_B ? (has_next ? S.boff(nxt, ui + 1, h, sRb[i], sC[i]) : oB[h][i]) : 0u; }
#pragma unroll 1
        for (int t = 0; t < nt; t += 2) {
            const bool last = (t == nt - 2);
            const char* a1 = cA + (size_t)(t + 1) * kstep;
            const char* a2 = last ? nA : cA + (size_t)(t + 2) * kstep; const char* b2 = last ? nB : cB + (size_t)(t + 2) * kstep;
            const char* a3 = a2 + kstep; const char* b3 = b2 + kstep;
            unsigned o2[2][2], o2B[2][2];
#pragma unroll
            for (int h = 0; h < 2; ++h)
#pragma unroll
                for (int i = 0; i < 2; ++i) { o2[h][i] = Sched::GATHER ? (last ? noA[h][i] : oA[h][i]) : 0u; o2B[h][i] = Sched::GATHER_B ? (last ? noB[h][i] : oB[h][i]) : 0u; }
            PG8_LDB(B0, 0, 0); PG8_LDB(B1, 0, 1); PG8_SCHED; PG8_LDA(At, 0, 0); PG8_STAGE_A(PG8_SA(1, 1), a1, 1, oA);
            PG8_WAIT_V(8); PG8_WAIT_L(0); PG8_BAR; PG8_MMA(0, 0, At, B0); PG8_MMA(0, 1, At, B1); PG8_BAR; PG8_SCHED;
            PG8_LDA(At, 0, 1); PG8_STAGE_B(PG8_SB(0, 0), b2, 0, o2B); PG8_STAGE_B(PG8_SB(0, 1), b2, 1, o2B); PG8_STAGE_A(PG8_SA(0, 0), a2, 0, o2);
            PG8_WAIT_V(8); PG8_WAIT_L(0); PG8_BAR; PG8_MMA(1, 0, At, B0); PG8_MMA(1, 1, At, B1); PG8_BAR; PG8_SCHED;
            PG8_LDB(B0, 1, 0); PG8_LDB(B1, 1, 1); PG8_SCHED; PG8_LDA(At, 1, 0); PG8_STAGE_A(PG8_SA(0, 1), a2, 1, o2);
            PG8_WAIT_V(8); PG8_WAIT_L(0); PG8_BAR; PG8_MMA(0, 0, At, B0); PG8_MMA(0, 1, At, B1); PG8_BAR; PG8_SCHED;
            PG8_LDA(At, 1, 1); PG8_STAGE_B(PG8_SB(1, 0), b3, 0, o2B); PG8_STAGE_B(PG8_SB(1, 1), b3, 1, o2B); PG8_STAGE_A(PG8_SA(1, 0), a3, 0, o2);
            PG8_WAIT_V(8); PG8_WAIT_L(0); PG8_BAR; PG8_MMA(1, 0, At, B0); PG8_MMA(1, 1, At, B1); PG8_BAR; PG8_SCHED;
        }
        if constexpr (ALIGN_EPI) { if (wr == 0) PG8_BAR; }
        if constexpr (FP8) asm volatile("s_nop 15\n\ts_nop 15\n\ts_nop 15\n\ts_nop 15" ::: "memory");
        bool keep_acc = false;
        int fr_e = fr, fq_e = fq; asm volatile("" : "+v"(fr_e), "+v"(fq_e));
        if constexpr (Epi::TWO_PART) { if (cur.part == 0) { E.mid(acc, cur, wr, wc, fr_e, fq_e); keep_acc = true; } else E(acc, cur, wr, wc, fr_e, fq_e); }
        else E(acc, cur, wr, wc, fr_e, fq_e);
        if constexpr (Sched::HAS_HOOK) S.hook(ui);
        if (!has_next) break;
        if (!keep_acc) {
#pragma unroll
        for (int a = 0; a < 2; ++a)
#pragma unroll
            for (int b = 0; b < 2; ++b)
#pragma unroll
                for (int m = 0; m < 4; ++m)
#pragma unroll
                    for (int n = 0; n < 2; ++n) acc[a][b][m][n] = (f32x4){0.f, 0.f, 0.f, 0.f};
        }
        cur = nxt; cA = nA; cB = nB; ++ui;
#pragma unroll
        for (int h = 0; h < 2; ++h)
#pragma unroll
            for (int i = 0; i < 2; ++i) { oA[h][i] = noA[h][i]; oB[h][i] = noB[h][i]; }
        if constexpr (ALIGN_EPI) { if (wr == 1) PG8_BAR; }
    }
    PG8_WAIT_V(0);
    if constexpr (!ALIGN_EPI) { if (wr == 0) PG8_BAR; }
    PG8_BAR;
#undef PG8_SA
#undef PG8_SB
#undef PG8_STAGE
#undef PG8_STAGE_A
#undef PG8_STAGE_B
#undef PG8_LDA
#undef PG8_LDB
#undef PG8_MMA
#undef PG8_LD32
#undef PG8_WAIT_V
#undef PG8_WAIT_L
#undef PG8_BAR
#undef PG8_SCHED
}
}
using pg8::Unit;
using pg8::TileOrder;

struct Frame {
    LAS unsigned char* lds;
    int tid, lane, wave, G, bid;
    const float *x, *meta, *ln0_g, *ln0_b, *w_in, *b_gate, *sink, *w_attn_o, *w_four_o, *w_out, *ln1_g, *ln1_b, *w_router, *w_e_gate, *w_e_up, *w_e_down, *ln2_g, *ln2_b;
    float* out; unsigned char* ws;
};
#define WSP(T_, off) ((T_*)(F.ws + (off)))

__device__ __forceinline__ void conv_share_regs(const Frame& F, int cl);
struct SchedReg {
    static constexpr bool GATHER = false, GATHER_B = false, HAS_HOOK = false;
    TileOrder o; const char* A; const char* B; int lda, ldb;
    __device__ __forceinline__ bool next(int i, Unit& u) const { int pm, pn; if (!o.tile(i, pm, pn)) return false; u.pm = pm; u.pn = pn; u.part = 1;
        u.A = A + (size_t)pm * 256 * lda; u.B = B + (size_t)pn * 256 * ldb; return true; }
    __device__ __forceinline__ unsigned aoff(const Unit&, int, int h, int R, int C) const { return (unsigned)((h * 128 + R) * lda + C * 2); }
    __device__ __forceinline__ unsigned boff(const Unit&, int, int, int, int) const { return 0u; }
};
struct SchedInProj {
    static constexpr bool GATHER = false, GATHER_B = false, HAS_HOOK = false;
    TileOrder o, o1, o2; bool bal; const char* A; const char* B; int lda, ldb;
    __device__ __forceinline__ bool next(int i, Unit& u) const { int pm, pn;
        if (!bal) { if (!o.tile(i, pm, pn)) return false; }
        else if (i < 4) { o1.tile(i, pm, pn); pn += 5; }
        else { const int L = (i - 4) * 256 + o2.c; if (L < 645) o2.tile(i - 4, pm, pn); else if (L < 653) { pm = 128; pn = 5 + (L - 645); } else return false; }
        u.pm = pm; u.pn = pn; u.part = 1; u.A = A + (size_t)pm * 256 * lda; u.B = B + (size_t)pn * 256 * ldb; return true; }
    __device__ __forceinline__ unsigned aoff(const Unit&, int, int h, int R, int C) const { return (unsigned)((h * 128 + R) * lda + C * 2); }
    __device__ __forceinline__ unsigned boff(const Unit&, int, int, int, int) const { return 0u; }
};
struct SchedMerge {
    static constexpr bool GATHER = false, GATHER_B = false, HAS_HOOK = false; static constexpr int lda = AW;
    TileOrder o; const char* ATT; const char* FOUR; const char* WA; const char* WF;
    __device__ __forceinline__ bool next(int i, Unit& u) const { int pm, pn; if (!o.tile(i >> 1, pm, pn)) return false; u.pm = pm; u.pn = pn; u.part = i & 1;
        u.A = ((i & 1) ? FOUR : ATT) + (size_t)pm * 256 * AW; u.B = ((i & 1) ? WF : WA) + (size_t)pn * 256 * AW; return true; }
    __device__ __forceinline__ unsigned aoff(const Unit&, int, int h, int R, int C) const { return (unsigned)((h * 128 + R) * AW + C) * 2u; }
    __device__ __forceinline__ unsigned boff(const Unit&, int, int, int, int) const { return 0u; }
};
struct SchedDown {
    static constexpr bool GATHER = false, GATHER_B = false, HAS_HOOK = false; static constexpr int lda = FF;
    TileOrder o; const char* HID; const char* WD;
    __device__ __forceinline__ bool next(int i, Unit& u) const { int pm, pn; if (!o.tile(i, pm, pn)) return false; u.pm = pm; u.pn = pn; u.part = 1; const int e = pm >> 4;
        u.A = HID + (size_t)(e * ESLOTS + (pm & 15) * 256) * FF; u.B = WD + ((size_t)e * D + (size_t)pn * 256) * FF; return true; }
    __device__ __forceinline__ unsigned aoff(const Unit&, int, int h, int R, int C) const { return (unsigned)((h * 128 + R) * FF + C * 2); }
    __device__ __forceinline__ unsigned boff(const Unit&, int, int, int, int) const { return 0u; }
};
struct SchedGU {
    static constexpr bool GATHER = true, GATHER_B = false, HAS_HOOK = true; static constexpr int lda = D;
    TileOrder o; const char* HB; const char* WGU; const LAS int* idxtab; const Frame* Fp; int conv_layer, conv_slot;
    __device__ __forceinline__ void hook(int ui) const { if (conv_layer >= 0 && ui == conv_slot) conv_share_regs(*Fp, conv_layer); }
    __device__ __forceinline__ bool next(int i, Unit& u) const { int pm, pn; if (!o.tile(i, pm, pn)) return false; u.pm = pm; u.pn = pn; u.part = 1; const int e = pm >> 4;
        u.A = HB; u.B = WGU + ((size_t)e * (2 * FF) + (size_t)pn * 256) * D; return true; }
    __device__ __forceinline__ unsigned aoff(const Unit&, int i, int h, int R, int C) const { return (unsigned)idxtab[i * 256 + h * 128 + R] * (unsigned)D + (unsigned)C * 2u; }
    __device__ __forceinline__ unsigned boff(const Unit&, int, int, int, int) const { return 0u; }
};
struct SchedChan {
    static constexpr bool GATHER = false, GATHER_B = true, HAS_HOOK = false; static constexpr int lda = 512;
    TileOrder o; const char* UF; const char* CSM;
    __device__ __forceinline__ bool next(int i, Unit& u) const { int pm, pn; if (!o.tile(i, pm, pn)) return false; u.pm = pm; u.pn = 0; u.part = 1; const int bg = pm / 17, g = bg & 3, b = bg >> 2;
        u.A = CSM; u.B = UF + ((size_t)b * LSEQ * FW + (size_t)g * 128) * 2; return true; }
    __device__ __forceinline__ unsigned aoff(const Unit&, int, int, int, int) const { return 0u; }
    __device__ __forceinline__ unsigned boff(const Unit& u, int, int h, int R, int C) const { const int lt = u.pm % 17, l = lt * 128 + R; int tok = h ? LSEQ - l : l; if (tok >= LSEQ) tok = 0;
        return (unsigned)(tok * FW + C) * 2u; }
};

typedef const f32x4 (&AccRef)[2][2][4][2];
__device__ __forceinline__ f32x4 i2f(const f32x4 a, float sc) { const v4i_t i = __builtin_bit_cast(v4i_t, a); return (f32x4){(float)i[0], (float)i[1], (float)i[2], (float)i[3]} * sc; }
__device__ __forceinline__ u32x4 pack8(const f32x4 a, const f32x4 b) { u32x4 w; w.x = cvtpk(a[0], a[1]); w.y = cvtpk(a[2], a[3]); w.z = cvtpk(b[0], b[1]); w.w = cvtpk(b[2], b[3]); return w; }

#ifndef EPI_WT
#define EPI_WT 0
#endif
__device__ __forceinline__ void st16(void* p, const u32x4 v) {
#if EPI_WT
    asm volatile("global_store_dwordx4 %0, %1, off sc1\n\ts_nop 1" :: "v"(p), "v"(v) : "memory");
#elif defined(EPI_NT)
    __builtin_nontemporal_store(v, (u32x4*)p);
#else
    *(u32x4*)p = v;
#endif
}
__device__ __forceinline__ u32x4 pair16(const u32x2 a, const u32x2 b) {
    const auto r0 = __builtin_amdgcn_permlane16_swap(a.x, b.x, false, false), r1 = __builtin_amdgcn_permlane16_swap(a.y, b.y, false, false);
    return (u32x4){r0[0], r1[0], r0[1], r1[1]};
}
__device__ __forceinline__ void store_rows8(unsigned char* base, size_t pitch, const u32x2 (&pk)[4], int fq) {
#pragma unroll
    for (int mp = 0; mp < 2; ++mp) st16(base + (size_t)(32 * mp + 16 * (fq & 1)) * pitch + 16 * (fq >> 1), pair16(pk[2 * mp], pk[2 * mp + 1]));
}
struct EpiInProj { static constexpr bool TWO_PART = false;
    static constexpr bool PERM = true;
    bf16_t *Q, *KB, *VT, *UF; unsigned char* G; const float* bgate; bool active;
    __device__ __forceinline__ void operator()(AccRef acc, const Unit& u, int wr, int wc, int fr, int fq) const {
        if (!active) return;
        const int pn = u.pn, rbase = u.pm * 256 + wr * 64 + fr, c8 = wc * 32 + 8 * fq;
        constexpr float dq = 1.0f / (SX * SW);
#pragma unroll
        for (int ai = 0; ai < 2; ++ai) { if (u.pm * 256 + ai * 128 >= T) continue;
#pragma unroll
            for (int bj = 0; bj < 2; ++bj) { const int colt = bj * 128 + c8;
                if (pn >= 5) {
                    const int gc = (pn - 5) * 256 + colt; const f32x4 b0 = *(const f32x4*)(bgate + gc) * -LOG2E, b1 = *(const f32x4*)(bgate + gc + 4) * -LOG2E; u32x2 pk[4];
#pragma unroll
                    for (int m = 0; m < 4; ++m) { f32x4 v0 = i2f(acc[ai][bj][m][0], -LOG2E * dq), v1 = i2f(acc[ai][bj][m][1], -LOG2E * dq);
#pragma unroll
                        for (int j = 0; j < 4; ++j) { v0[j] = __builtin_amdgcn_rcpf(__builtin_fmaf(__builtin_amdgcn_exp2f(v0[j] + b0[j]), 1.0f / 255.0f, 1.0f / 255.0f));
                                                      v1[j] = __builtin_amdgcn_rcpf(__builtin_fmaf(__builtin_amdgcn_exp2f(v1[j] + b1[j]), 1.0f / 255.0f, 1.0f / 255.0f)); }
                        pk[m] = (u32x2){pack4_u8(v0[0], v0[1], v0[2], v0[3]), pack4_u8(v1[0], v1[1], v1[2], v1[3])}; }
                    store_rows8(G + (size_t)(rbase + ai * 128) * (2 * D) + (pn - 5) * 256 + bj * 128 + wc * 32, 2 * D, pk, fq);
                } else {
#pragma unroll
                    for (int m = 0; m < 4; ++m) { const int row = rbase + ai * 128 + m * 16; f32x4 v0 = i2f(acc[ai][bj][m][0], dq), v1 = i2f(acc[ai][bj][m][1], dq);
                        if (pn < 2) { v0 = v0 * QSCALE; v1 = v1 * QSCALE; st16(Q + (size_t)row * AW + pn * 256 + colt, pack8(v0, v1)); }
                        else if (pn == 2) {
                            if (bj == 0) { st16(KB + (size_t)row * 128 + c8, pack8(v0, v1)); }
                            else { const int b = row / LSEQ, p = row - b * LSEQ; const int kvh = c8 >> 6, d0 = c8 & 63;
                                bf16_t* vp = VT + ((size_t)((b * NKV + kvh) * HD + d0)) * VT_LD + VT_OFF + p;
#pragma unroll
                                for (int j = 0; j < 4; ++j) { vp[(size_t)j * VT_LD] = f2bf(v0[j]); vp[(size_t)(4 + j) * VT_LD] = f2bf(v1[j]); } } }
                        else { st16(UF + (size_t)row * FW + (pn - 3) * 256 + colt, pack8(v0, v1)); } } } } }
    }
};
struct EpiChan { static constexpr bool TWO_PART = false;
    static constexpr bool PERM = true;
    unsigned char* PQT;
    __device__ __forceinline__ void operator()(AccRef acc, const Unit& u, int wr, int wc, int fr, int fq) const {
        const int lt = u.pm % 17, bg = u.pm / 17, l8 = lt * 128 + wc * 32 + 8 * fq;
        u32x2 pp[4], pq[4];
#pragma unroll
        for (int m = 0; m < 4; ++m) { float pe[8], qo[8];
#pragma unroll
            for (int n = 0; n < 2; ++n)
#pragma unroll
                for (int j = 0; j < 4; ++j) { const int l = l8 + 4 * n + j; const bool pair = (l >= 1 && l <= HALFL - 1), own = (l <= HALFL);
                    float p = own ? acc[0][0][m][n][j] : 0.f, q = 0.f;
                    if (pair) { p += acc[0][1][m][n][j]; q = acc[1][0][m][n][j] - acc[1][1][m][n][j]; }
                    pe[4 * n + j] = p; qo[4 * n + j] = q; }
            pp[m] = (u32x2){pack4_i8(pe[0] * SPQ, pe[1] * SPQ, pe[2] * SPQ, pe[3] * SPQ), pack4_i8(pe[4] * SPQ, pe[5] * SPQ, pe[6] * SPQ, pe[7] * SPQ)};
            pq[m] = (u32x2){pack4_i8(qo[0] * SPQ, qo[1] * SPQ, qo[2] * SPQ, qo[3] * SPQ), pack4_i8(qo[4] * SPQ, qo[5] * SPQ, qo[6] * SPQ, qo[7] * SPQ)}; }
        unsigned char* base = PQT + (size_t)(bg * 128 + wr * 64 + fr) * DK + lt * 128 + wc * 32;
        store_rows8(base, DK, pp, fq); store_rows8(base + QOFF, DK, pq, fq);
    }
};
struct EpiSeq { static constexpr bool TWO_PART = false;
    static constexpr bool PERM = true;
    unsigned char* FOUR;
    __device__ __forceinline__ void operator()(AccRef acc, const Unit& u, int wr, int wc, int fr, int fq) const {
        const float us = 1.0f / (127.0f * sqrtf(128.0f * (float)LSEQ) * SPQ);
#pragma unroll
        for (int ai = 0; ai < 2; ++ai)
#pragma unroll
            for (int bj = 0; bj < 2; ++bj) { const int n = u.pn * 256 + bj * 128 + wc * 32, b = n >> 9, cc = n & 511, k0 = u.pm * 256 + ai * 128 + wr * 64 + fr; u32x2 pk[4];
#pragma unroll
                for (int m = 0; m < 4; ++m) { const f32x4 z0 = i2f(acc[ai][bj][m][0], us), z1 = i2f(acc[ai][bj][m][1], us);
                    pk[m] = (u32x2){pack4_fp8(z0[0], z0[1], z0[2], z0[3]), pack4_fp8(z1[0], z1[1], z1[2], z1[3])}; }
                store_rows8(FOUR + (size_t)(b * LSEQ + k0) * FW + cc, FW, pk, fq); }
    }
};
__device__ __forceinline__ void unpack8(const u32x4 w, f32x4& a, f32x4& b) { a = (f32x4){bflo(w.x), bfhi(w.x), bflo(w.y), bfhi(w.y)}; b = (f32x4){bflo(w.z), bfhi(w.z), bflo(w.w), bfhi(w.w)}; }
__device__ __forceinline__ f32x4 fmaxv(const f32x4 a) { return (f32x4){fmaxf(a[0], 0.5f), fmaxf(a[1], 0.5f), fmaxf(a[2], 0.5f), fmaxf(a[3], 0.5f)}; }
struct EpiMerge {
    static constexpr bool PERM = true, TWO_PART = true;
    unsigned char* MG; const unsigned char* G;
    typedef f32x4 (&AccMut)[2][2][4][2];
    __device__ __forceinline__ void mid(AccMut acc, const Unit& u, int wr, int wc, int fr, int fq) const {
#pragma unroll
        for (int ai = 0; ai < 2; ++ai)
#pragma unroll
            for (int m = 0; m < 4; ++m) { int row = u.pm * 256 + ai * 128 + wr * 64 + 16 * m + fr; if (row >= T) row = T - 1;
#pragma unroll
                for (int bj = 0; bj < 2; ++bj) { const int col = u.pn * 256 + bj * 128 + wc * 32 + 8 * fq;
                    const u32x2 wa = *(const u32x2*)(G + (size_t)row * (2 * D) + col), wb = *(const u32x2*)(G + (size_t)row * (2 * D) + D + col);
                    const f32x4 a0 = unpack4_u8(wa.x), a1 = unpack4_u8(wa.y), b0 = unpack4_u8(wb.x), b1 = unpack4_u8(wb.y);
#pragma unroll
                    for (int j = 0; j < 4; ++j) { acc[ai][bj][m][0][j] *= a0[j] * __builtin_amdgcn_rcpf(fmaxf(b0[j], 0.5f)); acc[ai][bj][m][1][j] *= a1[j] * __builtin_amdgcn_rcpf(fmaxf(b1[j], 0.5f)); } } }
    }
    __device__ __forceinline__ void operator()(AccRef acc, const Unit& u, int wr, int wc, int fr, int fq) const {
#pragma unroll
        for (int ai = 0; ai < 2; ++ai)
#pragma unroll
            for (int bj = 0; bj < 2; ++bj) { const int row0 = u.pm * 256 + ai * 128 + wr * 64 + fr, colg = u.pn * 256 + bj * 128 + wc * 32; u32x2 pk[4];
#pragma unroll
                for (int m = 0; m < 4; ++m) { const u32x2 wb = *(const u32x2*)(G + (size_t)(row0 + 16 * m) * (2 * D) + D + colg + 8 * fq);
                    const f32x4 g0 = fmaxv(unpack4_u8(wb.x)) * (1.0f / 255.0f), g1 = fmaxv(unpack4_u8(wb.y)) * (1.0f / 255.0f);
                    const f32x4 o0 = acc[ai][bj][m][0] * g0, o1 = acc[ai][bj][m][1] * g1;
                    pk[m] = (u32x2){pack4_fp8(o0[0], o0[1], o0[2], o0[3]), pack4_fp8(o1[0], o1[1], o1[2], o1[3])}; }
                store_rows8(MG + (size_t)row0 * D + colg, D, pk, fq); }
    }
};
struct EpiWout { static constexpr bool TWO_PART = false;
    static constexpr bool PERM = true;
    unsigned char* MIXB;
    __device__ __forceinline__ void operator()(AccRef acc, const Unit& u, int wr, int wc, int fr, int fq) const {
#pragma unroll
        for (int ai = 0; ai < 2; ++ai)
#pragma unroll
            for (int bj = 0; bj < 2; ++bj) { u32x2 pk[4];
#pragma unroll
                for (int m = 0; m < 4; ++m) { const f32x4 a0 = acc[ai][bj][m][0], a1 = acc[ai][bj][m][1]; pk[m] = (u32x2){pack4_fp8(a0[0], a0[1], a0[2], a0[3]), pack4_fp8(a1[0], a1[1], a1[2], a1[3])}; }
                store_rows8(MIXB + (size_t)(u.pm * 256 + ai * 128 + wr * 64 + fr) * D + u.pn * 256 + bj * 128 + wc * 32, D, pk, fq); }
    }
};
struct EpiGU { static constexpr bool TWO_PART = false;
    static constexpr bool PERM = true;
    bf16_t* HID; bool active;
    __device__ __forceinline__ void operator()(AccRef acc, const Unit& u, int wr, int wc, int fr, int fq) const {
        if (!active) return;
        constexpr float dq = 1.0f / (SX * SW);
#pragma unroll
        for (int ai = 0; ai < 2; ++ai) { u32x2 pk[4];
#pragma unroll
            for (int m = 0; m < 4; ++m) { f32x4 o[2];
#pragma unroll
                for (int n = 0; n < 2; ++n)
                    { const f32x4 ga = i2f(acc[ai][0][m][n], 1.0f), up = i2f(acc[ai][1][m][n], 1.0f);
#pragma unroll
                    for (int j = 0; j < 4; ++j) o[n][j] = (ga[j] * up[j]) * __builtin_amdgcn_rcpf(__builtin_fmaf(__builtin_amdgcn_exp2f(ga[j] * (-LOG2E * dq)), 1.0f / (dq * dq), 1.0f / (dq * dq))); }
                pk[m] = (u32x2){pack4_fp8(o[0][0], o[0][1], o[0][2], o[0][3]), pack4_fp8(o[1][0], o[1][1], o[1][2], o[1][3])}; }
            store_rows8((unsigned char*)HID + (size_t)((u.pm >> 4) * ESLOTS + (u.pm & 15) * 256 + ai * 128 + wr * 64 + fr) * FF + u.pn * 128 + wc * 32, FF, pk, fq); }
    }
};
struct EpiDown { static constexpr bool TWO_PART = false;
    static constexpr bool PERM = true;
    unsigned char* Y; const float* GATE; bool active;
    __device__ __forceinline__ void operator()(AccRef acc, const Unit& u, int wr, int wc, int fr, int fq) const {
        if (!active) return;
#pragma unroll
        for (int ai = 0; ai < 2; ++ai) { const int row0 = (u.pm >> 4) * ESLOTS + (u.pm & 15) * 256 + ai * 128 + wr * 64 + fr; float g[4];
#pragma unroll
            for (int m = 0; m < 4; ++m) g[m] = GATE[row0 + 16 * m];
#pragma unroll
            for (int bj = 0; bj < 2; ++bj) { u32x2 pk[4];
#pragma unroll
                for (int m = 0; m < 4; ++m) { const f32x4 y0 = acc[ai][bj][m][0] * g[m], y1 = acc[ai][bj][m][1] * g[m]; pk[m] = (u32x2){pack4_fp8(y0[0], y0[1], y0[2], y0[3]), pack4_fp8(y1[0], y1[1], y1[2], y1[3])}; }
                store_rows8(Y + (size_t)row0 * D + u.pn * 256 + bj * 128 + wc * 32, D, pk, fq); } }
    }
};

__device__ __forceinline__ void transpose_item(const float* W, int K, int N, int k0, int n0, bf16_t* WT, int drow0, LAS float* scr, int lane) {
    float r[64];
#pragma unroll
    for (int kk = 0; kk < 64; ++kk) r[kk] = __builtin_nontemporal_load(W + (size_t)(k0 + kk) * N + n0 + lane);
#pragma unroll
    for (int kk = 0; kk < 64; ++kk) scr[kk * 65 + lane] = r[kk];
    LDS_WAIT(); asm volatile("" ::: "memory");
    const int c = lane & 7;
#pragma unroll
    for (int j = 0; j < 8; ++j) { const int n = (lane >> 3) + 8 * j; const LAS float* s = scr + (8 * c) * 65 + n;
        u32x4 o; o.x = cvtpk(s[0 * 65], s[1 * 65]); o.y = cvtpk(s[2 * 65], s[3 * 65]); o.z = cvtpk(s[4 * 65], s[5 * 65]); o.w = cvtpk(s[6 * 65], s[7 * 65]);
        *(u32x4*)(WT + (size_t)(drow0 + n) * K + k0 + 8 * c) = o; }
    LDS_WAIT(); asm volatile("" ::: "memory");
}
template <bool I8>
__device__ __forceinline__ void transpose_item_q(const float* W, int K, int N, int k0, int n0, unsigned char* WT, int drow0, float sc, LAS float* scr, int lane) {
    float r[64];
#pragma unroll
    for (int kk = 0; kk < 64; ++kk) r[kk] = __builtin_nontemporal_load(W + (size_t)(k0 + kk) * N + n0 + lane);
#pragma unroll
    for (int kk = 0; kk < 64; ++kk) scr[kk * 65 + lane] = r[kk] * sc;
    LDS_WAIT(); asm volatile("" ::: "memory");
    const int c = lane & 7;
#pragma unroll
    for (int j = 0; j < 8; ++j) { const int n = (lane >> 3) + 8 * j; const LAS float* s = scr + (8 * c) * 65 + n;
        u32x2 o; if constexpr (I8) { o.x = pack4_i8(s[0 * 65], s[1 * 65], s[2 * 65], s[3 * 65]); o.y = pack4_i8(s[4 * 65], s[5 * 65], s[6 * 65], s[7 * 65]); }
        else { o.x = pack4_fp8(s[0 * 65], s[1 * 65], s[2 * 65], s[3 * 65]); o.y = pack4_fp8(s[4 * 65], s[5 * 65], s[6 * 65], s[7 * 65]); }
        *(u32x2*)(WT + (size_t)(drow0 + n) * K + k0 + 8 * c) = o; }
    LDS_WAIT(); asm volatile("" ::: "memory");
}
__device__ __forceinline__ void ln_row(f32x4 (&v)[4], const f32x4 (&gm)[4], const f32x4 (&bt)[4], float& mean_o, float& rstd_o) {
    float s = 0.f;
#pragma unroll
    for (int j = 0; j < 4; ++j) s += (v[j][0] + v[j][1]) + (v[j][2] + v[j][3]);
    const float mean = wave_sum(s) * (1.f / D); float s2 = 0.f;
#pragma unroll
    for (int j = 0; j < 4; ++j) { v[j] = v[j] - mean; s2 += (v[j][0] * v[j][0] + v[j][1] * v[j][1]) + (v[j][2] * v[j][2] + v[j][3] * v[j][3]); }
    const float rstd = 1.0f / sqrtf(wave_sum(s2) * (1.f / D) + LN_EPS);
#pragma unroll
    for (int j = 0; j < 4; ++j) v[j] = v[j] * rstd * gm[j] + bt[j];
    mean_o = mean; rstd_o = rstd;
}
__device__ __forceinline__ void ln_row(f32x4 (&v)[4], const f32x4 (&gm)[4], const f32x4 (&bt)[4]) { float a, b; ln_row(v, gm, bt, a, b); }
__device__ __forceinline__ void ln_apply(f32x4 (&v)[4], const f32x4 (&gm)[4], const f32x4 (&bt)[4], float mean, float rstd) {
#pragma unroll
    for (int j = 0; j < 4; ++j) { v[j] = v[j] - mean; v[j] = v[j] * rstd * gm[j] + bt[j]; }
}
typedef _Float16 f16x4 __attribute__((ext_vector_type(4)));
__device__ __forceinline__ f32x4 h2f(const f16x4 h) { return __builtin_convertvector(h, f32x4); }
__device__ __forceinline__ void store_row(const f32x4 (&v)[4], _Float16* hrow, unsigned char* h8row, int lane) {
#pragma unroll
    for (int j = 0; j < 4; ++j) { *(f16x4*)(hrow + 4 * lane + 256 * j) = __builtin_convertvector(v[j], f16x4); *(unsigned*)(h8row + 4 * lane + 256 * j) = pack4_i8(v[j][0] * SX, v[j][1] * SX, v[j][2] * SX, v[j][3] * SX); }
}

constexpr int CV_IN = 16 * 52, CV_A = 8 * 16, CV_O = 16 * 16, CV_E = 16 * 24  , CV_D = 24 * 16  ;
constexpr int CV_PER_LAYER = CV_IN + 2 * CV_A + CV_O + NE * (2 * CV_E + CV_D);
struct ConvDesc { const float* src; unsigned char* dst; int N, K; float sc; bool i8; };
__device__ __forceinline__ ConvDesc conv_desc(const Frame& F, int it) { ConvDesc d; const int l = it / CV_PER_LAYER; int r = it % CV_PER_LAYER;
    if (r < CV_IN) { const int kb = r / 52, nb = r % 52; d.N = INW; d.K = D; d.src = F.w_in + (size_t)l * D * INW + (size_t)(kb * 64) * INW + nb * 64; d.dst = WSP(unsigned char, WS_WIN) + (size_t)l * INW * D + (size_t)(nb * 64) * D + kb * 64; d.sc = SW; d.i8 = true; return d; } r -= CV_IN;
    if (r < CV_A) { const int kb = r / 16, nb = r % 16; d.N = D; d.K = AW; d.src = F.w_attn_o + (size_t)l * AW * D + (size_t)(kb * 64) * D + nb * 64; d.dst = WSP(unsigned char, WS_WA) + (size_t)l * D * AW + (size_t)(nb * 64) * AW + kb * 64; d.sc = (float)(1 << WAF_SHIFT); d.i8 = false; return d; } r -= CV_A;
    if (r < CV_A) { const int kb = r / 16, nb = r % 16; d.N = D; d.K = FW; d.src = F.w_four_o + (size_t)l * FW * D + (size_t)(kb * 64) * D + nb * 64; d.dst = WSP(unsigned char, WS_WF) + (size_t)l * D * FW + (size_t)(nb * 64) * FW + kb * 64; d.sc = (float)(1 << WAF_SHIFT); d.i8 = false; return d; } r -= CV_A;
    if (r < CV_O) { const int kb = r / 16, nb = r % 16; d.N = D; d.K = D; d.src = F.w_out + (size_t)l * D * D + (size_t)(kb * 64) * D + nb * 64; d.dst = WSP(unsigned char, WS_WOUT) + (size_t)l * D * D + (size_t)(nb * 64) * D + kb * 64; d.sc = (float)(1 << WOUT_SHIFT); d.i8 = false; return d; } r -= CV_O;
    const int e = r / (2 * CV_E + CV_D); r %= (2 * CV_E + CV_D);
    if (r < 2 * CV_E) { const int up = r / CV_E; r %= CV_E; const int kb = r / 24, nb = r % 24, n0 = nb * 64; d.N = FF; d.K = D;
        d.src = (up ? F.w_e_up : F.w_e_gate) + ((size_t)l * NE + e) * D * FF + (size_t)(kb * 64) * FF + n0;
        d.dst = WSP(unsigned char, WS_WGU) + ((size_t)l * NE + e) * (2 * FF) * D + (size_t)((n0 >> 7) * 256 + up * 128 + (n0 & 127)) * D + kb * 64; d.sc = SW; d.i8 = true; return d; }
    r -= 2 * CV_E;
    { const int kb = r / 16, nb = r % 16; d.N = D; d.K = FF; d.src = F.w_e_down + ((size_t)l * NE + e) * FF * D + (size_t)(kb * 64) * D + nb * 64;
      d.dst = WSP(unsigned char, WS_WD) + ((size_t)l * NE + e) * D * FF + (size_t)(nb * 64) * FF + kb * 64; d.sc = (float)(1 << WD_SHIFT); d.i8 = false; return d; } }
__device__ __forceinline__ void conv_item_regs(const ConvDesc& d, int lane) {
    float r[64];
#pragma unroll
    for (int kk = 0; kk < 64; ++kk) r[kk] = __builtin_nontemporal_load(d.src + (size_t)kk * d.N + lane);
    unsigned char* o = d.dst + (size_t)lane * d.K;
#pragma unroll
    for (int j = 0; j < 4; ++j) { u32x4 w;
        if (d.i8) { w.x = pack4_i8(r[16 * j] * d.sc, r[16 * j + 1] * d.sc, r[16 * j + 2] * d.sc, r[16 * j + 3] * d.sc); w.y = pack4_i8(r[16 * j + 4] * d.sc, r[16 * j + 5] * d.sc, r[16 * j + 6] * d.sc, r[16 * j + 7] * d.sc);
                    w.z = pack4_i8(r[16 * j + 8] * d.sc, r[16 * j + 9] * d.sc, r[16 * j + 10] * d.sc, r[16 * j + 11] * d.sc); w.w = pack4_i8(r[16 * j + 12] * d.sc, r[16 * j + 13] * d.sc, r[16 * j + 14] * d.sc, r[16 * j + 15] * d.sc); }
        else { w.x = pack4_fp8(r[16 * j] * d.sc, r[16 * j + 1] * d.sc, r[16 * j + 2] * d.sc, r[16 * j + 3] * d.sc); w.y = pack4_fp8(r[16 * j + 4] * d.sc, r[16 * j + 5] * d.sc, r[16 * j + 6] * d.sc, r[16 * j + 7] * d.sc);
               w.z = pack4_fp8(r[16 * j + 8] * d.sc, r[16 * j + 9] * d.sc, r[16 * j + 10] * d.sc, r[16 * j + 11] * d.sc); w.w = pack4_fp8(r[16 * j + 12] * d.sc, r[16 * j + 13] * d.sc, r[16 * j + 14] * d.sc, r[16 * j + 15] * d.sc); }
        *(u32x4*)(o + 16 * j) = w; }
}
__device__ __forceinline__ void conv_range_regs(const Frame& F, int cl, int first, int stride, int count) {
    int lane_ = F.lane; asm volatile("" : "+v"(lane_));
#pragma unroll 1
    for (int i = 0; i < count; ++i) { const int it = first + i * stride; if (it >= CV_PER_LAYER) break; const ConvDesc d = conv_desc(F, cl * CV_PER_LAYER + it); conv_item_regs(d, lane_); }
    asm volatile("s_waitcnt vmcnt(0)" ::: "memory");
}
#ifndef CV_NA
#define CV_NA 2
#endif
#ifndef CV_NB
#define CV_NB 2
#endif
constexpr int CV_SLOT_A = CV_NA * (256 - 141) * 8, CV_SLOT_B = CV_NB * 128 * 8;
__device__ __forceinline__ void conv_share_regs(const Frame& F, int cl) {
    const int pre = (F.G == 256) ? CV_SLOT_A + CV_SLOT_B : 0;
    conv_range_regs(F, cl, pre + F.bid * 8 + F.wave, F.G * 8, CV_PER_LAYER);
}
__device__ __forceinline__ void p0_prologue(Frame& F) {
    const int gw = F.bid * 8 + F.wave, NGW = F.G * 8, gt = F.bid * 512 + F.tid, NGT = F.G * 512;
    {
        LAS float* scr = (LAS float*)(F.lds + F.wave * 16640);
        constexpr int TOTAL = CV_PER_LAYER * CONV_P0_LAYERS;
        typedef ConvDesc Desc;
        auto make = [&](int it) -> Desc { return conv_desc(F, it); };
#define P0_LOAD(d, r) do { _Pragma("unroll") for (int kk = 0; kk < 64; ++kk) r[kk] = __builtin_nontemporal_load((d).src + (size_t)kk * (d).N + F.lane); } while (0)
#define P0_FINISH(d, r) do { _Pragma("unroll") for (int kk = 0; kk < 64; ++kk) scr[kk * 65 + F.lane] = r[kk] * (d).sc; \
            LDS_WAIT(); asm volatile("" ::: "memory"); const int c_ = F.lane & 7; \
            _Pragma("unroll") for (int j = 0; j < 8; ++j) { const int n_ = (F.lane >> 3) + 8 * j; const LAS float* s_ = scr + (8 * c_) * 65 + n_; u32x2 o_; \
                if ((d).i8) { o_.x = pack4_i8(s_[0 * 65], s_[1 * 65], s_[2 * 65], s_[3 * 65]); o_.y = pack4_i8(s_[4 * 65], s_[5 * 65], s_[6 * 65], s_[7 * 65]); } \
                else { o_.x = pack4_fp8(s_[0 * 65], s_[1 * 65], s_[2 * 65], s_[3 * 65]); o_.y = pack4_fp8(s_[4 * 65], s_[5 * 65], s_[6 * 65], s_[7 * 65]); } \
                *(u32x2*)((d).dst + (size_t)n_ * (d).K + 8 * c_) = o_; } \
            LDS_WAIT(); asm volatile("" ::: "memory"); } while (0)
        float r0[64], r1[64]; Desc d0, d1;
        if (gw < TOTAL) { d0 = make(gw); P0_LOAD(d0, r0); }
#pragma unroll 1
        for (int it = gw; it < TOTAL; it += 2 * NGW) {
            const bool v1 = it + NGW < TOTAL; if (v1) { d1 = make(it + NGW); P0_LOAD(d1, r1); }
            P0_FINISH(d0, r0);
            if (it + 2 * NGW < TOTAL) { d0 = make(it + 2 * NGW); P0_LOAD(d0, r0); }
            if (v1) P0_FINISH(d1, r1);
        }
#undef P0_LOAD
#undef P0_FINISH
    }
    {
        const float sc = 127.0f, invL = 1.0f / (float)LSEQ;
        unsigned char* M = WSP(unsigned char, WS_DFTM);
        for (int ch = gt; ch < DK * (DK / 16); ch += NGT) { const int k = ch / (DK / 16), j0 = (ch % (DK / 16)) * 16; float v[16];
#pragma unroll
            for (int jj = 0; jj < 16; ++jj) { const int j = j0 + jj; float val = 0.f;
                if (k < LSEQ) { if (j <= HALFL) val = __builtin_amdgcn_cosf((float)((k * j) % LSEQ) * invL) * sc;
                                else if (j >= QOFF && j - QOFF <= HALFL) val = -__builtin_amdgcn_sinf((float)((k * (j - QOFF)) % LSEQ) * invL) * sc; }
                v[jj] = val; }
            u32x4 o; o.x = pack4_i8(v[0], v[1], v[2], v[3]); o.y = pack4_i8(v[4], v[5], v[6], v[7]); o.z = pack4_i8(v[8], v[9], v[10], v[11]); o.w = pack4_i8(v[12], v[13], v[14], v[15]);
            *(u32x4*)(M + (size_t)k * DK + j0) = o; }
        bf16_t* C = WSP(bf16_t, WS_CSM);
        for (int idx = gt; idx < 256 * 256; idx += NGT) { const int n = idx >> 8, c = idx & 255; float val = 0.f;
            if (c < 128) { const float ph = (float)(((n & 127) * c) & 127) * (1.0f / 128.0f); val = (n < 128) ? __builtin_amdgcn_cosf(ph) : __builtin_amdgcn_sinf(ph); }
            C[idx] = f2bf(val); }
    }
    {
        u32x4 z = {0u, 0u, 0u, 0u};
        u32x4* vt = WSP(u32x4, WS_VT); for (int i = gt; i < (int)((size_t)BATCH * NKV * HD * VT_LD * 2 / 16); i += NGT) vt[i] = z;
        u32x4* ri = WSP(u32x4, WS_ROWIDX); for (int i = gt; i < NSLOT * 4 / 16; i += NGT) ri[i] = z;
        u32x4* ga = WSP(u32x4, WS_GATE); for (int i = gt; i < NSLOT * 4 / 16; i += NGT) ga[i] = z;
        u32x4* hp = (u32x4*)(WSP(unsigned char, WS_HB8) + (size_t)T * D); for (int i = gt; i < (TP - T) * D / 16; i += NGT) hp[i] = z;
    }
    {
        f32x4 gm[4], bt[4];
#pragma unroll
        for (int j = 0; j < 4; ++j) { gm[j] = *(const f32x4*)(F.ln0_g + 4 * F.lane + 256 * j); bt[j] = *(const f32x4*)(F.ln0_b + 4 * F.lane + 256 * j); }
        _Float16* H = WSP(_Float16, WS_H); unsigned char* HB = WSP(unsigned char, WS_HB8);
        for (int row = gw; row < T; row += NGW) { const int b = row / LSEQ, p = row - b * LSEQ;
            const float* src = (p < NMETA) ? F.meta + (size_t)p * D : F.x + ((size_t)b * SEQ + (p - NMETA)) * D;
            f32x4 v[4];
#pragma unroll
            for (int j = 0; j < 4; ++j) v[j] = *(const f32x4*)(src + 4 * F.lane + 256 * j);
            ln_row(v, gm, bt); store_row(v, H + (size_t)row * D, HB + (size_t)row * D, F.lane); }
    }
}

constexpr float RESCALE_THR = 8.0f;
__device__ __forceinline__ void attn_phase(Frame& F, int layer) {
    const bf16_t* Q = WSP(bf16_t, WS_Q); const bf16_t* KB = WSP(bf16_t, WS_KB); const bf16_t* VT = WSP(bf16_t, WS_VT); unsigned char* ATT = WSP(unsigned char, WS_ATT);
    LAS unsigned char* Ks = F.lds; LAS unsigned char* Vs = F.lds + 40960;
    int tid_ = F.tid; asm volatile("" : "+v"(tid_)); const int tid = tid_, lane = tid & 63, r32 = lane & 31, hi = lane >> 5, w = F.wave;
    u32x4 kreg[5], vreg[5];
#define ATT_LOAD(uu) do { const int qt_ = (uu) < 1024 ? ((uu) & 63) : 64, bk_ = (uu) < 1024 ? ((uu) >> 6) : (uu) - 1024, kvh_ = bk_ & 1, b_ = bk_ >> 1, kb_ = qt_ * 64 - 128; \
        _Pragma("unroll") for (int i = 0; i < 5; ++i) { const int c = tid + 512 * i, row = c >> 3, ch = c & 7; int pos = kb_ + row; pos = pos < 0 ? 0 : (pos > LSEQ - 1 ? LSEQ - 1 : pos); \
            kreg[i] = *(const u32x4*)(KB + (size_t)(b_ * LSEQ + pos) * 128 + kvh_ * 64 + ch * 8); } \
        _Pragma("unroll") for (int i = 0; i < 5; ++i) { const int c = tid + 512 * i, d = c / 40, ch = c - d * 40; \
            vreg[i] = *(const u32x4*)(VT + (size_t)((b_ * NKV + kvh_) * HD + d) * VT_LD + VT_OFF + kb_ + ch * 8); } } while (0)
    bf16x8 qf[4];
#define ATT_LOADQ(uu) do { const int qt_ = (uu) < 1024 ? ((uu) & 63) : 64, bk_ = (uu) < 1024 ? ((uu) >> 6) : (uu) - 1024, kvh_ = bk_ & 1, b_ = bk_ >> 1; \
        const int qp_ = qt_ * 64 + 32 * (w & 1) + r32, qr_ = qp_ < LSEQ ? qp_ : LSEQ - 1; \
        _Pragma("unroll") for (int d0 = 0; d0 < 4; ++d0) qf[d0] = *(const bf16x8*)(Q + (size_t)(b_ * LSEQ + qr_) * AW + (kvh_ * 4 + (w >> 1)) * 64 + 16 * d0 + 8 * hi); } while (0)
    const float snk0 = __builtin_bit_cast(float, __builtin_amdgcn_readfirstlane(__builtin_bit_cast(int, F.sink[layer * NH + (w >> 1)])));
    const float snk1 = __builtin_bit_cast(float, __builtin_amdgcn_readfirstlane(__builtin_bit_cast(int, F.sink[layer * NH + 4 + (w >> 1)])));
#define ATT_UNIT(L) ((F.G == 256 && (L) < 1024) ? (((L) & ~255) + (((L) & 7) << 5) + (((L) & 255) >> 3)) : (L))
    if (F.bid < BATCH * NKV * 65) { const int u0_ = ATT_UNIT(F.bid); ATT_LOAD(u0_); ATT_LOADQ(u0_); }
#pragma unroll 1
    for (int ul = F.bid; ul < BATCH * NKV * 65; ul += F.G) { const int u = ATT_UNIT(ul), un = ATT_UNIT(ul + F.G);
        const int qt = u < 1024 ? (u & 63) : 64, bk = u < 1024 ? (u >> 6) : u - 1024, kvh = bk & 1, b = bk >> 1, q0 = qt * 64, kb = q0 - 128;
        int tw = tid; asm volatile("" : "+v"(tw));
#pragma unroll
        for (int i = 0; i < 5; ++i) { const int c = tw + 512 * i, row = c >> 3, ch = c & 7;
            *(LAS u32x4*)(Ks + row * 128 + ((ch ^ ((row >> 1) & 7)) << 4)) = kreg[i]; }
#pragma unroll
        for (int i = 0; i < 5; ++i) { const int c = tw + 512 * i, d = c / 40, ch = c - d * 40; const u32x4 v = vreg[i];
            const int x = (d >> 1) & 15, g0 = 2 * ch;
            *(LAS u32x2*)(Vs + d * 640 + ((g0 ^ x) << 3)) = (u32x2){v.x, v.y};
            *(LAS u32x2*)(Vs + d * 640 + (((g0 + 1) ^ x) << 3)) = (u32x2){v.z, v.w}; }
        __syncthreads();
        asm volatile("" :: "v"(qf[0]), "v"(qf[1]), "v"(qf[2]), "v"(qf[3]));
        if (ul + F.G < BATCH * NKV * 65) ATT_LOAD(un);
        if (q0 + 32 * (w & 1) < LSEQ) {
            const int hq = kvh * 4 + (w >> 1), sub = w & 1, qpos = q0 + 32 * sub + r32;
            const float slope2 = __builtin_amdgcn_exp2f(-(float)(hq + 1)) * LOG2E;
            float mrun = (kvh ? snk1 : snk0) * LOG2E, lsum = hi == 0 ? 1.0f : 0.0f;
            f32x16 o0 = {}, o1 = {};
            const int kbase = kb + 4 * hi; const float frel = (float)(kbase - qpos);
            const float dlo = (float)(qpos < 128 ? -qpos : -128), dhi = (float)((LSEQ - 1 - qpos) < 128 ? (LSEQ - 1 - qpos) : 128), dmid = 0.5f * (dlo + dhi), dhalf = 0.5f * (dhi - dlo);
            const bool inner = (q0 >= 128) && (q0 + 63 + 128 <= LSEQ - 1);
            const int sw = (r32 >> 1) & 7;
            LAS unsigned char* kp = Ks + r32 * 128;
            const int x0 = (r32 >> 1) & 15;
            LAS unsigned char* vp0 = Vs + r32 * 640;
#pragma unroll
            for (int t = 0; t < 5; ++t) {
                f32x16 p0 = {}, p1 = {};
                LAS unsigned char* kt = kp + t * 8192;
#pragma unroll
                for (int d0 = 0; d0 < 4; ++d0) { const int c = 2 * d0 + hi;
                    const bf16x8 kf0 = *(const LAS bf16x8*)(kt + ((c ^ sw) << 4));
                    const bf16x8 kf1 = *(const LAS bf16x8*)(kt + 4096 + ((c ^ sw) << 4));
                    p0 = __builtin_amdgcn_mfma_f32_32x32x16_bf16(kf0, qf[d0], p0, 0, 0, 0);
                    p1 = __builtin_amdgcn_mfma_f32_32x32x16_bf16(kf1, qf[d0], p1, 0, 0, 0); }
                float tmax = -1e30f; float ft = frel + (float)(64 * t); asm volatile("" : "+v"(ft));
                if (inner && t >= 1 && t <= 3) {
                    float fa = ft; asm volatile("" : "+v"(fa));
#pragma unroll
                    for (int r = 0; r < 16; ++r) { const float cst = (float)((r & 3) + 8 * (r >> 2));
                        const float d0f = fa + cst, d1f = fa + (cst + 32.0f);
                        p0[r] = p0[r] - slope2 * fabsf(d0f); p1[r] = p1[r] - slope2 * fabsf(d1f);
                        tmax = fmaxf(tmax, fmaxf(p0[r], p1[r])); }
                } else {
                    float fb = ft; asm volatile("" : "+v"(fb)); const float fe = fb - dmid;
#pragma unroll
                    for (int r = 0; r < 16; ++r) { const float cst = (float)((r & 3) + 8 * (r >> 2));
                        const float d0f = fb + cst, d1f = fb + (cst + 32.0f), e0f = fe + cst, e1f = fe + (cst + 32.0f);
                        p0[r] = (fabsf(e0f) <= dhalf) ? p0[r] - slope2 * fabsf(d0f) : -1e30f; p1[r] = (fabsf(e1f) <= dhalf) ? p1[r] - slope2 * fabsf(d1f) : -1e30f;
                        tmax = fmaxf(tmax, fmaxf(p0[r], p1[r])); }
                }
                tmax = fmaxf(tmax, __shfl_xor(tmax, 32));
                const float mnew = (tmax - mrun > RESCALE_THR) ? tmax : mrun, alpha = __builtin_amdgcn_exp2f(mrun - mnew); mrun = mnew;
                if (__any(alpha != 1.0f)) { lsum *= alpha; o0 = o0 * alpha; o1 = o1 * alpha; }
                float ps = 0.f;
#pragma unroll
                for (int r = 0; r < 16; ++r) { p0[r] = __builtin_amdgcn_exp2f(p0[r] - mnew); p1[r] = __builtin_amdgcn_exp2f(p1[r] - mnew); ps += p0[r] + p1[r]; }
                lsum += ps;
                u32x4 pw[4];
                pw[0] = (u32x4){cvtpk(p0[0], p0[1]), cvtpk(p0[2], p0[3]), cvtpk(p0[4], p0[5]), cvtpk(p0[6], p0[7])};
                pw[1] = (u32x4){cvtpk(p0[8], p0[9]), cvtpk(p0[10], p0[11]), cvtpk(p0[12], p0[13]), cvtpk(p0[14], p0[15])};
                pw[2] = (u32x4){cvtpk(p1[0], p1[1]), cvtpk(p1[2], p1[3]), cvtpk(p1[4], p1[5]), cvtpk(p1[6], p1[7])};
                pw[3] = (u32x4){cvtpk(p1[8], p1[9]), cvtpk(p1[10], p1[11]), cvtpk(p1[12], p1[13]), cvtpk(p1[14], p1[15])};
                LAS unsigned char* vt0 = vp0 + t * 128;
#pragma unroll
                for (int ks = 0; ks < 4; ++ks) { const int gl = 4 * ks + hi; const int ol = (gl ^ x0) << 3, oh = ((gl + 2) ^ x0) << 3;
                    { const u32x2 lo = *(const LAS u32x2*)(vt0 + ol), h8 = *(const LAS u32x2*)(vt0 + oh);
                      const u32x4 vf = {lo.x, lo.y, h8.x, h8.y}; o0 = __builtin_amdgcn_mfma_f32_32x32x16_bf16(__builtin_bit_cast(bf16x8, vf), __builtin_bit_cast(bf16x8, pw[ks]), o0, 0, 0, 0); }
                    { const u32x2 lo = *(const LAS u32x2*)(vt0 + ol + 32 * 640), h8 = *(const LAS u32x2*)(vt0 + oh + 32 * 640);
                      const u32x4 vf = {lo.x, lo.y, h8.x, h8.y}; o1 = __builtin_amdgcn_mfma_f32_32x32x16_bf16(__builtin_bit_cast(bf16x8, vf), __builtin_bit_cast(bf16x8, pw[ks]), o1, 0, 0, 0); } }
            }
            if (ul + F.G < BATCH * NKV * 65) ATT_LOADQ(un);
            const float ltot = lsum + __shfl_xor(lsum, 32), inv = 1.0f / ltot;
            if (qpos < LSEQ) { unsigned char* orow = ATT + (size_t)(b * LSEQ + qpos) * AW + hq * 64 + 4 * hi;
#pragma unroll
                for (int rq = 0; rq < 4; ++rq) {
                    *(unsigned*)(orow + 8 * rq) = pack4_fp8(o0[4 * rq] * inv, o0[4 * rq + 1] * inv, o0[4 * rq + 2] * inv, o0[4 * rq + 3] * inv);
                    *(unsigned*)(orow + 32 + 8 * rq) = pack4_fp8(o1[4 * rq] * inv, o1[4 * rq + 1] * inv, o1[4 * rq + 2] * inv, o1[4 * rq + 3] * inv); } }
        }
        __syncthreads();
    }
#undef ATT_LOAD
#undef ATT_UNIT
#undef ATT_LOADQ
}

__device__ __forceinline__ void reduce_scatter32(float (&a)[32], int lane) {
#pragma unroll
    for (int i = 0; i < 16; ++i) { const auto r = __builtin_amdgcn_permlane32_swap(__builtin_bit_cast(unsigned, a[i]), __builtin_bit_cast(unsigned, a[i + 16]), false, false);
        unsigned r0 = r[0], r1 = r[1]; asm volatile("" : "+v"(r0), "+v"(r1));
        a[i] = __builtin_bit_cast(float, r0) + __builtin_bit_cast(float, r1); }
#pragma unroll
    for (int i = 0; i < 8; ++i) { const auto r = __builtin_amdgcn_permlane16_swap(__builtin_bit_cast(unsigned, a[i]), __builtin_bit_cast(unsigned, a[i + 8]), false, false);
        unsigned r0 = r[0], r1 = r[1]; asm volatile("" : "+v"(r0), "+v"(r1));
        a[i] = __builtin_bit_cast(float, r0) + __builtin_bit_cast(float, r1); }
    { const bool up = (lane & 8) != 0;
#pragma unroll
      for (int i = 0; i < 4; ++i) { const float keep = up ? a[i + 4] : a[i], send = up ? a[i] : a[i + 4]; a[i] = keep + dpp_xor8(send); } }
    { const bool up = (lane & 4) != 0;
#pragma unroll
      for (int i = 0; i < 2; ++i) { const float keep = up ? a[i + 2] : a[i], send = up ? a[i] : a[i + 2]; a[i] = keep + dpp_xor4(send); } }
    { const bool up = (lane & 2) != 0; const float keep = up ? a[1] : a[0], send = up ? a[0] : a[1]; a[0] = keep + dpp_xor2(send); }
    a[0] += dpp_xor1(a[0]);
}
__device__ __forceinline__ void ln1_router_phase(Frame& F, int layer, unsigned char* HBo) {
    LAS float* WrL = (LAS float*)F.lds;
    int tid_ = F.tid; asm volatile("" : "+v"(tid_)); const int lane = tid_ & 63;
    { const float* wr = F.w_router + (size_t)layer * D * NE;
      for (int idx = tid_; idx < D * NE; idx += 512) { const int d = idx >> 4, e = idx & 15, ln = (d & 255) >> 2, j = d >> 8, i = d & 3; WrL[ln * 260 + (j * 4 + i) * 16 + e] = wr[idx]; } }
    __syncthreads();
    f32x4 gm[4], bt[4];
#pragma unroll
    for (int j = 0; j < 4; ++j) { gm[j] = *(const f32x4*)(F.ln1_g + (size_t)layer * D + 4 * lane + 256 * j); bt[j] = *(const f32x4*)(F.ln1_b + (size_t)layer * D + 4 * lane + 256 * j); }
    const _Float16* H = WSP(_Float16, WS_H); _Float16* Hw = WSP(_Float16, WS_H); const unsigned char* MIXB = WSP(unsigned char, WS_MIXB); float* AFFT = WSP(float, WS_AFFT);
    const int gw = F.bid * 8 + F.wave, NGW = F.G * 8;
    f16x4 yn[2][4]; unsigned mn[2][4];
#define LN1_LOAD(g_) do { _Pragma("unroll") for (int tk = 0; tk < 2; ++tk) _Pragma("unroll") for (int j = 0; j < 4; ++j) { \
        yn[tk][j] = *(const f16x4*)(H + (size_t)((g_) * 2 + tk) * D + 4 * lane + 256 * j); mn[tk][j] = *(const unsigned*)(MIXB + (size_t)((g_) * 2 + tk) * D + 4 * lane + 256 * j); } } while (0)
    if (gw < T / 2) LN1_LOAD(gw);
#pragma unroll 1
    for (int grp = gw; grp < T / 2; grp += NGW) {
        const int row0 = grp * 2;
        f32x4 y[2][4];
#pragma unroll
        for (int tk = 0; tk < 2; ++tk)
#pragma unroll
            for (int j = 0; j < 4; ++j) y[tk][j] = h2f(yn[tk][j]) * ALPHA + unpack4_fp8(mn[tk][j]);
        if (grp + NGW < T / 2) LN1_LOAD(grp + NGW);
#pragma unroll
        for (int tk = 0; tk < 2; ++tk) { ln_row(y[tk], gm, bt);
#pragma unroll
            for (int j = 0; j < 4; ++j) *(f16x4*)(Hw + (size_t)(row0 + tk) * D + 4 * lane + 256 * j) = __builtin_convertvector(y[tk][j], f16x4);
#pragma unroll
            for (int j = 0; j < 4; ++j) *(unsigned*)(HBo + (size_t)(row0 + tk) * D + 4 * lane + 256 * j) = pack4_i8(y[tk][j][0] * SX, y[tk][j][1] * SX, y[tk][j][2] * SX, y[tk][j][3] * SX); }
        f32x2_t acc2[16];
#pragma unroll
        for (int i = 0; i < 16; ++i) acc2[i] = (f32x2_t){0.f, 0.f};
#pragma unroll
        for (int ji = 0; ji < 16; ++ji) { if ((ji & 1) == 0) asm volatile("" ::: "memory");
            const LAS f32x4* wp = (const LAS f32x4*)(WrL + lane * 260 + ji * 16); const f32x4 w0 = wp[0], w1 = wp[1], w2 = wp[2], w3 = wp[3];
#pragma unroll
            for (int tk = 0; tk < 2; ++tk) { const float yv = y[tk][ji >> 2][ji & 3];
                { const f32x2_t y2 = {yv, yv};
                  acc2[tk * 8 + 0] += y2 * (f32x2_t){w0[0], w0[1]}; acc2[tk * 8 + 1] += y2 * (f32x2_t){w0[2], w0[3]}; acc2[tk * 8 + 2] += y2 * (f32x2_t){w1[0], w1[1]}; acc2[tk * 8 + 3] += y2 * (f32x2_t){w1[2], w1[3]};
                  acc2[tk * 8 + 4] += y2 * (f32x2_t){w2[0], w2[1]}; acc2[tk * 8 + 5] += y2 * (f32x2_t){w2[2], w2[3]}; acc2[tk * 8 + 6] += y2 * (f32x2_t){w3[0], w3[1]}; acc2[tk * 8 + 7] += y2 * (f32x2_t){w3[2], w3[3]}; } } }
        float acc[32];
#pragma unroll
        for (int i = 0; i < 16; ++i) { acc[2 * i] = acc2[i][0]; acc[2 * i + 1] = acc2[i][1]; }
        reduce_scatter32(acc, lane);
        const float logit = acc[0]; float mx = logit;
        mx = fmaxf(mx, dpp_xor2(mx)); mx = fmaxf(mx, dpp_xor4(mx)); mx = fmaxf(mx, dpp_xor8(mx)); mx = fmaxf(mx, __shfl_xor(mx, 16));
        const float ex = __expf(logit - mx); float sm = ex;
        sm += dpp_xor2(sm); sm += dpp_xor4(sm); sm += dpp_xor8(sm); sm += __shfl_xor(sm, 16);
        if ((lane & 1) == 0) { const int row = row0 + (lane >> 5), e = (lane >> 1) & 15, b = row / LSEQ, p = row - b * LSEQ;
            AFFT[(size_t)(b * NE + e) * AFF_LD + p] = ex / sm; }
    }
#undef LN1_LOAD
}

__device__ __forceinline__ void topk_phase(Frame& F) {
    LAS unsigned* cnt = (LAS unsigned*)F.lds; LAS unsigned* pre = cnt + 64;
    const float* AFFT = WSP(float, WS_AFFT); int* ROWIDX = WSP(int, WS_ROWIDX); float* GATE = WSP(float, WS_GATE); int* SLOTMAP = WSP(int, WS_SLOTMAP);
    int tid_ = F.tid; asm volatile("" : "+v"(tid_)); const int tid = tid_, lane = tid & 63, wave = F.wave;
    for (int item = F.bid; item < BATCH * NE; item += F.G) {
        const int b = item >> 4, e = item & 15; const float* a = AFFT + (size_t)item * AFF_LD;
        unsigned key[9];
#pragma unroll
        for (int i = 0; i < 9; ++i) { const int p = tid * 9 + i; key[i] = p < LSEQ ? __float_as_uint(a[p]) : 0u; }
        unsigned thr = 0u;
#pragma unroll 1
        for (int it = 0; it < 15; ++it) { const unsigned hb = 1u << (30 - 2 * it), lb = hb >> 1, c10 = thr | hb, c01 = thr | lb, c11 = c10 | lb; unsigned n10 = 0, n01 = 0, n11 = 0;
#pragma unroll
            for (int i = 0; i < 9; ++i) { n10 += (unsigned)__popcll(__ballot(key[i] >= c10)); n01 += (unsigned)__popcll(__ballot(key[i] >= c01)); n11 += (unsigned)__popcll(__ballot(key[i] >= c11)); }
            if (lane == 0) { cnt[(it & 1) * 24 + wave * 3 + 0] = n10; cnt[(it & 1) * 24 + wave * 3 + 1] = n01; cnt[(it & 1) * 24 + wave * 3 + 2] = n11; }
            __syncthreads();
            unsigned t10 = 0, t01 = 0, t11 = 0;
#pragma unroll
            for (int w2 = 0; w2 < 8; ++w2) { t10 += cnt[(it & 1) * 24 + w2 * 3 + 0]; t01 += cnt[(it & 1) * 24 + w2 * 3 + 1]; t11 += cnt[(it & 1) * 24 + w2 * 3 + 2]; }
            if (t10 >= (unsigned)CAP) thr = (t11 >= (unsigned)CAP) ? c11 : c10; else if (t01 >= (unsigned)CAP) thr = c01; }
        { const unsigned cand = thr | 1u; unsigned c = 0;
#pragma unroll
            for (int i = 0; i < 9; ++i) c += (unsigned)__popcll(__ballot(key[i] >= cand));
            if (lane == 0) cnt[24 + wave * 3] = c;
            __syncthreads();
            unsigned tot = 0;
#pragma unroll
            for (int w2 = 0; w2 < 8; ++w2) tot += cnt[24 + w2 * 3];
            if (tot >= (unsigned)CAP) thr = cand; }
        unsigned pg = 0, pe = 0;
#pragma unroll
        for (int i = 0; i < 9; ++i) { pg += key[i] > thr ? 1u : 0u; pe += key[i] == thr ? 1u : 0u; }
        unsigned v = pg | (pe << 16);
#pragma unroll
        for (int o = 1; o < 64; o <<= 1) { const unsigned t2 = __shfl_up(v, o); if (lane >= o) v += t2; }
        if (lane == 63) pre[wave] = v;
        __syncthreads();
        unsigned woff = 0, tot = 0;
#pragma unroll
        for (int w2 = 0; w2 < 8; ++w2) { const unsigned x = pre[w2]; if (w2 < wave) woff += x; tot += x; }
        const unsigned need = (unsigned)CAP - (tot & 0xffffu);
        unsigned excl = v - (pg | (pe << 16)) + woff; unsigned gtb = excl & 0xffffu, eqb = excl >> 16;
#pragma unroll
        for (int i = 0; i < 9; ++i) { const int p = tid * 9 + i; const bool isgt = key[i] > thr, iseq = key[i] == thr, sel = isgt || (iseq && eqb < need);
            if (p < LSEQ) { const int row = b * LSEQ + p; int s = -1;
                if (sel) { s = e * ESLOTS + b * CAP + (int)(gtb + (eqb < need ? eqb : need)); ROWIDX[s] = row; GATE[s] = __uint_as_float(key[i]); }
                SLOTMAP[(size_t)row * NE + e] = s; }
            gtb += isgt ? 1u : 0u; eqb += iseq ? 1u : 0u; }
        __syncthreads();
    }
}

__device__ __forceinline__ void combine_ln2_phase(Frame& F, int layer, _Float16* Ho, unsigned char* HBo) {
    int lane_ = F.lane; asm volatile("" : "+v"(lane_)); const int lane = lane_;
    f32x4 gm[4], bt[4];
#pragma unroll
    for (int j = 0; j < 4; ++j) { gm[j] = *(const f32x4*)(F.ln2_g + (size_t)layer * D + 4 * lane + 256 * j); bt[j] = *(const f32x4*)(F.ln2_b + (size_t)layer * D + 4 * lane + 256 * j); }
    const _Float16* H = WSP(_Float16, WS_H); const unsigned char* Y = WSP(unsigned char, WS_Y); const int* SLOTMAP = WSP(int, WS_SLOTMAP);
    const int gw = F.bid * 8 + F.wave, NGW = F.G * 8;
    f16x4 hvN[2][4]; unsigned mskN[2]; int slN[2][4]; unsigned ywN[2][4][4]; int smN[2];
    int smA[2] = {0, 0};
#define P10_SEL(r0_, sm_) do { _Pragma("unroll") for (int q = 0; q < 2; ++q) { const int row_ = (q == 0 || (r0_) + NGW >= T) ? (r0_) : (r0_) + NGW; sm_[q] = SLOTMAP[(size_t)row_ * NE + (lane & 15)]; } } while (0)
#define P10_LOAD(r0_, sm_) do { _Pragma("unroll") for (int q = 0; q < 2; ++q) { const int row_ = (q == 0 || (r0_) + NGW >= T) ? (r0_) : (r0_) + NGW; \
        _Pragma("unroll") for (int j = 0; j < 4; ++j) hvN[q][j] = *(const f16x4*)(H + (size_t)row_ * D + 4 * lane + 256 * j); \
        smN[q] = sm_[q]; \
        unsigned mm_ = (unsigned)__ballot(sm_[q] >= 0) & 0xffffu; \
        _Pragma("unroll") for (int k = 0; k < 4; ++k) { int s_ = -1; if (mm_) { const int e_ = __builtin_ctz(mm_); mm_ &= mm_ - 1; s_ = __builtin_amdgcn_readlane(sm_[q], e_); } slN[q][k] = s_; \
            const unsigned char* yr_ = Y + (size_t)(s_ >= 0 ? s_ : 0) * D + 4 * lane; \
            _Pragma("unroll") for (int j = 0; j < 4; ++j) ywN[q][k][j] = *(const unsigned*)(yr_ + 256 * j); } \
        mskN[q] = mm_; } } while (0)
    int rc = gw, rn = gw + 2 * NGW;
    { int sm0[2]; P10_SEL(rc, sm0); P10_LOAD(rc, sm0); }
    if (rn < T) P10_SEL(rn, smA);
#pragma unroll 1
    for (;;) {
        int rows[2]; rows[0] = rc; rows[1] = (rc + NGW < T) ? rc + NGW : rc;
        f32x4 v[2][4]; unsigned msk[2]; int sl[2][4]; int sm[2]; unsigned yw[2][4][4];
#pragma unroll
        for (int q = 0; q < 2; ++q) { msk[q] = mskN[q]; sm[q] = smN[q];
#pragma unroll
            for (int j = 0; j < 4; ++j) v[q][j] = h2f(hvN[q][j]) * ALPHA;
#pragma unroll
            for (int k = 0; k < 4; ++k) { sl[q][k] = slN[q][k];
#pragma unroll
                for (int j = 0; j < 4; ++j) yw[q][k][j] = ywN[q][k][j]; } }
        const bool has_next = rn < T; const int rnn = rn + 2 * NGW;
        if (has_next) { P10_LOAD(rn, smA); if (rnn < T) P10_SEL(rnn, smA); }
#pragma unroll
        for (int q = 0; q < 2; ++q) {
#pragma unroll
            for (int k = 0; k < 4; ++k) { const float wgt = sl[q][k] >= 0 ? 1.0f : 0.0f;
#pragma unroll
                for (int j = 0; j < 4; ++j) v[q][j] += unpack4_fp8(yw[q][k][j]) * wgt; }
            unsigned mm = msk[q];
            while (mm) { const int e = __builtin_ctz(mm); mm &= mm - 1; const int s = __builtin_amdgcn_readlane(sm[q], e); const unsigned char* yr = Y + (size_t)s * D + 4 * lane;
#pragma unroll
                for (int j = 0; j < 4; ++j) v[q][j] += unpack4_fp8(*(const unsigned*)(yr + 256 * j)); }
            ln_row(v[q], gm, bt);
            if (q == 0 || rows[1] != rows[0]) {
                if (layer < DEPTH - 1) store_row(v[q], Ho + (size_t)rows[q] * D, HBo + (size_t)rows[q] * D, lane);
                else { const int b = rows[q] / LSEQ, p = rows[q] - b * LSEQ;
                    if (p >= NMETA) { float* o = F.out + ((size_t)b * SEQ + (p - NMETA)) * D;
#pragma unroll
                        for (int j = 0; j < 4; ++j) *(f32x4*)(o + 4 * lane + 256 * j) = v[q][j]; } } }
        }
        if (!has_next) break;
        rc = rn; rn = rnn;
    }
#undef P10_SEL
#undef P10_LOAD
}

template <class Dsc>
__device__ __forceinline__ void skinny_phase(Frame& F, const Dsc& S) {
    constexpr int NB = Dsc::NB;
    int tid_ = F.tid; asm volatile("" : "+v"(tid_)); const int tid = tid_, lane = tid & 63, fr = lane & 15, fq = lane >> 4, w = F.wave;
    LAS f32x4* red = (LAS f32x4*)F.lds;
#pragma unroll 1
    for (int t0 = F.bid; t0 < S.ntasks; t0 += F.G * NB) {
        f32x4 acc[NB][4];
#pragma unroll
        for (int b = 0; b < NB; ++b)
#pragma unroll
            for (int j = 0; j < 4; ++j) acc[b][j] = (f32x4){0.f, 0.f, 0.f, 0.f};
        const int ns = S.ksteps(w);
        if constexpr (Dsc::MODE == 2) {
            const unsigned char* ap[NB]; const unsigned char* bp[NB][4]; v4i_t ia[NB][4];
#pragma unroll
            for (int b = 0; b < NB; ++b) { int t = t0 + b * F.G; if (t >= S.ntasks) t = t0;
                ap[b] = S.a_ptr(t, w, fr) + 32 * fq;
#pragma unroll
                for (int j = 0; j < 4; ++j) { bp[b][j] = S.b_ptr(t, w, 16 * j + fr) + 32 * fq; ia[b][j] = (v4i_t){0, 0, 0, 0}; } }
#pragma unroll
            for (int s = 0; s < ns; ++s)
#pragma unroll
                for (int b = 0; b < NB; ++b) { const v4i_t a0 = *(const v4i_t*)(ap[b] + 128 * s), a1 = *(const v4i_t*)(ap[b] + 128 * s + 16);
#pragma unroll
                    for (int j = 0; j < 4; ++j) { const v4i_t b0 = *(const v4i_t*)(bp[b][j] + 128 * s), b1 = *(const v4i_t*)(bp[b][j] + 128 * s + 16);
                        ia[b][j] = __builtin_amdgcn_mfma_i32_16x16x64_i8(b0, a0, ia[b][j], 0, 0, 0); ia[b][j] = __builtin_amdgcn_mfma_i32_16x16x64_i8(b1, a1, ia[b][j], 0, 0, 0); } }
#pragma unroll
            for (int b = 0; b < NB; ++b)
#pragma unroll
                for (int j = 0; j < 4; ++j) acc[b][j] = (f32x4){(float)ia[b][j][0], (float)ia[b][j][1], (float)ia[b][j][2], (float)ia[b][j][3]};
        } else if constexpr (Dsc::MODE == 1) {
            static_assert(NB == 1, "batched passes: int8 descriptors only");
            const unsigned char* ap = S.a_ptr(t0, w, fr) + 32 * fq;
            const unsigned char* bp[4];
#pragma unroll
            for (int j = 0; j < 4; ++j) bp[j] = S.b_ptr(t0, w, 16 * j + fr) + 32 * fq;
#pragma unroll
            for (int s = 0; s < ns; ++s) { const v8i_t a = *(const v8i_t*)(ap + 128 * s);
#pragma unroll
                for (int j = 0; j < 4; ++j) { const v8i_t b = *(const v8i_t*)(bp[j] + 128 * s); acc[0][j] = __builtin_amdgcn_mfma_scale_f32_16x16x128_f8f6f4(b, a, acc[0][j], 0, 0, 0, Dsc::SCALE_W * 0x01010101, 0, 0x7f7f7f7f); } }
        } else {
            static_assert(NB == 1, "batched passes: int8 descriptors only");
            const bf16_t* ap = S.a_ptr(t0, w, fr) + 8 * fq;
            const bf16_t* bp[4];
#pragma unroll
            for (int j = 0; j < 4; ++j) bp[j] = S.b_ptr(t0, w, 16 * j + fr) + 8 * fq;
#pragma unroll 2
            for (int s = 0; s < ns; ++s) { const bf16x8 a = *(const bf16x8*)(ap + 32 * s);
#pragma unroll
                for (int j = 0; j < 4; ++j) { const bf16x8 b = *(const bf16x8*)(bp[j] + 32 * s); acc[0][j] = __builtin_amdgcn_mfma_f32_16x16x32_bf16(b, a, acc[0][j], 0, 0, 0); } }
        }
#pragma unroll
        for (int b = 0; b < NB; ++b)
#pragma unroll
            for (int j = 0; j < 4; ++j) red[((b * 8 + w) * 4 + j) * 64 + lane] = acc[b][j];
        __syncthreads();
#pragma unroll
        for (int b = 0; b < NB; ++b) { const int t = t0 + b * F.G; if (t >= S.ntasks) break; LAS f32x4* rb = red + b * 8 * 4 * 64;
            if constexpr (Dsc::PAIRED) {
                if (tid < 128) { const int j = tid >> 6; f32x4 ga = rb[(0 * 4 + j) * 64 + lane], up = rb[(0 * 4 + j + 2) * 64 + lane];
#pragma unroll
                    for (int ww = 1; ww < 8; ++ww) { ga += rb[(ww * 4 + j) * 64 + lane]; up += rb[(ww * 4 + j + 2) * 64 + lane]; }
                    S.fin(t, fr, 16 * j + 4 * fq, ga, up); }
            } else
            if (tid < 256) { const int j = tid >> 6; f32x4 lo = rb[(0 * 4 + j) * 64 + lane], hi = rb[(4 * 4 + j) * 64 + lane];
#pragma unroll
                for (int ww = 1; ww < 4; ++ww) { lo += rb[(ww * 4 + j) * 64 + lane]; hi += rb[((4 + ww) * 4 + j) * 64 + lane]; }
                S.fin(t, fr, 16 * j + 4 * fq, lo, hi); } }
        __syncthreads();
    }
}

struct SkSeq { static constexpr int NB = 1; static constexpr int MODE = 2; static constexpr bool PAIRED = false;
    static constexpr int ntasks = 64;
    __device__ __forceinline__ int ksteps(int w) const { return 4 + (w < 2 ? 1 : 0); }
    __device__ __forceinline__ int kbeg(int w) const { return (4 * w + (w < 2 ? w : 2)) * 128; }
    const unsigned char* DFTM; const unsigned char* PQT; unsigned char* FOUR;
    __device__ __forceinline__ const unsigned char* a_ptr(int, int w, int r) const { return DFTM + (size_t)(4096 + r) * DK + kbeg(w); }
    __device__ __forceinline__ const unsigned char* b_ptr(int t, int w, int c) const { return PQT + (size_t)(64 * t + c) * DK + kbeg(w); }
    __device__ __forceinline__ void fin(int t, int r, int c, const f32x4 lo, const f32x4 hi) const { const int k = 4096 + r, n = 64 * t + c, b = n >> 9;
        const f32x4 z = (lo + hi) * (1.0f / (127.0f * sqrtf(128.0f * (float)LSEQ) * SPQ)); *(unsigned*)(FOUR + (size_t)(b * LSEQ + k) * FW + (n & 511)) = pack4_fp8(z[0], z[1], z[2], z[3]); }
};
struct SkMerge { static constexpr int NB = 1; static constexpr int MODE = 1; static constexpr bool PAIRED = false; static constexpr int SCALE_W = 127 - WAF_SHIFT;
    static constexpr int ntasks = 128, nsteps = 1; __device__ __forceinline__ int ksteps(int) const { return nsteps; }
    const unsigned char *ATT, *FOUR, *WA, *WF; const unsigned char* G; unsigned char* MG;
    __device__ __forceinline__ const unsigned char* a_ptr(int t, int w, int r) const { return ((w >> 2) ? FOUR : ATT) + (size_t)(32768 + 16 * (t >> 4) + r) * AW + (w & 3) * 128; }
    __device__ __forceinline__ const unsigned char* b_ptr(int t, int w, int c) const { return ((w >> 2) ? WF : WA) + (size_t)(64 * (t & 15) + c) * AW + (w & 3) * 128; }
    __device__ __forceinline__ void fin(int t, int r, int c, const f32x4 lo, const f32x4 hi) const { const int row = 32768 + 16 * (t >> 4) + r, col = 64 * (t & 15) + c;
        const f32x4 g0 = unpack4_u8(*(const unsigned*)(G + (size_t)row * (2 * D) + col)) * (1.0f / 255.0f), g1 = unpack4_u8(*(const unsigned*)(G + (size_t)row * (2 * D) + D + col)) * (1.0f / 255.0f);
        const f32x4 o = g0 * lo + g1 * hi; *(unsigned*)(MG + (size_t)row * D + col) = pack4_fp8(o[0], o[1], o[2], o[3]); }
};
struct SkWout { static constexpr int NB = 1; static constexpr int MODE = 1; static constexpr bool PAIRED = false; static constexpr int SCALE_W = 127 - WOUT_SHIFT;
    static constexpr int ntasks = 128, nsteps = 1; __device__ __forceinline__ int ksteps(int) const { return nsteps; }
    const unsigned char *MG, *WOUT; unsigned char* MIXB;
    __device__ __forceinline__ const unsigned char* a_ptr(int t, int w, int r) const { return MG + (size_t)(32768 + 16 * (t >> 4) + r) * D + w * 128; }
    __device__ __forceinline__ const unsigned char* b_ptr(int t, int w, int c) const { return WOUT + (size_t)(64 * (t & 15) + c) * D + w * 128; }
    __device__ __forceinline__ void fin(int t, int r, int c, const f32x4 lo, const f32x4 hi) const { const f32x4 o = lo + hi; *(unsigned*)(MIXB + (size_t)(32768 + 16 * (t >> 4) + r) * D + 64 * (t & 15) + c) = pack4_fp8(o[0], o[1], o[2], o[3]); }
};
struct SkDown { static constexpr int NB = 1; static constexpr int MODE = 1; static constexpr bool PAIRED = false; static constexpr int SCALE_W = 127 - WD_SHIFT;
    static constexpr int ntasks = NE * 8, nsteps = FF / 4 / 128; __device__ __forceinline__ int ksteps(int) const { return nsteps; }
    const unsigned char *HID, *WD; const float* GATE; unsigned char* Y;
    __device__ __forceinline__ const unsigned char* a_ptr(int t, int w, int r) const { return HID + (size_t)((t >> 3) * ESLOTS + 4096 + r) * FF + (w & 3) * (FF / 4); }
    __device__ __forceinline__ const unsigned char* b_ptr(int t, int w, int c) const { return WD + ((size_t)(t >> 3) * D + 128 * (t & 7) + 64 * (w >> 2) + c) * FF + (w & 3) * (FF / 4); }
    __device__ __forceinline__ void fin(int t, int r, int c, const f32x4 lo, const f32x4 hi) const { const int slot = (t >> 3) * ESLOTS + 4096 + r; const float g = GATE[slot];
        unsigned char* y = Y + (size_t)slot * D + 128 * (t & 7) + c; const f32x4 a = lo * g, b = hi * g; *(unsigned*)y = pack4_fp8(a[0], a[1], a[2], a[3]); *(unsigned*)(y + 64) = pack4_fp8(b[0], b[1], b[2], b[3]); }
};
struct SkGU { static constexpr int NB = 3; static constexpr int MODE = 2; static constexpr bool PAIRED = true;
    static constexpr int ntasks = NE * (FF / 32), nsteps = 1; __device__ __forceinline__ int ksteps(int) const { return nsteps; }
    const unsigned char *HB8, *WGU; const int* ROWIDX; unsigned char* HID;
    __device__ __forceinline__ const unsigned char* a_ptr(int t, int w, int r) const { const int e = t / (FF / 32); return HB8 + (size_t)ROWIDX[e * ESLOTS + 4096 + r] * D + w * 128; }
    __device__ __forceinline__ const unsigned char* b_ptr(int t, int w, int c) const { const int e = t / (FF / 32), hc = (t % (FF / 32)) * 32 + (c & 31), up = c >> 5;
        return WGU + ((size_t)e * (2 * FF) + (hc >> 7) * 256 + up * 128 + (hc & 127)) * D + w * 128; }
    __device__ __forceinline__ void fin(int t, int r, int c, const f32x4 ga, const f32x4 up) const { const int e = t / (FF / 32), slot = e * ESLOTS + 4096 + r, hc = (t % (FF / 32)) * 32 + c; f32x4 o;
#pragma unroll
        for (int j = 0; j < 4; ++j) { const float g = ga[j] * (1.0f / (SX * SW)); o[j] = g * fast_sigmoid(g) * (up[j] * (1.0f / (SX * SW))); }
        *(unsigned*)(HID + (size_t)slot * FF + hc) = pack4_fp8(o[0], o[1], o[2], o[3]); }
};

#ifndef PHASE_MASK
#define PHASE_MASK 0xFFFF
#endif
#define EN(k) ((PHASE_MASK >> (k)) & 1)
#ifndef REP_PHASE
#define REP_PHASE -1
#endif
#ifndef REP_NOEPI
#define REP_NOEPI 0
#endif
#define NREP(k) ((REP_PHASE) == (k) ? 2 : 1)
#define EPI_ON(k) (!(REP_NOEPI && NREP(k) == 2 && rep == 1))
constexpr int PH_PER_LAYER = 10, N_PHASES = 1 + DEPTH * PH_PER_LAYER;
struct Args { const float* in[18]; float* out; unsigned char* ws; int ph_lo, ph_hi; };
template <bool ALL>
__global__ void __launch_bounds__(512, 2) mk_fwd(Args args) {
    extern __shared__ __attribute__((aligned(16))) unsigned char lds_raw[];
    Frame F;
    F.lds = (LAS unsigned char*)lds_raw;
    F.tid = threadIdx.x; F.lane = F.tid & 63; F.wave = __builtin_amdgcn_readfirstlane(F.tid >> 6); F.G = gridDim.x; F.bid = blockIdx.x;
    F.x = args.in[0]; F.meta = args.in[1]; F.ln0_g = args.in[2]; F.ln0_b = args.in[3]; F.w_in = args.in[4]; F.b_gate = args.in[5]; F.sink = args.in[6];
    F.w_attn_o = args.in[7]; F.w_four_o = args.in[8]; F.w_out = args.in[9]; F.ln1_g = args.in[10]; F.ln1_b = args.in[11]; F.w_router = args.in[12];
    F.w_e_gate = args.in[13]; F.w_e_up = args.in[14]; F.w_e_down = args.in[15]; F.ln2_g = args.in[16]; F.ln2_b = args.in[17];
    F.out = args.out; F.ws = args.ws;
    volatile LAS unsigned* MISC = (volatile LAS unsigned*)(F.lds + MISC_OFF);
    if (F.tid < 64) MISC[F.tid] = 0u;
    __syncthreads();
    const int lo = ALL ? 0 : args.ph_lo, hi = ALL ? (MK_DEBUG ? 3 : N_PHASES) : args.ph_hi;
    unsigned* ctl = (unsigned*)(F.ws + WS_CTL);
    XcdBarrier bar; bar.bar = ctl + CW_BAR; bar.x = 0; bar.st = nullptr;
    if (hi - lo > 1) bar = xcd_barrier_post(ctl + CW_BAR, MISC + 8);
#define IN(k) (ALL ? (!MK_DEBUG || (k) < 3) : (lo <= (k) && (k) < hi))
#if defined(MK_PROBE_A)
    unsigned long long* ts = (unsigned long long*)(ctl + 2048);
#define STAMP(i) do { if (F.bid == 0 && F.tid == 0) ts[i] = __builtin_amdgcn_s_memrealtime(); } while (0)
#define SEAM(k) do { xcd_barrier(bar); STAMP((k) + 1); } while (0)
    STAMP(0);
#else
#define SEAM(k) do { if (IN(k) && IN((k) + 1)) xcd_barrier(bar); } while (0)
#endif
    LAS unsigned char* ring = F.lds;

    if (EN(0) && IN(0)) { for (int rep = 0; rep < NREP(0); ++rep) { p0_prologue(F); if (rep + 1 < NREP(0)) xcd_barrier(bar); } }
    SEAM(0);
    for (int layer = 0; layer < DEPTH; ++layer) {
        const int pb = 1 + layer * PH_PER_LAYER;
        if (EN(1) && IN(pb + 0)) for (int rep = 0; rep < NREP(1); ++rep) { if (rep) xcd_barrier(bar);
            SchedInProj S; S.o.init(TP / 256, INW / 256, F.G, F.bid); S.o1.init(128, 8, F.G, F.bid); S.o2.init(129, 5, F.G, F.bid); S.bal = (F.G == 256);
            S.A = (const char*)WSP(unsigned char, WS_HB8); S.B = (const char*)(WSP(unsigned char, WS_WIN) + (size_t)layer * INW * D); S.lda = D; S.ldb = D;
            EpiInProj E{WSP(bf16_t, WS_Q), WSP(bf16_t, WS_KB), WSP(bf16_t, WS_VT), WSP(bf16_t, WS_UF), WSP(unsigned char, WS_G), F.b_gate + (size_t)layer * 2 * D, EPI_ON(1)};
            pg8::gemm_phase<EpiInProj, SchedInProj, true, 2>(ring, S, E, D, D);
            if (F.G == 256 && F.bid >= 141 && layer + 1 < DEPTH && layer + 1 >= CONV_P0_LAYERS && rep == 0) conv_range_regs(F, layer + 1, (F.bid - 141) * 8 + F.wave, (256 - 141) * 8, CV_NA);
        }
        SEAM(pb + 0);
        if (EN(2) && IN(pb + 1)) for (int rep = 0; rep < NREP(2); ++rep) { if (rep) xcd_barrier(bar);
#ifndef NO_ATTN
#ifdef REP_CHAN_ONLY
            if (rep == 0)
#endif
            attn_phase(F, layer);
#endif
#ifndef NO_CHAN
            const bool skip16 = (F.G > 64);
            SchedChan S; S.o.init(BATCH * 4 * 17, 1, skip16 ? F.G - 16 : F.G, skip16 ? (F.bid < 16 ? BATCH * 4 * 17 : F.bid - 16) : F.bid); S.UF = (const char*)WSP(bf16_t, WS_UF); S.CSM = (const char*)WSP(bf16_t, WS_CSM);
            EpiChan E{WSP(unsigned char, WS_PQT)};
            pg8::gemm_phase<EpiChan, SchedChan, true>(ring, S, E, 256, 512);
#endif
        }
        SEAM(pb + 1);
        if (EN(3) && IN(pb + 2)) for (int rep = 0; rep < NREP(3); ++rep) { if (rep) xcd_barrier(bar);
            { SchedReg S; S.o.init(4096 / 256, 4096 / 256, F.G, F.bid); S.A = (const char*)WSP(unsigned char, WS_DFTM); S.B = (const char*)WSP(unsigned char, WS_PQT); S.lda = DK; S.ldb = DK;
              EpiSeq E{WSP(unsigned char, WS_FOUR)};
              pg8::gemm_phase<EpiSeq, SchedReg, true, 2>(ring, S, E, DK, DK); }
            { SkSeq K{WSP(unsigned char, WS_DFTM), WSP(unsigned char, WS_PQT), WSP(unsigned char, WS_FOUR)}; skinny_phase(F, K); }
        }
        SEAM(pb + 2);
        if (EN(4) && IN(pb + 3)) for (int rep = 0; rep < NREP(4); ++rep) { if (rep) xcd_barrier(bar);
            SchedMerge S; S.o.init(32768 / 256, D / 256, F.G, F.bid); S.ATT = (const char*)WSP(unsigned char, WS_ATT); S.FOUR = (const char*)WSP(unsigned char, WS_FOUR);
            S.WA = (const char*)(WSP(unsigned char, WS_WA) + (size_t)layer * D * AW); S.WF = (const char*)(WSP(unsigned char, WS_WF) + (size_t)layer * D * FW);
            EpiMerge E{WSP(unsigned char, WS_MG), WSP(unsigned char, WS_G)};
            pg8::gemm_phase<EpiMerge, SchedMerge, true, 1, 127 - WAF_SHIFT>(ring, S, E, AW, AW);
            { SkMerge K{WSP(unsigned char, WS_ATT), WSP(unsigned char, WS_FOUR), WSP(unsigned char, WS_WA) + (size_t)layer * D * AW, WSP(unsigned char, WS_WF) + (size_t)layer * D * FW, WSP(unsigned char, WS_G), WSP(unsigned char, WS_MG)}; skinny_phase(F, K); }
        }
        SEAM(pb + 3);
        if (EN(5) && IN(pb + 4)) for (int rep = 0; rep < NREP(5); ++rep) { if (rep) xcd_barrier(bar);
            SchedReg S; S.o.init(32768 / 256, D / 256, F.G, F.bid); S.A = (const char*)WSP(unsigned char, WS_MG); S.B = (const char*)(WSP(unsigned char, WS_WOUT) + (size_t)layer * D * D); S.lda = D; S.ldb = D;
            EpiWout E{(NREP(5) == 2 && rep == 0) ? WSP(unsigned char, WS_Q) : WSP(unsigned char, WS_MIXB)};
            pg8::gemm_phase<EpiWout, SchedReg, true, 1, 127 - WOUT_SHIFT>(ring, S, E, D, D);
            { SkWout K{WSP(unsigned char, WS_MG), WSP(unsigned char, WS_WOUT) + (size_t)layer * D * D, (NREP(5) == 2 && rep == 0) ? WSP(unsigned char, WS_Q) : WSP(unsigned char, WS_MIXB)}; skinny_phase(F, K); }
        }
        SEAM(pb + 4);
        if (EN(6) && IN(pb + 5)) for (int rep = 0; rep < NREP(6); ++rep) { if (rep) xcd_barrier(bar); ln1_router_phase(F, layer, (NREP(6) == 2 && rep == 0) ? WSP(unsigned char, WS_G) : WSP(unsigned char, WS_HB8)); }
        SEAM(pb + 5);
        if (EN(7) && IN(pb + 6)) for (int rep = 0; rep < NREP(7); ++rep) { if (rep) xcd_barrier(bar); topk_phase(F);
            if (F.G == 256 && F.bid >= 128 && layer + 1 < DEPTH && layer + 1 >= CONV_P0_LAYERS && rep == 0) conv_range_regs(F, layer + 1, CV_SLOT_A + (F.bid - 128) * 8 + F.wave, 128 * 8, CV_NB); }
        SEAM(pb + 6);
        if (EN(8) && IN(pb + 7)) for (int rep = 0; rep < NREP(8); ++rep) { if (rep) xcd_barrier(bar);
            SchedGU S; S.o.init(NE * 16, (2 * FF) / 256, F.G, F.bid); S.HB = (const char*)WSP(unsigned char, WS_HB8); S.WGU = (const char*)(WSP(unsigned char, WS_WGU) + (size_t)layer * NE * (2 * FF) * D);
            LAS int* idxtab = (LAS int*)(F.lds + IDXTAB_OFF); S.idxtab = idxtab;
            S.Fp = &F; S.conv_layer = (layer + 1 < DEPTH && layer + 1 >= CONV_P0_LAYERS && rep == 0) ? layer + 1 : -1; S.conv_slot = F.bid % 8;
            const int* ROWIDX = WSP(int, WS_ROWIDX);
            { int t_ = F.tid; asm volatile("" : "+v"(t_));
              for (int i = 0; i < IDXTAB_UNITS; ++i) { int pm, pn; if (!S.o.tile(i, pm, pn)) break; if (t_ < 256) idxtab[i * 256 + t_] = ROWIDX[(pm >> 4) * ESLOTS + (pm & 15) * 256 + t_]; } }
            __syncthreads();
            EpiGU E{WSP(bf16_t, WS_HID), EPI_ON(8)};
            pg8::gemm_phase<EpiGU, SchedGU, true, 2>(ring, S, E, D, D);
            { SkGU K{WSP(unsigned char, WS_HB8), WSP(unsigned char, WS_WGU) + (size_t)layer * NE * (2 * FF) * D, WSP(int, WS_ROWIDX), WSP(unsigned char, WS_HID)}; skinny_phase(F, K); }
        }
        SEAM(pb + 7);
        if (EN(9) && IN(pb + 8)) for (int rep = 0; rep < NREP(9); ++rep) { if (rep) xcd_barrier(bar);
            SchedDown S; S.o.init(NE * 16, D / 256, F.G, F.bid); S.HID = (const char*)WSP(bf16_t, WS_HID); S.WD = (const char*)(WSP(unsigned char, WS_WD) + (size_t)layer * NE * D * FF);
            EpiDown E{WSP(unsigned char, WS_Y), WSP(float, WS_GATE), EPI_ON(9)};
            pg8::gemm_phase<EpiDown, SchedDown, true, 1, 127 - WD_SHIFT>(ring, S, E, FF, FF);
            { SkDown K{WSP(unsigned char, WS_HID), WSP(unsigned char, WS_WD) + (size_t)layer * NE * D * FF, WSP(float, WS_GATE), WSP(unsigned char, WS_Y)}; skinny_phase(F, K); }
        }
        SEAM(pb + 8);
        if (EN(10) && IN(pb + 9)) for (int rep = 0; rep < NREP(10); ++rep) { if (rep) xcd_barrier(bar); combine_ln2_phase(F, layer, (NREP(10) == 2 && rep == 0) ? WSP(_Float16, WS_HID) : WSP(_Float16, WS_H), (NREP(10) == 2 && rep == 0) ? WSP(unsigned char, WS_HID + (size_t)TP * D * 4) : WSP(unsigned char, WS_HB8)); }
        SEAM(pb + 9);
#ifdef EXTRA_BAR
        for (int xb = 0; xb < EXTRA_BAR; ++xb) xcd_barrier(bar);
#endif
    }
#if defined(MK_PROBE_A)
    if (F.bid == 0) {
        float A = 0.f, B = 0.f;
        if (MK_PROBE_A == 0) A = (float)(ts[1] - ts[0]); else for (int l = 0; l < DEPTH; ++l) A += (float)(ts[1 + l * 10 + MK_PROBE_A + 0] - ts[1 + l * 10 + MK_PROBE_A - 1]);
        if (MK_PROBE_B == 0) B = (float)(ts[1] - ts[0]); else for (int l = 0; l < DEPTH; ++l) B += (float)(ts[1 + l * 10 + MK_PROBE_B + 0] - ts[1 + l * 10 + MK_PROBE_B - 1]);
        A *= 0.01f; B *= 0.01f;
        for (int j = F.tid; j < 33554; j += 512) { if (j == 0) F.out[0] = A; else F.out[(size_t)j * 1000] += B; }
    }
#endif
#undef IN
#undef SEAM
}

#if MK_DEBUG
__global__ void chk_attn(const unsigned char* ws, const float* sink, unsigned* errw) {
    const int s = blockIdx.x, d = threadIdx.x;
    const bf16_t* Q = (const bf16_t*)(ws + WS_Q); const bf16_t* KB = (const bf16_t*)(ws + WS_KB); const bf16_t* VT = (const bf16_t*)(ws + WS_VT); const unsigned char* ATT = ws + WS_ATT;
    int row;
    if (s < 64) { const int k = s & 15; const int p = k < 3 ? (k == 2 ? 15 : k) : k < 5 ? 13 + k : k < 7 ? 58 + k : k < 11 ? 120 + k : k == 11 ? 2056 : k < 14 ? 3971 + k : 4096 + k; row = ((s >> 4) * 2 + ((s >> 4) == 3 ? 1 : 0)) * LSEQ + p; }
    else row = (int)(((unsigned)s * 2654435761u) % (unsigned)T);
    const int hq = s & 7, kvh = hq >> 2, b = row / LSEQ, i = row - b * LSEQ;
    const float q = bf2f(Q[(size_t)row * AW + hq * 64 + d]);
    const float slope2 = exp2f(-(float)(hq + 1)) * LOG2E, sink2 = sink[hq] * LOG2E;
    const int j0 = i - 128 < 0 ? 0 : i - 128, j1 = i + 128 > LSEQ - 1 ? LSEQ - 1 : i + 128;
    float m = sink2;
    for (int j = j0; j <= j1; ++j) { float sc = wave_sum(q * bf2f(KB[(size_t)(b * LSEQ + j) * 128 + kvh * 64 + d])); sc -= slope2 * fabsf((float)(j - i)); m = fmaxf(m, sc); }
    float o = 0.f, den = exp2f(sink2 - m);
    for (int j = j0; j <= j1; ++j) { float sc = wave_sum(q * bf2f(KB[(size_t)(b * LSEQ + j) * 128 + kvh * 64 + d])); sc -= slope2 * fabsf((float)(j - i)); const float p = exp2f(sc - m); den += p;
        o += p * bf2f(VT[(size_t)((b * NKV + kvh) * HD + d) * VT_LD + VT_OFF + j]); }
    const float r = o / den, a = __builtin_amdgcn_cvt_f32_fp8((int)ATT[(size_t)row * AW + hq * 64 + d], 0);
    float err = fabsf(r - a), scale = fabsf(r);
    for (int x = 1; x < 64; x <<= 1) { err = fmaxf(err, __shfl_xor(err, x)); scale = fmaxf(scale, __shfl_xor(scale, x)); }
    if (d == 0) atomicMax(errw, __float_as_uint(err / fmaxf(scale, 1e-2f)));
}
__global__ void chk_report(const unsigned* errw, float* out, int n) {
    const int i = blockIdx.x * blockDim.x + threadIdx.x; if (i >= n) return;
    out[i] = (i == 0) ? 1000.0f + 10000.0f * __uint_as_float(errw[0]) : 0.0f;
}
static void debug_driver(Args a, int grid, hipStream_t stream, int out_size) {
    a.ph_lo = 0; a.ph_hi = 3;
    hipLaunchKernelGGL(mk_fwd<true>, dim3(grid), dim3(512), LDS_BYTES, stream, a);
    unsigned* errw = (unsigned*)(a.ws + WS_CTL) + CW_ERR;
    hipLaunchKernelGGL(chk_attn, dim3(8192), dim3(64), 0, stream, (const unsigned char*)a.ws, a.in[6], errw);
    hipLaunchKernelGGL(chk_report, dim3((out_size + 255) / 256), dim3(256), 0, stream, (const unsigned*)errw, a.out, out_size);
}
#endif

extern "C" void kernel_launch(void* const* d_in, const int* in_sizes, int n_in, void* d_out, int out_size, void* d_ws, size_t ws_size, hipStream_t stream) {
#if defined(MK_PER_PHASE)
    auto MKF = mk_fwd<false>;
#else
    auto MKF = mk_fwd<true>;
#endif
    static int grid = 0;
    if (grid == 0) {
        int dev = 0, cus = 0, per_cu = 0;
        if (hipGetDevice(&dev) != hipSuccess || hipDeviceGetAttribute(&cus, hipDeviceAttributeMultiprocessorCount, dev) != hipSuccess) { fprintf(stderr, "kernel_launch: device query failed\n"); grid = -1; return; }
        if (hipFuncSetAttribute((const void*)MKF, hipFuncAttributeMaxDynamicSharedMemorySize, LDS_BYTES) != hipSuccess) { fprintf(stderr, "kernel_launch: hipFuncSetAttribute failed\n"); grid = -1; return; }
        if (hipOccupancyMaxActiveBlocksPerMultiprocessor(&per_cu, (const void*)MKF, 512, LDS_BYTES) != hipSuccess || per_cu < 1) fprintf(stderr, "kernel_launch: occupancy query reports %d\n", per_cu);
        (void)hipGetLastError();
        if (ws_size < WS_END) fprintf(stderr, "kernel_launch: workspace %zu < %zu\n", ws_size, (size_t)WS_END);
        grid = cus;
    }
    if (grid < 0) return;
    (void)hipMemsetAsync((char*)d_ws + WS_CTL, 0, CTL_BYTES, stream);
    Args a{};
    for (int i = 0; i < 18; ++i) a.in[i] = (const float*)d_in[i];
    a.out = (float*)d_out; a.ws = (unsigned char*)d_ws;
#if MK_DEBUG
    debug_driver(a, grid, stream, out_size);
#elif defined(MK_PER_PHASE)
    for (int p = 0; p < N_PHASES; ++p) { a.ph_lo = p; a.ph_hi = p + 1; hipLaunchKernelGGL(MKF, dim3(grid), dim3(512), LDS_BYTES, stream, a); }
#else
    a.ph_lo = 0; a.ph_hi = N_PHASES;
    hipLaunchKernelGGL(MKF, dim3(grid), dim3(512), LDS_BYTES, stream, a);
#endif
}
```
